# Optimizing an MI355X kernel written in HIP

```python
import jax
import jax.numpy as jnp
from jax import lax
import numpy as np

D_MODEL = 1024
BATCH = 4
SEQ = 4096
DEPTH = 4

MEM_LEN = 256
N_EVEN = (DEPTH + 1) // 2
N_ODD = DEPTH // 2
D_FF = 2816
NORM_EPS = 1e-6
ATTN_BLOCK = 128

RET_HEADS = 4
RET_DK = 128
RET_DV = 128
RET_CHUNK = 128
RET_ROPE_BASE = 10000.0

SSM_HEADS = 8
SSM_HEAD_DIM = 64
SSM_D_INNER = SSM_HEADS * SSM_HEAD_DIM
SSM_D_STATE = 64
SSM_GROUPS = 2
SSM_CONV = 4
SSM_CHUNK = 128
SSM_CONV_DIM = SSM_D_INNER + 2 * SSM_GROUPS * SSM_D_STATE

EVEN_SPLITS = (RET_HEADS * RET_DK, RET_HEADS * RET_DK, RET_HEADS * RET_DV, RET_HEADS * RET_DV, SSM_D_INNER, SSM_CONV_DIM, SSM_HEADS)
EVEN_IN = sum(EVEN_SPLITS)
EVEN_MIX = RET_HEADS * RET_DV + SSM_D_INNER

NSA_HEADS = 8
NSA_KV_HEADS = 2
NSA_HEAD_DIM = 64
NSA_CMP_BLOCK = 32
NSA_CMP_STRIDE = 16
NSA_CMP_HIDDEN = 256
NSA_SEL_BLOCK = 64
NSA_TOPN = 16
NSA_WINDOW = 512
NSA_SEL_QBLOCK = 64
NSA_FORCE_SCORE = 1e6

SWA_HEADS = 8
SWA_KV_HEADS = 2
SWA_HEAD_DIM = 64
SWA_WINDOW = 128

ODD_SPLITS = (NSA_HEADS * NSA_HEAD_DIM,) + (NSA_KV_HEADS * NSA_HEAD_DIM,) * 6 + (3 * NSA_HEADS, SWA_HEADS * SWA_HEAD_DIM, SWA_KV_HEADS * SWA_HEAD_DIM, SWA_KV_HEADS * SWA_HEAD_DIM)
ODD_IN = sum(ODD_SPLITS)
ODD_MIX = NSA_HEADS * NSA_HEAD_DIM + SWA_HEADS * SWA_HEAD_DIM

XATTN_HEADS = 4
XATTN_HEAD_DIM = D_MODEL // XATTN_HEADS

kernel_name = 'hybrid_retnet_mamba2_nsa_swa_macaron'


def split_last(t, sizes):
    cuts = [int(c) for c in np.cumsum(sizes)[:-1]]
    return jnp.split(t, cuts, axis=-1)


def rmsnorm(x, w):
    xf = x.astype(jnp.float32)
    y = xf * lax.rsqrt(jnp.mean(xf * xf, axis=-1, keepdims=True) + NORM_EPS)
    return (y * w.astype(jnp.float32)).astype(x.dtype)


def swiglu(h, w_gate, w_up, w_down):
    return (jax.nn.silu(h @ w_gate) * (h @ w_up)) @ w_down


def masked_softmax(s, mask):
    s = jnp.where(mask, s, -jnp.inf)
    m = jnp.max(s, axis=-1, keepdims=True)
    m = jnp.where(jnp.isfinite(m), m, 0.0)
    p = jnp.exp(s - m)
    return p / jnp.maximum(jnp.sum(p, axis=-1, keepdims=True), 1e-30)


def sink_softmax(s, mask, sink):
    s = jnp.where(mask, s, -jnp.inf)
    m = jnp.maximum(jnp.max(s, axis=-1, keepdims=True), sink)
    p = jnp.exp(s - m)
    return p / (jnp.sum(p, axis=-1, keepdims=True) + jnp.exp(sink - m))


def rotate_pairs(t, cos, sin):
    t1 = t[..., 0::2]
    t2 = t[..., 1::2]
    return jnp.stack([t1 * cos - t2 * sin, t1 * sin + t2 * cos], axis=-1).reshape(t.shape)


def retention(q, k, v):
    bsz, seq, nh, dk = q.shape
    dv = v.shape[-1]
    L = RET_CHUNK
    nc = seq // L
    cdt = q.dtype
    pos = jnp.arange(seq, dtype=jnp.float32)
    inv_freq = 1.0 / (RET_ROPE_BASE ** jnp.linspace(0.0, 1.0, dk // 2, dtype=jnp.float32))
    ang = pos[:, None] * inv_freq[None, :]
    cos = jnp.cos(ang)[:, None, :].astype(cdt)
    sin = jnp.sin(ang)[:, None, :].astype(cdt)
    q = rotate_pairs(q, cos, sin)
    k = rotate_pairs(k, cos, sin) * (dk ** -0.5)
    log_g = jnp.log1p(-jnp.exp2(-5.0 - jnp.arange(nh, dtype=jnp.float32)))
    idx = jnp.arange(L, dtype=jnp.float32)
    diff = idx[:, None] - idx[None, :]
    dmat = jnp.where(diff >= 0, jnp.exp(jnp.maximum(diff, 0.0)[None] * log_g[:, None, None]), 0.0).astype(cdt)
    zeta = jnp.exp((L - 1 - idx)[None, :] * log_g[:, None]).astype(cdt)
    xi = jnp.exp((idx + 1)[None, :] * log_g[:, None]).astype(cdt)
    chunk_decay = jnp.exp(L * log_g).astype(cdt)
    qc = q.reshape(bsz, nc, L, nh, dk)
    kc = k.reshape(bsz, nc, L, nh, dk)
    vc = v.reshape(bsz, nc, L, nh, dv)
    scores = jnp.einsum('bcihd,bcjhd->bchij', qc, kc) * dmat
    inner = jnp.einsum('bchij,bcjhe->bcihe', scores, vc)
    chunk_kv = jnp.einsum('bcjhd,hj,bcjhe->cbhde', kc, zeta, vc)

    def step(state, kv):
        return chunk_decay[None, :, None, None] * state + kv, state

    _, s_in = lax.scan(step, jnp.zeros((bsz, nh, dk, dv), chunk_kv.dtype), chunk_kv)
    cross = jnp.einsum('bcihd,hi,cbhde->bcihe', qc, xi, s_in)
    o = (inner + cross).reshape(bsz, seq, nh, dv).astype(jnp.float32)
    o = o * lax.rsqrt(jnp.mean(o * o, axis=-1, keepdims=True) + NORM_EPS)
    return o.astype(cdt)


def ssd_scan(xh, dt, a, bm, cm):
    bsz, seq, nh, hp = xh.shape
    ng, ns = bm.shape[2], bm.shape[3]
    ne = nh // ng
    L = SSM_CHUNK
    nc = seq // L
    cdt = xh.dtype
    cums = jnp.cumsum((dt * a).reshape(bsz, nc, L, ng, ne), axis=2)
    xdt = (xh * dt[..., None].astype(cdt)).reshape(bsz, nc, L, ng, ne, hp)
    bc = bm.reshape(bsz, nc, L, ng, ns)
    cc = cm.reshape(bsz, nc, L, ng, ns)
    idx = jnp.arange(L)
    causal = (idx[:, None] >= idx[None, :])[:, :, None, None]
    seg = cums[:, :, :, None] - cums[:, :, None, :]
    lmat = jnp.exp(jnp.where(causal, seg, -jnp.inf)).astype(cdt)
    cb = jnp.einsum('bclgn,bcsgn->bclsg', cc, bc)
    y_diag = jnp.einsum('bclsg,bclsge,bcsgep->bclgep', cb, lmat, xdt)
    decay_states = jnp.exp(cums[:, :, -1:] - cums).astype(cdt)
    states = jnp.einsum('bclgn,bclge,bclgep->cbgepn', bc, decay_states, xdt)
    chunk_decay = jnp.exp(cums[:, :, -1]).astype(cdt).transpose(1, 0, 2, 3)

    def step(state, inp):
        dec, st = inp
        return dec[..., None, None] * state + st, state

    _, s_in = lax.scan(step, jnp.zeros((bsz, ng, ne, hp, ns), states.dtype), (chunk_decay, states))
    y_off = jnp.einsum('bclgn,cbgepn,bclge->bclgep', cc, s_in, jnp.exp(cums).astype(cdt))
    return (y_diag + y_off).reshape(bsz, seq, nh, hp)


def even_mixer(h, w_in, w_out, conv_w, conv_b, dt_bias, a_log, d_skip, norm_w):
    bsz, seq, _ = h.shape
    q, k, v, g, z, xbc, dt_raw = split_last(h @ w_in, EVEN_SPLITS)
    o_ret = retention(q.reshape(bsz, seq, RET_HEADS, RET_DK), k.reshape(bsz, seq, RET_HEADS, RET_DK), v.reshape(bsz, seq, RET_HEADS, RET_DV))
    o_ret = jax.nn.silu(g) * o_ret.reshape(bsz, seq, RET_HEADS * RET_DV)
    xbc = lax.conv_general_dilated(xbc, conv_w[:, None, :].astype(xbc.dtype), window_strides=(1,), padding=[(SSM_CONV - 1, 0)], dimension_numbers=('NWC', 'WIO', 'NWC'), feature_group_count=SSM_CONV_DIM)
    xbc = jax.nn.silu(xbc + conv_b)
    xs, bm, cm = split_last(xbc, (SSM_D_INNER, SSM_GROUPS * SSM_D_STATE, SSM_GROUPS * SSM_D_STATE))
    dt = jax.nn.softplus(dt_raw.astype(jnp.float32) + dt_bias.astype(jnp.float32))
    a = -jnp.exp(a_log.astype(jnp.float32))
    xh = xs.reshape(bsz, seq, SSM_HEADS, SSM_HEAD_DIM)
    y = ssd_scan(xh, dt, a, bm.reshape(bsz, seq, SSM_GROUPS, SSM_D_STATE), cm.reshape(bsz, seq, SSM_GROUPS, SSM_D_STATE))
    y = (y + d_skip[:, None] * xh).reshape(bsz, seq, SSM_D_INNER)
    y = rmsnorm(y * jax.nn.silu(z), norm_w)
    return jnp.concatenate([o_ret, y], axis=-1) @ w_out


def banded_attention(q, k, v, window, sinks=None):
    bsz, ng, ne, seq, hd = q.shape
    qb_size = ATTN_BLOCK
    nb = seq // qb_size
    nprev = -(-(window - 1) // qb_size)
    nk = (nprev + 1) * qb_size

    def band(t):
        tb = jnp.pad(t.reshape(bsz, ng, nb, qb_size, hd), ((0, 0), (0, 0), (nprev, 0), (0, 0), (0, 0)))
        return jnp.concatenate([tb[:, :, j:j + nb] for j in range(nprev + 1)], axis=3)

    kb, vb = band(k), band(v)
    blk = jnp.arange(nb)
    qpos = blk[:, None] * qb_size + jnp.arange(qb_size)[None, :]
    kpos = (blk[:, None] - nprev) * qb_size + jnp.arange(nk)[None, :]
    rel = qpos[:, :, None] - kpos[:, None, :]
    mask = (rel >= 0) & (rel < window) & (kpos[:, None, :] >= 0)
    s = jnp.einsum('bgeiqd,bgikd->bgeiqk', q.reshape(bsz, ng, ne, nb, qb_size, hd), kb).astype(jnp.float32) * (hd ** -0.5)
    if sinks is None:
        p = masked_softmax(s, mask)
    else:
        p = sink_softmax(s, mask, sinks.astype(jnp.float32)[None, :, :, None, None, None])
    o = jnp.einsum('bgeiqk,bgikd->bgeiqd', p.astype(v.dtype), vb)
    return o.reshape(bsz, ng, ne, seq, hd)


def selected_block_attention(q, k, v, sel_idx):
    bsz, ng, ne, seq, hd = q.shape
    n = sel_idx.shape[-1]
    qb_size = NSA_SEL_QBLOCK
    nq = seq // qb_size
    kb = k.reshape(bsz, ng, seq // NSA_SEL_BLOCK, NSA_SEL_BLOCK, hd)
    vb = v.reshape(bsz, ng, seq // NSA_SEL_BLOCK, NSA_SEL_BLOCK, hd)
    q_ch = q.reshape(bsz, ng, ne, nq, qb_size, hd).transpose(3, 0, 1, 2, 4, 5)
    idx_ch = sel_idx.reshape(bsz, ng, nq, qb_size, n).transpose(2, 0, 1, 3, 4)
    t_ch = jnp.arange(seq).reshape(nq, qb_size)
    bi = jnp.arange(bsz)[:, None, None, None]
    gi = jnp.arange(ng)[None, :, None, None]
    offs = jnp.arange(NSA_SEL_BLOCK)
    scale = hd ** -0.5

    def body(args):
        qc, ic, tc = args
        kg = kb[bi, gi, ic].reshape(bsz, ng, qb_size, n * NSA_SEL_BLOCK, hd)
        vg = vb[bi, gi, ic].reshape(bsz, ng, qb_size, n * NSA_SEL_BLOCK, hd)
        s = jnp.einsum('bgeqd,bgqmd->bgeqm', qc, kg).astype(jnp.float32) * scale
        kpos = (ic[..., None] * NSA_SEL_BLOCK + offs).reshape(bsz, ng, qb_size, n * NSA_SEL_BLOCK)
        mask = (kpos <= tc[None, None, :, None])[:, :, None]
        p = masked_softmax(s, mask)
        return jnp.einsum('bgeqm,bgqmd->bgeqd', p.astype(vg.dtype), vg)

    o = lax.map(body, (q_ch, idx_ch, t_ch))
    return o.transpose(1, 2, 3, 0, 4, 5).reshape(bsz, ng, ne, seq, hd)


def native_sparse_attention(q, kc, vc, ks, vs, kw, vw, g, cmp_pe, cmp_w1, cmp_w2):
    bsz, ng, ne, seq, hd = q.shape
    scale = hd ** -0.5
    tpos = jnp.arange(seq)
    n_cmp = (seq - NSA_CMP_BLOCK) // NSA_CMP_STRIDE + 1
    starts = jnp.arange(n_cmp) * NSA_CMP_STRIDE
    tok = starts[:, None] + jnp.arange(NSA_CMP_BLOCK)[None, :]

    def compress(t, pe, w1, w2):
        blk = t[:, :, tok] + pe
        return jax.nn.silu(blk.reshape(bsz, ng, n_cmp, NSA_CMP_BLOCK * hd) @ w1) @ w2

    k_cmp = compress(kc, cmp_pe[0], cmp_w1[0], cmp_w2[0])
    v_cmp = compress(vc, cmp_pe[1], cmp_w1[1], cmp_w2[1])
    s_cmp = jnp.einsum('bgeqd,bgnd->bgeqn', q, k_cmp).astype(jnp.float32) * scale
    p_cmp = masked_softmax(s_cmp, (starts + NSA_CMP_BLOCK - 1)[None, :] <= tpos[:, None])
    o_cmp = jnp.einsum('bgeqn,bgnd->bgeqd', p_cmp.astype(vc.dtype), v_cmp)
    n_sel = seq // NSA_SEL_BLOCK
    sel_start = jnp.arange(n_sel) * NSA_SEL_BLOCK
    overlap = ((starts[:, None] < sel_start[None, :] + NSA_SEL_BLOCK) & (starts[:, None] + NSA_CMP_BLOCK > sel_start[None, :])).astype(jnp.float32)
    imp = jnp.einsum('bgqn,nj->bgqj', jnp.sum(p_cmp, axis=2), overlap)
    cur = (tpos // NSA_SEL_BLOCK)[:, None]
    jb = jnp.arange(n_sel)[None, :]
    valid = jb <= cur
    forced = valid & ((jb == 0) | (jb == cur) | (jb == cur - 1))
    score = jnp.where(forced, NSA_FORCE_SCORE, jnp.where(valid, imp, -jnp.inf))
    _, sel_idx = lax.top_k(score, min(NSA_TOPN, n_sel))
    o_sel = selected_block_attention(q, ks, vs, sel_idx)
    o_win = banded_attention(q, kw, vw, NSA_WINDOW)
    return g[..., 0:1] * o_cmp + g[..., 1:2] * o_sel + g[..., 2:3] * o_win


def odd_mixer(h, w_in, w_out, cmp_pe, cmp_w1, cmp_w2, sinks):
    bsz, seq, _ = h.shape
    q_n, kc, vc, ks, vs, kw, vw, gates, q_s, k_s, v_s = split_last(h @ w_in, ODD_SPLITS)

    def q_heads(t, nh, nkv, hd):
        return t.reshape(bsz, seq, nkv, nh // nkv, hd).transpose(0, 2, 3, 1, 4)

    def kv_heads(t, nkv, hd):
        return t.reshape(bsz, seq, nkv, hd).transpose(0, 2, 1, 3)

    def merge(o):
        return o.transpose(0, 3, 1, 2, 4).reshape(bsz, seq, -1)

    g = jax.nn.sigmoid(gates.astype(jnp.float32)).astype(h.dtype)
    g = g.reshape(bsz, seq, NSA_KV_HEADS, NSA_HEADS // NSA_KV_HEADS, 3).transpose(0, 2, 3, 1, 4)
    o_nsa = native_sparse_attention(
        q_heads(q_n, NSA_HEADS, NSA_KV_HEADS, NSA_HEAD_DIM),
        kv_heads(kc, NSA_KV_HEADS, NSA_HEAD_DIM), kv_heads(vc, NSA_KV_HEADS, NSA_HEAD_DIM),
        kv_heads(ks, NSA_KV_HEADS, NSA_HEAD_DIM), kv_heads(vs, NSA_KV_HEADS, NSA_HEAD_DIM),
        kv_heads(kw, NSA_KV_HEADS, NSA_HEAD_DIM), kv_heads(vw, NSA_KV_HEADS, NSA_HEAD_DIM),
        g, cmp_pe, cmp_w1, cmp_w2)
    o_swa = banded_attention(
        q_heads(q_s, SWA_HEADS, SWA_KV_HEADS, SWA_HEAD_DIM),
        kv_heads(k_s, SWA_KV_HEADS, SWA_HEAD_DIM), kv_heads(v_s, SWA_KV_HEADS, SWA_HEAD_DIM),
        SWA_WINDOW, sinks.reshape(SWA_KV_HEADS, SWA_HEADS // SWA_KV_HEADS))
    return jnp.concatenate([merge(o_nsa), merge(o_swa)], axis=-1) @ w_out


def cross_attention(h, memn, wq, wkv, wo):
    bsz, seq, _ = h.shape
    m = memn.shape[1]
    q = (h @ wq).reshape(bsz, seq, XATTN_HEADS, XATTN_HEAD_DIM)
    kv = (memn @ wkv).reshape(bsz, m, 2, XATTN_HEADS, XATTN_HEAD_DIM)
    s = jnp.einsum('bshd,bmhd->bhsm', q, kv[:, :, 0]).astype(jnp.float32) * (XATTN_HEAD_DIM ** -0.5)
    p = jax.nn.softmax(s, axis=-1).astype(h.dtype)
    o = jnp.einsum('bhsm,bmhd->bshd', p, kv[:, :, 1]).reshape(bsz, seq, XATTN_HEADS * XATTN_HEAD_DIM)
    return o @ wo


def setup_inputs(seed: int = 0) -> dict:
    key = jax.random.key(seed)
    keys = jax.random.split(key, 32)
    f32 = jnp.float32

    def nrm(k, shape, scale):
        return jax.random.normal(k, shape, f32) * scale

    dt0 = jnp.exp(jax.random.uniform(keys[16], (N_EVEN, SSM_HEADS), f32, float(np.log(1e-3)), float(np.log(1e-1))))
    return {
        'x': nrm(keys[0], (BATCH, SEQ, D_MODEL), 1.0),
        'mem': nrm(keys[1], (BATCH, MEM_LEN, D_MODEL), 1.0),
        'norm_w': 1.0 + nrm(keys[2], (DEPTH, 4, D_MODEL), 0.02),
        'final_norm_w': 1.0 + nrm(keys[3], (D_MODEL,), 0.02),
        'mem_norm_w': 1.0 + nrm(keys[4], (D_MODEL,), 0.02),
        'ffn_w_gate': nrm(keys[5], (DEPTH, 2, D_MODEL, D_FF), D_MODEL ** -0.5),
        'ffn_w_up': nrm(keys[6], (DEPTH, 2, D_MODEL, D_FF), D_MODEL ** -0.5),
        'ffn_w_down': nrm(keys[7], (DEPTH, 2, D_FF, D_MODEL), D_FF ** -0.5),
        'xattn_wq': nrm(keys[8], (DEPTH, D_MODEL, XATTN_HEADS * XATTN_HEAD_DIM), D_MODEL ** -0.5),
        'xattn_wkv': nrm(keys[9], (DEPTH, D_MODEL, 2 * XATTN_HEADS * XATTN_HEAD_DIM), D_MODEL ** -0.5),
        'xattn_wo': nrm(keys[10], (DEPTH, XATTN_HEADS * XATTN_HEAD_DIM, D_MODEL), (XATTN_HEADS * XATTN_HEAD_DIM) ** -0.5),
        'even_w_in': nrm(keys[11], (N_EVEN, D_MODEL, EVEN_IN), D_MODEL ** -0.5),
        'even_w_out': nrm(keys[12], (N_EVEN, EVEN_MIX, D_MODEL), EVEN_MIX ** -0.5),
        'ssm_conv_w': nrm(keys[13], (N_EVEN, SSM_CONV, SSM_CONV_DIM), SSM_CONV ** -0.5),
        'ssm_conv_b': nrm(keys[14], (N_EVEN, SSM_CONV_DIM), 0.01),
        'ssm_dt_bias': dt0 + jnp.log(-jnp.expm1(-dt0)),
        'ssm_a_log': jnp.log(jax.random.uniform(keys[17], (N_EVEN, SSM_HEADS), f32, 1.0, 16.0)),
        'ssm_d': 1.0 + nrm(keys[18], (N_EVEN, SSM_HEADS), 0.02),
        'ssm_norm_w': 1.0 + nrm(keys[19], (N_EVEN, SSM_D_INNER), 0.02),
        'odd_w_in': nrm(keys[20], (N_ODD, D_MODEL, ODD_IN), D_MODEL ** -0.5),
        'odd_w_out': nrm(keys[21], (N_ODD, ODD_MIX, D_MODEL), ODD_MIX ** -0.5),
        'nsa_cmp_pe': nrm(keys[22], (N_ODD, 2, NSA_CMP_BLOCK, NSA_HEAD_DIM), 0.02),
        'nsa_cmp_w1': nrm(keys[23], (N_ODD, 2, NSA_CMP_BLOCK * NSA_HEAD_DIM, NSA_CMP_HIDDEN), (NSA_CMP_BLOCK * NSA_HEAD_DIM) ** -0.5),
        'nsa_cmp_w2': nrm(keys[24], (N_ODD, 2, NSA_CMP_HIDDEN, NSA_HEAD_DIM), NSA_CMP_HIDDEN ** -0.5),
        'swa_sinks': nrm(keys[25], (N_ODD, SWA_HEADS), 0.5),
    }


def reference(x, mem, norm_w, final_norm_w, mem_norm_w, ffn_w_gate, ffn_w_up, ffn_w_down, xattn_wq, xattn_wkv, xattn_wo, even_w_in, even_w_out, ssm_conv_w, ssm_conv_b, ssm_dt_bias, ssm_a_log, ssm_d, ssm_norm_w, odd_w_in, odd_w_out, nsa_cmp_pe, nsa_cmp_w1, nsa_cmp_w2, swa_sinks):
    memn = rmsnorm(mem, mem_norm_w)
    for layer in range(DEPTH):
        i = layer // 2
        h = rmsnorm(x, norm_w[layer, 0])
        x = x + 0.5 * swiglu(h, ffn_w_gate[layer, 0], ffn_w_up[layer, 0], ffn_w_down[layer, 0])
        h = rmsnorm(x, norm_w[layer, 1])
        if layer % 2 == 0:
            x = x + even_mixer(h, even_w_in[i], even_w_out[i], ssm_conv_w[i], ssm_conv_b[i], ssm_dt_bias[i], ssm_a_log[i], ssm_d[i], ssm_norm_w[i])
        else:
            x = x + odd_mixer(h, odd_w_in[i], odd_w_out[i], nsa_cmp_pe[i], nsa_cmp_w1[i], nsa_cmp_w2[i], swa_sinks[i])
        h = rmsnorm(x, norm_w[layer, 2])
        x = x + cross_attention(h, memn, xattn_wq[layer], xattn_wkv[layer], xattn_wo[layer])
        h = rmsnorm(x, norm_w[layer, 3])
        x = x + 0.5 * swiglu(h, ffn_w_gate[layer, 1], ffn_w_up[layer, 1], ffn_w_down[layer, 1])
    return rmsnorm(x, final_norm_w)
```

```cpp
#include <hip/hip_runtime.h>
#include <cstdio>
#include <cstdint>

#define DI __device__ __forceinline__
#define LAS __attribute__((address_space(3)))
#define GAS __attribute__((address_space(1)))
typedef unsigned short bf16_t;
typedef short bf16x8 __attribute__((ext_vector_type(8)));
typedef float f32x4 __attribute__((ext_vector_type(4)));
typedef float f32x2 __attribute__((ext_vector_type(2)));
typedef unsigned u32x4 __attribute__((ext_vector_type(4)));
typedef unsigned u32x2 __attribute__((ext_vector_type(2)));
typedef __bf16 bf16x2_t __attribute__((ext_vector_type(2)));

constexpr int DM = 1024, NB = 4, SEQ = 4096, MTOK = NB * SEQ, DEPTH = 4, FF = 2816, MEMLEN = 256;
constexpr int EV_IN = 3336, EV_PITCH = 3584;
constexpr int OD_IN = 2072, OD_PITCH = 1792;
constexpr float EPS = 1e-6f;
constexpr float LOG2E = 1.4426950408889634f;

constexpr size_t MiB = 1u << 20;
constexpr size_t WS_CTL = 0, CTL_ZERO_BYTES = 1 * MiB;
constexpr size_t WS_COS = 1 * MiB, WS_SIN = 2 * MiB;
constexpr size_t WS_MEMN = 3 * MiB;
constexpr size_t WS_KX = 5 * MiB, WS_VTX = 7 * MiB;
constexpr size_t WS_BIAS1 = 9 * MiB;
constexpr size_t WS_W = 10 * MiB;
constexpr size_t W_GU = 0, W_D = 22 * MiB, W_XQ = 33 * MiB, W_XKV = 35 * MiB, W_XO = 39 * MiB, W_IN = 41 * MiB, W_OUT = 48 * MiB, W_C1 = 50 * MiB, W_C2 = 52 * MiB;
constexpr size_t WS_X = 64 * MiB;
constexpr size_t WS_H = 128 * MiB;
constexpr size_t WS_R = 160 * MiB;
constexpr size_t R_HID = 0;
constexpr size_t R_Q = 0;
constexpr size_t R_PROJ = 0;
constexpr size_t R_CONV = 112 * MiB, R_XDT = 136 * MiB, R_STR = 152 * MiB, R_STS = 184 * MiB, R_SINR = 200 * MiB, R_SINS = 216 * MiB, R_YP = 224 * MiB, R_CUMS = 240 * MiB;
constexpr size_t R_VT = 56 * MiB, R_HIDC = 72 * MiB, R_KC = 74 * MiB, R_VCT = 75 * MiB;
constexpr size_t WS_END = 160 * MiB + 242 * MiB;

constexpr int LDS_BYTES = 147456;
constexpr int LDSCTL_OFF = 147456 - 512;

DI unsigned pk2(float lo, float hi) { f32x2 v = {lo, hi}; bf16x2_t b = __builtin_convertvector(v, bf16x2_t); return __builtin_bit_cast(unsigned, b); }
DI bf16_t f2bf(float f) { return (bf16_t)(pk2(f, 0.f) & 0xffffu); }
DI float bf2f(unsigned h) { return __uint_as_float((h & 0xffffu) << 16); }
DI float bflo(unsigned w) { return __uint_as_float(w << 16); }
DI float bfhi(unsigned w) { return __uint_as_float(w & 0xffff0000u); }
DI float silu_f(float x) { return x * __builtin_amdgcn_rcpf(1.f + __builtin_amdgcn_exp2f(-LOG2E * x)); }
DI float sigmoid_f(float x) { return __builtin_amdgcn_rcpf(1.f + __builtin_amdgcn_exp2f(-LOG2E * x)); }
DI float ex2(float x) { return __builtin_amdgcn_exp2f(x); }
DI f32x4 mfma16(bf16x8 a, bf16x8 b, f32x4 c) { return __builtin_amdgcn_mfma_f32_16x16x32_bf16(a, b, c, 0, 0, 0); }
DI float wave_sum(float v) {
#pragma unroll
    for (int o = 1; o < 64; o <<= 1) v += __shfl_xor(v, o);
    return v;
}
DI float grp16_sum(float v) { v += __shfl_xor(v, 1); v += __shfl_xor(v, 2); v += __shfl_xor(v, 4); v += __shfl_xor(v, 8); return v; }
DI float grp16_max(float v) { v = fmaxf(v, __shfl_xor(v, 1)); v = fmaxf(v, __shfl_xor(v, 2)); v = fmaxf(v, __shfl_xor(v, 4)); v = fmaxf(v, __shfl_xor(v, 8)); return v; }
#define LDS_WAIT() asm volatile("s_waitcnt lgkmcnt(0)" ::: "memory")
#define VM_WAIT() asm volatile("s_waitcnt vmcnt(0)" ::: "memory")

#define XB_TMO      128
#define XB_XCNT(j)  (256  + 64 * (j))
#define XB_XSUB(j)  (1280 + 64 * (j))
#define XB_XGEN(j)  (2304 + 64 * (j))
#define XB_TOP      3328
#define XB_TOPGEN   3392
#define XCD_BAR_WORDS 3456
#define XB_SPIN_CAP (1u << 18)
DI unsigned xb_ld(unsigned* p)              { return __hip_atomic_load(p, __ATOMIC_RELAXED, __HIP_MEMORY_SCOPE_AGENT); }
DI unsigned xb_add(unsigned* p, unsigned v) { return __hip_atomic_fetch_add(p, v, __ATOMIC_RELAXED, __HIP_MEMORY_SCOPE_AGENT); }
DI unsigned xb_xcc_id() { return (unsigned)__builtin_amdgcn_s_getreg((3 << 11) | 20) & 0xFu; }
#define XB_SPIN(cond, bar) do { unsigned _sp = 0; while (cond) { __builtin_amdgcn_s_sleep(1); \
    if ((++_sp & 255u) == 0u) { if (xb_ld(&(bar)[XB_TMO])) break; if (_sp > XB_SPIN_CAP) { atomicAdd(&(bar)[XB_TMO], 1u); break; } } } } while (0)
struct XcdBarrier { unsigned* bar; unsigned x; volatile LAS unsigned* st; };
DI XcdBarrier xcd_barrier_post(unsigned* bar, volatile LAS unsigned* st) {
    XcdBarrier b; b.bar = bar; b.x = xb_xcc_id(); b.st = st;
    if (threadIdx.x == 0) (void)xb_add(&bar[XB_XCNT(b.x)], 1u);
    return b;
}
DI void xcd_barrier_complete(unsigned* bar, unsigned x, unsigned& nloc, unsigned& nx) {
    const unsigned G = gridDim.x * gridDim.y * gridDim.z;
    unsigned sum, cnt, mine, sp = 0u;
    for (;;) {
        sum = 0u; cnt = 0u; mine = 0u;
#pragma unroll
        for (unsigned j = 0; j < 16; ++j) { const unsigned c = xb_ld(&bar[XB_XCNT(j)]); sum += c; cnt += (c > 0u) ? 1u : 0u; mine = (j == x) ? c : mine; }
        if (sum == G) break;
        __builtin_amdgcn_s_sleep(1);
        if ((++sp & 255u) == 0u) { if (xb_ld(&bar[XB_TMO])) break; if (sp > XB_SPIN_CAP) { atomicAdd(&bar[XB_TMO], 1u); break; } }
    }
    nloc = mine > 0u ? mine : 1u; nx = cnt > 0u ? cnt : 1u;
}
DI void xcd_barrier(const XcdBarrier& b) {
    asm volatile("s_waitcnt vmcnt(0)" ::: "memory");
    __syncthreads();
    if (threadIdx.x == 0) {
        unsigned* bar = b.bar;
        __builtin_amdgcn_s_waitcnt(0);
        unsigned nloc = b.st[0], nx = b.st[1];
        if (nloc == 0u) { xcd_barrier_complete(bar, b.x, nloc, nx); b.st[0] = nloc; b.st[1] = nx; }
        const unsigned old = xb_add(&bar[XB_XSUB(b.x)], 1u);
        const unsigned gen = old / nloc;
        if (old + 1u == (gen + 1u) * nloc) {
            __builtin_amdgcn_fence(__ATOMIC_RELEASE, "agent");
            asm volatile("s_waitcnt vmcnt(0)" ::: "memory");
            const unsigned og = xb_add(&bar[XB_TOP], 1u);
            const unsigned tg = og / nx;
            if (og + 1u == (tg + 1u) * nx) xb_add(&bar[XB_TOPGEN], 1u);
            else XB_SPIN(xb_ld(&bar[XB_TOPGEN]) == tg, bar);
            __builtin_amdgcn_fence(__ATOMIC_ACQUIRE, "agent");
            xb_add(&bar[XB_XGEN(b.x)], 1u);
            asm volatile("s_waitcnt vmcnt(0)" ::: "memory");
        } else {
            XB_SPIN(xb_ld(&bar[XB_XGEN(b.x)]) == gen, bar);
            __builtin_amdgcn_fence(__ATOMIC_ACQUIRE, "agent");
            asm volatile("s_waitcnt vmcnt(0)" ::: "memory");
        }
    }
    __syncthreads();
}

namespace pg8 {
constexpr int BM = 256, BK = 64, HALF = 128, HTB = HALF * BK * 2, STAGE_BYTES = 8 * HTB, NXCD = 8, WGM = 8;
__host__ __device__ __forceinline__ int lds_byte(int r, int c) { const int st = (r >> 4) * 2 + (c >> 5), rr = r & 15, cc = c & 31, ob = rr * 64 + cc * 2; return st * 1024 + (ob ^ (((ob >> 9) & 1) << 5)); }
__host__ __device__ __forceinline__ void stage_rc(int b, int& R, int& C) { const int st = b / 1024, sb = b % 1024, swz = sb ^ (((sb >> 9) & 1) << 5); R = (st >> 1) * 16 + swz / 64; C = (st & 1) * 32 + (swz % 64) / 2; }
__host__ __device__ __forceinline__ int perm32(int rho) { const int n = rho >> 4, i = rho & 15; return 8 * (i >> 2) + 4 * n + (i & 3); }

struct Unit { int pm, pn; const char* a; const char* b; };
struct Gemm { const bf16_t* A; const bf16_t* Bt; int lda, ldb, kstepA, kstepB, K; };

struct StaticOrder {
    int nM, nN, nwg, G, c; const char* A; const char* B; size_t tA, tB;
    DI void init(const Gemm& g, int M, int N, int G_, int c_) { nM = M / BM; nN = N / BM; nwg = nM * nN; G = G_; c = c_; A = (const char*)g.A; B = (const char*)g.Bt; tA = (size_t)BM * g.lda * 2; tB = (size_t)BM * g.ldb * 2; }
    DI bool next(int i, Unit& u) const {
        const int L = i * G + c; if (L >= nwg) return false;
        int wgid = L; { const int q = nwg / NXCD, r = nwg % NXCD, xcd = wgid % NXCD, off = wgid / NXCD; wgid = (xcd < r ? xcd * (q + 1) : r * (q + 1) + (xcd - r) * q) + off; }
        const int nig = WGM * nN, gid = wgid / nig, fm = gid * WGM, gsz = (nM - fm) < WGM ? (nM - fm) : WGM;
        u.pm = fm + ((wgid % nig) % gsz); u.pn = (wgid % nig) / gsz; u.a = A + (size_t)u.pm * tA; u.b = B + (size_t)u.pn * tB; return true;
    }
};

DI unsigned cvt_pk_bf16(float lo, float hi) { return pk2(lo, hi); }

template <int ACT> struct EpiBf16 {
    static constexpr bool PERM = true;
    bf16_t* O; int ldc; const float* bias; int cmp_mode;
    DI void operator()(const f32x4 (&acc)[2][2][4][2], const Unit& u, int wr, int wc, int fr, int fq) const {
        const int rt = cmp_mode ? (u.pn * 8 + u.pm) : u.pm, ct = cmp_mode ? 0 : u.pn;
        const int row0 = rt * BM + wr * 64 + fr; const int col0 = ct * BM + wc * 32 + 8 * fq;
        f32x4 bv[2][2];
#pragma unroll
        for (int bj = 0; bj < 2; ++bj)
#pragma unroll
            for (int n = 0; n < 2; ++n) bv[bj][n] = bias ? *(const f32x4*)(bias + u.pn * BM + (wc * 32 + 8 * fq) + bj * HALF + 4 * n) : (f32x4){0.f, 0.f, 0.f, 0.f};
#pragma unroll
        for (int ai = 0; ai < 2; ++ai)
#pragma unroll
            for (int m = 0; m < 4; ++m) { bf16_t* rowp = O + (size_t)(row0 + ai * HALF + m * 16) * ldc + col0;
#pragma unroll
                for (int bj = 0; bj < 2; ++bj) { f32x4 v0 = acc[ai][bj][m][0] + bv[bj][0], v1 = acc[ai][bj][m][1] + bv[bj][1];
                    if (ACT == 2) { v0 = (f32x4){silu_f(v0[0]), silu_f(v0[1]), silu_f(v0[2]), silu_f(v0[3])}; v1 = (f32x4){silu_f(v1[0]), silu_f(v1[1]), silu_f(v1[2]), silu_f(v1[3])}; }
                    u32x4 w; w.x = cvt_pk_bf16(v0[0], v0[1]); w.y = cvt_pk_bf16(v0[2], v0[3]); w.z = cvt_pk_bf16(v1[0], v1[1]); w.w = cvt_pk_bf16(v1[2], v1[3]);
                    *(u32x4*)(rowp + bj * HALF) = w; } }
    }
};
struct EpiSwiGLU {
    static constexpr bool PERM = true;
    bf16_t* O; int ldc;
    DI void operator()(const f32x4 (&acc)[2][2][4][2], const Unit& u, int wr, int wc, int fr, int fq) const {
        const int row0 = u.pm * BM + wr * 64 + fr; const int col0 = u.pn * HALF + wc * 32 + 8 * fq;
#pragma unroll
        for (int ai = 0; ai < 2; ++ai)
#pragma unroll
            for (int m = 0; m < 4; ++m) { bf16_t* rowp = O + (size_t)(row0 + ai * HALF + m * 16) * ldc + col0;
                const f32x4 g0 = acc[ai][0][m][0], g1 = acc[ai][0][m][1], u0 = acc[ai][1][m][0], u1 = acc[ai][1][m][1];
                u32x4 w; w.x = cvt_pk_bf16(silu_f(g0[0]) * u0[0], silu_f(g0[1]) * u0[1]); w.y = cvt_pk_bf16(silu_f(g0[2]) * u0[2], silu_f(g0[3]) * u0[3]);
                w.z = cvt_pk_bf16(silu_f(g1[0]) * u1[0], silu_f(g1[1]) * u1[1]); w.w = cvt_pk_bf16(silu_f(g1[2]) * u1[2], silu_f(g1[3]) * u1[3]);
                *(u32x4*)rowp = w; }
    }
};
struct EpiResid {
    static constexpr bool PERM = false;
    const float* base; float* out; float scale;
    DI void operator()(const f32x4 (&acc)[2][2][4][2], const Unit& u, int wr, int wc, int fr, int fq) const {
        const int col0 = u.pn * BM + wc * 32 + 4 * fq;
#pragma unroll
        for (int ai = 0; ai < 2; ++ai)
#pragma unroll
            for (int m = 0; m < 4; ++m) { const size_t off = (size_t)(u.pm * BM + ai * HALF + wr * 64 + m * 16 + fr) * DM + col0;
#pragma unroll
                for (int bj = 0; bj < 2; ++bj)
#pragma unroll
                    for (int n = 0; n < 2; ++n) { const f32x4 bs = *(const f32x4*)(base + off + bj * HALF + n * 16); *(f32x4*)(out + off + bj * HALF + n * 16) = bs + acc[ai][bj][m][n] * scale; } }
    }
};

template <class Epi, class Sched>
DI void gemm_phase(LAS unsigned char* lds, const Gemm g, const Sched& S, const Epi& E, const int tid) {
    const int wid = __builtin_amdgcn_readfirstlane(tid >> 6), lane = tid & 63, wr = wid >> 2, wc = wid & 3, fr = lane & 15, fq = lane >> 4;
    const int K = g.K, nt = K / BK;
    unsigned voffA[2], voffB[2];
#pragma unroll
    for (int i = 0; i < 2; ++i) { int R, C; stage_rc(tid * 16 + i * 8192, R, C); const int Rb = Epi::PERM ? ((R & ~31) + perm32(R & 31)) : R;
        voffA[i] = (unsigned)(R * g.lda + C) * 2u; voffB[i] = (unsigned)(Rb * g.ldb + C) * 2u; }
    const size_t kA = (size_t)g.kstepA, kB = (size_t)g.kstepB;
    const size_t hA = (size_t)HALF * g.lda * 2, hB = (size_t)HALF * g.ldb * 2;
    const unsigned ldsw = (unsigned)wid * 1024u;
    const int aoff = lds_byte(wr * 64 + fr, fq * 8), boff = lds_byte(wc * 32 + fr, fq * 8);
#define PG8_SA(b, h) (((b) * 2 + (h)) * HTB)
#define PG8_SB(b, h) ((4 + (b) * 2 + (h)) * HTB)
#define PG8_STAGE(bufoff, gbase, voff) do { _Pragma("unroll") for (int _i = 0; _i < 2; ++_i) \
        __builtin_amdgcn_global_load_lds((const unsigned*)((const char*)(gbase) + (voff)[_i]), (LAS unsigned*)(lds + (bufoff) + ldsw + _i * 8192), 16, 0, 0); } while (0)
#define PG8_LDA(dst, b, h) do { _Pragma("unroll") for (int m = 0; m < 4; ++m) _Pragma("unroll") for (int k = 0; k < 2; ++k) dst[m][k] = *(const LAS bf16x8*)(lds + PG8_SA(b, h) + aoff + m * 2048 + k * 1024); } while (0)
#define PG8_LDB(dst, b, h) do { _Pragma("unroll") for (int n = 0; n < 2; ++n) _Pragma("unroll") for (int k = 0; k < 2; ++k) dst[n][k] = *(const LAS bf16x8*)(lds + PG8_SB(b, h) + boff + n * 2048 + k * 1024); } while (0)
#define PG8_MMA(ai, bj, At, Bt) do { __builtin_amdgcn_s_setprio(1); _Pragma("unroll") for (int m = 0; m < 4; ++m) _Pragma("unroll") for (int n = 0; n < 2; ++n) _Pragma("unroll") for (int k = 0; k < 2; ++k) \
        acc[ai][bj][m][n] = __builtin_amdgcn_mfma_f32_16x16x32_bf16(Bt[n][k], At[m][k], acc[ai][bj][m][n], 0, 0, 0); __builtin_amdgcn_s_setprio(0); } while (0)
#define PG8_WAIT_V(n) asm volatile("s_waitcnt vmcnt(" #n ")" ::: "memory")
#define PG8_WAIT_L(n) asm volatile("s_waitcnt lgkmcnt(" #n ")" ::: "memory")
#define PG8_BAR __builtin_amdgcn_s_barrier()
#define PG8_SCHED __builtin_amdgcn_sched_barrier(0)
    Unit cur, nxt; int ui = 0;
    if (!S.next(0, cur)) return;
    f32x4 acc[2][2][4][2];
#pragma unroll
    for (int a = 0; a < 2; ++a)
#pragma unroll
        for (int b = 0; b < 2; ++b)
#pragma unroll
            for (int m = 0; m < 4; ++m)
#pragma unroll
                for (int n = 0; n < 2; ++n) acc[a][b][m][n] = (f32x4){0.f, 0.f, 0.f, 0.f};
    bf16x8 At[4][2], B0[2][2], B1[2][2];
    const char* cA = cur.a; const char* cB = cur.b;
    PG8_STAGE(PG8_SB(0, 0), cB, voffB); PG8_STAGE(PG8_SB(0, 1), cB + hB, voffB); PG8_STAGE(PG8_SA(0, 0), cA, voffA); PG8_STAGE(PG8_SA(0, 1), cA + hA, voffA);
    if (wr == 1) PG8_BAR;
    PG8_WAIT_V(2); PG8_BAR;
    PG8_STAGE(PG8_SB(1, 0), cB + kB, voffB); PG8_STAGE(PG8_SA(1, 0), cA + kA, voffA); PG8_STAGE(PG8_SB(1, 1), cB + hB + kB, voffB);
    PG8_WAIT_V(6); PG8_BAR;
    for (;;) {
        const bool has_next = S.next(ui + 1, nxt);
        const char* nA = has_next ? nxt.a : cA; const char* nB = has_next ? nxt.b : cB;
        for (int t = 0; t < nt; t += 2) {
            const bool last = (t == nt - 2);
            const char* a1 = cA + (size_t)(t + 1) * kA;
            const char* a2 = last ? nA : cA + (size_t)(t + 2) * kA; const char* b2 = last ? nB : cB + (size_t)(t + 2) * kB;
            const char* a3 = a2 + kA; const char* b3 = b2 + kB;
            PG8_LDB(B0, 0, 0); PG8_LDB(B1, 0, 1); PG8_SCHED; PG8_LDA(At, 0, 0); PG8_STAGE(PG8_SA(1, 1), a1 + hA, voffA);
            PG8_WAIT_V(8); PG8_WAIT_L(0); PG8_BAR; PG8_MMA(0, 0, At, B0); PG8_MMA(0, 1, At, B1); PG8_BAR; PG8_SCHED;
            PG8_LDA(At, 0, 1); PG8_STAGE(PG8_SB(0, 0), b2, voffB); PG8_STAGE(PG8_SB(0, 1), b2 + hB, voffB); PG8_STAGE(PG8_SA(0, 0), a2, voffA);
            PG8_WAIT_V(8); PG8_WAIT_L(0); PG8_BAR; PG8_MMA(1, 0, At, B0); PG8_MMA(1, 1, At, B1); PG8_BAR; PG8_SCHED;
            PG8_LDB(B0, 1, 0); PG8_LDB(B1, 1, 1); PG8_SCHED; PG8_LDA(At, 1, 0); PG8_STAGE(PG8_SA(0, 1), a2 + hA, voffA);
            PG8_WAIT_V(8); PG8_WAIT_L(0); PG8_BAR; PG8_MMA(0, 0, At, B0); PG8_MMA(0, 1, At, B1); PG8_BAR; PG8_SCHED;
            PG8_LDA(At, 1, 1); PG8_STAGE(PG8_SB(1, 0), b3, voffB); PG8_STAGE(PG8_SB(1, 1), b3 + hB, voffB); PG8_STAGE(PG8_SA(1, 0), a3, voffA);
            PG8_WAIT_V(8); PG8_WAIT_L(0); PG8_BAR; PG8_MMA(1, 0, At, B0); PG8_MMA(1, 1, At, B1); PG8_BAR; PG8_SCHED;
        }
        if (wr == 0) PG8_BAR;
        E(acc, cur, wr, wc, fr, fq);
        if (!has_next) break;
#pragma unroll
        for (int a = 0; a < 2; ++a)
#pragma unroll
            for (int b = 0; b < 2; ++b)
#pragma unroll
                for (int m = 0; m < 4; ++m)
#pragma unroll
                    for (int n = 0; n < 2; ++n) acc[a][b][m][n] = (f32x4){0.f, 0.f, 0.f, 0.f};
        cur = nxt; cA = nA; cB = nB; ++ui;
        if (wr == 1) PG8_BAR;
    }
    PG8_WAIT_V(0);
    PG8_BAR;
#undef PG8_SA
#undef PG8_SB
#undef PG8_STAGE
#undef PG8_LDA
#undef PG8_LDB
#undef PG8_MMA
#undef PG8_WAIT_V
#undef PG8_WAIT_L
#undef PG8_BAR
#undef PG8_SCHED
}
}

struct Args { const float* in[25]; float* out; unsigned char* ws; int ph_lo, ph_hi; };
struct KArgs { const float* in[25]; float* out; unsigned char* ws; int ph_lo, ph_hi, li, pad; };
typedef const KArgs __attribute__((address_space(4)))* KP;
enum { I_X = 0, I_MEM, I_NORMW, I_FNORMW, I_MNORMW, I_WG, I_WU, I_WD, I_XWQ, I_XWKV, I_XWO, I_EWIN, I_EWOUT, I_CONVW, I_CONVB, I_DTB, I_ALOG, I_SSMD, I_SSMNW, I_OWIN, I_OWOUT, I_CPE, I_CW1, I_CW2, I_SINKS };


__device__ const float INVF[64] = {1.000000000e+00f, 8.639885187e-01f, 7.464760542e-01f, 6.449466944e-01f, 5.572264791e-01f, 4.814372659e-01f, 4.159561992e-01f, 3.593813777e-01f, 3.105013072e-01f, 2.682695687e-01f, 2.317818254e-01f, 2.002568096e-01f, 1.730195731e-01f, 1.494869143e-01f, 1.291549653e-01f, 1.115884036e-01f, 9.641107917e-02f, 8.329805732e-02f, 7.196855545e-02f, 6.218000501e-02f, 5.372281000e-02f, 4.641588405e-02f, 4.010278732e-02f, 3.464834765e-02f, 2.993576974e-02f, 2.586415969e-02f, 2.234633639e-02f, 1.930697635e-02f, 1.668100618e-02f, 1.441219542e-02f, 1.245197095e-02f, 1.075835899e-02f, 9.295095690e-03f, 8.030855097e-03f, 6.938566454e-03f, 5.994840525e-03f, 5.179473199e-03f, 4.475005437e-03f, 3.866353072e-03f, 3.340484342e-03f, 2.886139555e-03f, 2.493591513e-03f, 2.154434333e-03f, 1.861406374e-03f, 1.608233666e-03f, 1.389495214e-03f, 1.200507861e-03f, 1.037224894e-03f, 8.961504791e-04f, 7.742635789e-04f, 6.689548027e-04f, 5.779692437e-04f, 4.993587499e-04f, 4.314401885e-04f, 3.727593285e-04f, 3.220597573e-04f, 2.782559313e-04f, 2.404098923e-04f, 2.077113895e-04f, 1.794602285e-04f, 1.550515735e-04f, 1.339627634e-04f, 1.157422957e-04f, 9.999999747e-05f};
DI void sincos_acc(float x, float& s, float& c) {
    const float kf = __builtin_rintf(x * 0.636619772367581343f); const int k = (int)kf;
    float r = __builtin_fmaf(-kf, 1.57079637050628662109375f, x); r = __builtin_fmaf(-kf, -4.37113900018624283e-8f, r);
    const float r2 = r * r;
    const float sp = r + r * r2 * (-1.0f / 6.0f + r2 * (1.0f / 120.0f + r2 * (-1.0f / 5040.0f + r2 * (1.0f / 362880.0f))));
    const float cp = 1.0f + r2 * (-0.5f + r2 * (1.0f / 24.0f + r2 * (-1.0f / 720.0f + r2 * (1.0f / 40320.0f + r2 * (-1.0f / 3628800.0f)))));
    const int q = k & 3;
    s = (q == 0) ? sp : (q == 1) ? cp : (q == 2) ? -sp : -cp;
    c = (q == 0) ? cp : (q == 1) ? -sp : (q == 2) ? -cp : sp;
}

#define JNO (1 << 20)
constexpr int NJ_EVEN = 11, NJ_ODD = 25;
__device__ const int JT_EVEN[NJ_EVEN][12] = {
    {I_WG, 2 * DM * FF, 0, 0, FF, DM, 0, FF, (int)W_GU, 128, 256, 0}, {I_WU, 2 * DM * FF, 0, 0, FF, DM, 0, FF, (int)W_GU, 128, 256, 128}, {I_WD, 2 * DM * FF, 0, 0, DM, FF, 0, DM, (int)W_D, JNO, 0, 0},
    {I_WG, 2 * DM * FF, 0, DM * FF, FF, DM, 0, FF, (int)(W_GU + 4 * FF * DM), 128, 256, 0}, {I_WU, 2 * DM * FF, 0, DM * FF, FF, DM, 0, FF, (int)(W_GU + 4 * FF * DM), 128, 256, 128}, {I_WD, 2 * DM * FF, 0, DM * FF, DM, FF, 0, DM, (int)(W_D + 2 * DM * FF), JNO, 0, 0},
    {I_XWQ, DM * DM, 0, 0, DM, DM, 0, DM, (int)W_XQ, JNO, 0, 0}, {I_XWKV, 2 * DM * DM, 0, 0, 2 * DM, DM, 0, 2 * DM, (int)W_XKV, JNO, 0, 0}, {I_XWO, DM * DM, 0, 0, DM, DM, 0, DM, (int)W_XO, JNO, 0, 0},
    {I_EWIN, 0, DM * EV_IN, 0, EV_IN, DM, 0, EV_IN, (int)W_IN, JNO, 0, 0}, {I_EWOUT, 0, DM * DM, 0, DM, DM, 0, DM, (int)W_OUT, JNO, 0, 0} };
__device__ const int JT_ODD[NJ_ODD][12] = {
    {I_WG, 2 * DM * FF, 0, 0, FF, DM, 0, FF, (int)W_GU, 128, 256, 0}, {I_WU, 2 * DM * FF, 0, 0, FF, DM, 0, FF, (int)W_GU, 128, 256, 128}, {I_WD, 2 * DM * FF, 0, 0, DM, FF, 0, DM, (int)W_D, JNO, 0, 0},
    {I_WG, 2 * DM * FF, 0, DM * FF, FF, DM, 0, FF, (int)(W_GU + 4 * FF * DM), 128, 256, 0}, {I_WU, 2 * DM * FF, 0, DM * FF, FF, DM, 0, FF, (int)(W_GU + 4 * FF * DM), 128, 256, 128}, {I_WD, 2 * DM * FF, 0, DM * FF, DM, FF, 0, DM, (int)(W_D + 2 * DM * FF), JNO, 0, 0},
    {I_XWQ, DM * DM, 0, 0, DM, DM, 0, DM, (int)W_XQ, JNO, 0, 0}, {I_XWKV, 2 * DM * DM, 0, 0, 2 * DM, DM, 0, 2 * DM, (int)W_XKV, JNO, 0, 0}, {I_XWO, DM * DM, 0, 0, DM, DM, 0, DM, (int)W_XO, JNO, 0, 0},
    {I_OWIN, 0, DM * OD_IN, 0, OD_IN, DM, 0, 512, (int)W_IN, JNO, 0, 0}, {I_OWIN, 0, DM * OD_IN, 0, OD_IN, DM, 512, 128, (int)W_IN, JNO, 0, 512}, {I_OWIN, 0, DM * OD_IN, 0, OD_IN, DM, 640, 128, (int)W_IN, JNO, 0, 640},
    {I_OWIN, 0, DM * OD_IN, 0, OD_IN, DM, 768, 128, (int)W_IN, JNO, 0, 768}, {I_OWIN, 0, DM * OD_IN, 0, OD_IN, DM, 1024, 128, (int)W_IN, JNO, 0, 896}, {I_OWIN, 0, DM * OD_IN, 0, OD_IN, DM, 1816, 128, (int)W_IN, JNO, 0, 1024},
    {I_OWIN, 0, DM * OD_IN, 0, OD_IN, DM, 1304, 512, (int)W_IN, JNO, 0, 1152}, {I_OWIN, 0, DM * OD_IN, 0, OD_IN, DM, 1280, 24, (int)W_IN, JNO, 0, 1664},
    {I_OWIN, 0, DM * OD_IN, 0, OD_IN, DM, 896, 128, (int)(W_IN + 2 * OD_PITCH * DM), JNO, 0, 0}, {I_OWIN, 0, DM * OD_IN, 0, OD_IN, DM, 1152, 128, (int)(W_IN + 2 * OD_PITCH * DM), JNO, 0, 128}, {I_OWIN, 0, DM * OD_IN, 0, OD_IN, DM, 1944, 128, (int)(W_IN + 2 * OD_PITCH * DM), JNO, 0, 256},
    {I_OWOUT, 0, DM * DM, 0, DM, DM, 0, DM, (int)W_OUT, JNO, 0, 0},
    {I_CW1, 0, 2 * 2048 * 256, 0, 256, 2048, 0, 256, (int)W_C1, JNO, 0, 0}, {I_CW1, 0, 2 * 2048 * 256, 2048 * 256, 256, 2048, 0, 256, (int)(W_C1 + 2 * 256 * 2048), JNO, 0, 0},
    {I_CW2, 0, 2 * 256 * 64, 0, 64, 256, 0, 64, (int)W_C2, JNO, 0, 0}, {I_CW2, 0, 2 * 256 * 64, 256 * 64, 64, 256, 0, 64, (int)(W_C2 + 2 * 64 * 256), JNO, 0, 0} };

DI void transpose_item(const float* src, bf16_t* dst, int ldw, int K, int c0, int ncols, int G, int GS, int off, int nblk, int item, LAS float* scr, int lane) {
    const int kb = item / nblk, nb = item % nblk, k0 = 64 * kb, n0 = 32 * nb;
    const int cl = n0 + (lane & 31); const bool okc = cl < ncols;
#pragma unroll 8
    for (int i = 0; i < 32; ++i) { const int kk = 2 * i + (lane >> 5); scr[kk * 33 + (lane & 31)] = okc ? src[(size_t)(k0 + kk) * ldw + c0 + cl] : 0.f; }
    LDS_WAIT(); asm volatile("" ::: "memory");
    const int c = lane & 7;
#pragma unroll
    for (int j = 0; j < 4; ++j) { const int n = (lane >> 3) + 8 * j; const LAS float* s = scr + (8 * c) * 33 + n;
        u32x4 o; o.x = pk2(s[0 * 33], s[1 * 33]); o.y = pk2(s[2 * 33], s[3 * 33]); o.z = pk2(s[4 * 33], s[5 * 33]); o.w = pk2(s[6 * 33], s[7 * 33]);
        const int cc = n0 + n; const int drow = (cc / G) * GS + off + (cc % G);
        *(u32x4*)(dst + (size_t)drow * K + k0 + 8 * c) = o; }
    LDS_WAIT(); asm volatile("" ::: "memory");
}
DI void layer_prologue(KP kp, const Args& a, int layer, LAS unsigned char* lds, int tid, int wave, int lane, int gw, int NGW) {
    LAS int* item0 = (LAS int*)(lds + 8 * 8448);
    unsigned char* ws = a.ws; unsigned char* W = ws + WS_W; const int li = layer >> 1; const bool odd = (layer & 1) != 0;
    const int nj = odd ? NJ_ODD : NJ_EVEN; const int (*JT)[12] = odd ? JT_ODD : JT_EVEN;
    if (tid == 0) { int items = 0; for (int j = 0; j < nj; ++j) { item0[j] = items; items += ((JT[j][7] + 31) / 32) * (JT[j][5] / 64); } item0[nj] = items; }
    __syncthreads();
    const int nitems = item0[nj];
    LAS float* scr = (LAS float*)(lds + wave * 8448);
    for (int it = gw; it < nitems; it += NGW) {
        int j = 0;
        while (j + 1 < nj && item0[j + 1] <= it) ++j;
        j = __builtin_amdgcn_readfirstlane(j);
        const int* J = JT[j];
        const float* src = kp->in[J[0]] + ((size_t)layer * J[1] + (size_t)li * J[2] + J[3]);
        transpose_item(src, (bf16_t*)(W + J[8]), J[4], J[5], J[6], J[7], J[9], J[10], J[11], (J[7] + 31) / 32, it - item0[j], scr, lane);
    }
    if (odd) {
        float* bias1 = (float*)(ws + WS_BIAS1);
        for (int o = gw; o < 512; o += NGW) { const int kv = o >> 8, col = o & 255;
            const float* pe = a.in[I_CPE] + (size_t)(li * 2 + kv) * 2048; const float* w1 = a.in[I_CW1] + (size_t)(li * 2 + kv) * 2048 * 256 + col;
            float s = 0.f;
            for (int k = lane; k < 2048; k += 64) s += pe[k] * w1[(size_t)k * 256];
            s = wave_sum(s); if (lane == 0) bias1[o] = s; }
    }
    if (layer == 0) {
        float* ct = (float*)(ws + WS_COS); float* st = (float*)(ws + WS_SIN);
        const int gt = gw * 64 + lane, NT = NGW * 64;
        for (int e = gt; e < SEQ * 64; e += NT) { const int pos = e >> 6, i = e & 63;
            const float ang = (float)pos * INVF[i];
            float sv, cv; sincos_acc(ang, sv, cv); ct[e] = cv; st[e] = sv; }
        const float* mem = a.in[I_MEM]; const float* mw = a.in[I_MNORMW]; bf16_t* memn = (bf16_t*)(ws + WS_MEMN);
        for (int m = gw; m < NB * MEMLEN; m += NGW) {
            const f32x4* xr = (const f32x4*)(mem + (size_t)m * DM) + lane; f32x4 v[4]; float s = 0.f;
#pragma unroll
            for (int j = 0; j < 4; ++j) { v[j] = xr[64 * j]; s += (v[j].x * v[j].x + v[j].y * v[j].y) + (v[j].z * v[j].z + v[j].w * v[j].w); }
            const float r = 1.0f / sqrtf(wave_sum(s) * (1.f / DM) + EPS);
#pragma unroll
            for (int j = 0; j < 4; ++j) { const f32x4 w = ((const f32x4*)mw)[lane + 64 * j];
                u32x2 o; o.x = pk2(v[j].x * r * w.x, v[j].y * r * w.y); o.y = pk2(v[j].z * r * w.z, v[j].w * r * w.w);
                *(u32x2*)(memn + (size_t)m * DM + 4 * (lane + 64 * j)) = o; }
        }
    }
}

DI void norm_phase(const float* x, const float* w, bf16_t* h, int gw, int NGW, int lane) {
    f32x4 wv[4];
#pragma unroll
    for (int j = 0; j < 4; ++j) wv[j] = ((const f32x4*)w)[lane + 64 * j];
    for (int m = gw; m < MTOK; m += NGW) {
        const f32x4* xr = (const f32x4*)(x + (size_t)m * DM) + lane; f32x4 v[4]; float s = 0.f;
#pragma unroll
        for (int j = 0; j < 4; ++j) { v[j] = xr[64 * j]; s += (v[j].x * v[j].x + v[j].y * v[j].y) + (v[j].z * v[j].z + v[j].w * v[j].w); }
        const float r = 1.0f / sqrtf(wave_sum(s) * (1.f / DM) + EPS);
#pragma unroll
        for (int j = 0; j < 4; ++j) { u32x2 o; o.x = pk2(v[j].x * r * wv[j].x, v[j].y * r * wv[j].y); o.y = pk2(v[j].z * r * wv[j].z, v[j].w * r * wv[j].w);
            *(u32x2*)(h + (size_t)m * DM + 4 * (lane + 64 * j)) = o; }
    }
}
DI void final_norm_phase(const float* x, const float* w, float* out, int gw, int NGW, int lane) {
    f32x4 wv[4];
#pragma unroll
    for (int j = 0; j < 4; ++j) wv[j] = ((const f32x4*)w)[lane + 64 * j];
    for (int m = gw; m < MTOK; m += NGW) {
        const f32x4* xr = (const f32x4*)(x + (size_t)m * DM) + lane; f32x4 v[4]; float s = 0.f;
#pragma unroll
        for (int j = 0; j < 4; ++j) { v[j] = xr[64 * j]; s += (v[j].x * v[j].x + v[j].y * v[j].y) + (v[j].z * v[j].z + v[j].w * v[j].w); }
        const float r = 1.0f / sqrtf(wave_sum(s) * (1.f / DM) + EPS);
#pragma unroll
        for (int j = 0; j < 4; ++j) ((f32x4*)(out + (size_t)m * DM))[lane + 64 * j] = v[j] * r * wv[j];
    }
}

constexpr int TP = 136;

DI void e0_unit(const Args& a, int li, int unit, LAS unsigned char* lds, int tid, int wave, int lane) {
    unsigned char* R = a.ws + WS_R;
    bf16_t* PROJ = (bf16_t*)(R + R_PROJ); bf16_t* CONV = (bf16_t*)(R + R_CONV); bf16_t* XDT = (bf16_t*)(R + R_XDT); float* CUMS = (float*)(R + R_CUMS);
    const float* COS = (const float*)(a.ws + WS_COS); const float* SIN = (const float*)(a.ws + WS_SIN);
    const int half = unit & 1, c = (unit >> 1) & 31, b = unit >> 6;
    const int crow0 = b * SEQ + c * 128;
    LAS float* dts = (LAS float*)lds;
    LAS float* das = dts + 1024;
    LAS float* cus = das + 1024;
    __syncthreads();
#pragma unroll
    for (int k = 0; k < 2; ++k) { const int idx = tid + 512 * k, l = idx >> 3, hd = idx & 7;
        const float raw = bf2f(PROJ[(size_t)(crow0 + l) * EV_PITCH + 3328 + hd]) + a.in[I_DTB][li * 8 + hd];
        const float dt = raw > 20.f ? raw : log1pf(expf(raw));
        const float av = -expf(a.in[I_ALOG][li * 8 + hd]);
        dts[l * 8 + hd] = dt; das[l * 8 + hd] = dt * av; }
    __syncthreads();
    {
        const float v0 = das[(2 * lane) * 8 + wave], v1 = das[(2 * lane + 1) * 8 + wave]; float s = v0 + v1;
#pragma unroll
        for (int o = 1; o < 64; o <<= 1) { const float t = __shfl_up(s, o); if (lane >= o) s += t; }
        cus[(2 * lane) * 8 + wave] = s - v1; cus[(2 * lane + 1) * 8 + wave] = s; }
    __syncthreads();
    for (int idx = tid; idx < 64 * 16; idx += 512) { const int rl = idx >> 4, k = idx & 15, l = half * 64 + rl; float v = 0.f;
        if (k < 8) v = cus[l * 8 + k]; else if (k < 12) v = (float)(l + 1) * log1pf(-exp2f(-5.0f - (float)(k - 8)));
        CUMS[(size_t)(crow0 + l) * 16 + k] = v; }
    const int r0 = crow0 + half * 64, pos0 = c * 128 + half * 64;
    for (int it = tid; it < 64 * 128; it += 512) { const int rl = it >> 7, ch = it & 127, col = ch * 8, i0 = (col & 127) >> 1;
        const f32x4 cs = *(const f32x4*)(COS + (size_t)(pos0 + rl) * 64 + i0), sn = *(const f32x4*)(SIN + (size_t)(pos0 + rl) * 64 + i0);
        u32x4* p = (u32x4*)(PROJ + (size_t)(r0 + rl) * EV_PITCH + col); const u32x4 v = *p; const float sc = col >= 512 ? 0.08838834764831845f : 1.0f; u32x4 o;
#pragma unroll
        for (int e = 0; e < 4; ++e) { const float t1 = bflo(v[e]), t2 = bfhi(v[e]); o[e] = pk2((t1 * cs[e] - t2 * sn[e]) * sc, (t1 * sn[e] + t2 * cs[e]) * sc); }
        *p = o; }
    const float* cw = a.in[I_CONVW] + (size_t)li * 4 * 768; const float* cb = a.in[I_CONVB] + (size_t)li * 768;
    for (int it = tid; it < 64 * 96; it += 512) { const int rl = it / 96, ch = (it % 96) * 8; const int pos = pos0 + rl;
        float acc[8];
        { const f32x4 b0 = *(const f32x4*)(cb + ch), b1 = *(const f32x4*)(cb + ch + 4); acc[0] = b0.x; acc[1] = b0.y; acc[2] = b0.z; acc[3] = b0.w; acc[4] = b1.x; acc[5] = b1.y; acc[6] = b1.z; acc[7] = b1.w; }
#pragma unroll
        for (int i = 0; i < 4; ++i) { const int ps = pos - 3 + i; if (ps >= 0) {
            const u32x4 v = *(const u32x4*)(PROJ + (size_t)(b * SEQ + ps) * EV_PITCH + 2560 + ch);
            const f32x4 w0 = *(const f32x4*)(cw + i * 768 + ch), w1 = *(const f32x4*)(cw + i * 768 + ch + 4);
            acc[0] += w0.x * bflo(v.x); acc[1] += w0.y * bfhi(v.x); acc[2] += w0.z * bflo(v.y); acc[3] += w0.w * bfhi(v.y);
            acc[4] += w1.x * bflo(v.z); acc[5] += w1.y * bfhi(v.z); acc[6] += w1.z * bflo(v.w); acc[7] += w1.w * bfhi(v.w); } }
#pragma unroll
        for (int e = 0; e < 8; ++e) acc[e] = silu_f(acc[e]);
        u32x4 o; o.x = pk2(acc[0], acc[1]); o.y = pk2(acc[2], acc[3]); o.z = pk2(acc[4], acc[5]); o.w = pk2(acc[6], acc[7]);
        *(u32x4*)(CONV + (size_t)(r0 + rl) * 768 + ch) = o;
        if (ch < 512) { const float dt = dts[(half * 64 + rl) * 8 + (ch >> 6)];
            u32x4 x; x.x = pk2(acc[0] * dt, acc[1] * dt); x.y = pk2(acc[2] * dt, acc[3] * dt); x.z = pk2(acc[4] * dt, acc[5] * dt); x.w = pk2(acc[6] * dt, acc[7] * dt);
            *(u32x4*)(XDT + (size_t)(r0 + rl) * 512 + ch) = x; } }
}

template <int NCOL, bool WEIGHT>
DI void stage_T(const bf16_t* src, int ld, LAS bf16_t* dstT, const float* cum, int tid) {
    constexpr int CPR = NCOL / 8;
    float cl = 0.f; if (WEIGHT) cl = cum[127 * 16];
    for (int it = tid; it < 128 * CPR; it += 512) { const int j = it / CPR, ch = it % CPR;
        const u32x4 v = *(const u32x4*)(src + (size_t)j * ld + ch * 8);
        float w = 1.f; if (WEIGHT) w = ex2((cl - cum[j * 16]) * LOG2E);
#pragma unroll
        for (int e = 0; e < 4; ++e) { float lo = bflo(v[e]), hi = bfhi(v[e]); if (WEIGHT) { lo *= w; hi *= w; }
            dstT[(ch * 8 + 2 * e) * TP + j] = f2bf(lo); dstT[(ch * 8 + 2 * e + 1) * TP + j] = f2bf(hi); } }
}
template <int NCOL>
DI void stage_N(const bf16_t* src, int ld, LAS bf16_t* dst, int tid) {
    constexpr int CPR = NCOL / 8;
    for (int it = tid; it < 128 * CPR; it += 512) { const int j = it / CPR, ch = it % CPR;
        *(LAS u32x4*)(dst + j * (NCOL + 8) + ch * 8) = *(const u32x4*)(src + (size_t)j * ld + ch * 8); }
}

template <int DK, int DV>
DI void e1_unit(const bf16_t* Kp, int ldk, const bf16_t* Vp, int ldv, const float* cum, float* st, LAS unsigned char* lds, int tid, int wave, int lane) {
    LAS bf16_t* KT = (LAS bf16_t*)lds; LAS bf16_t* VT = KT + DK * TP;
    __syncthreads();
    stage_T<DK, false>(Kp, ldk, KT, cum, tid);
    stage_T<DV, true>(Vp, ldv, VT, cum, tid);
    __syncthreads();
    constexpr int NTILES = DK / 16, TPW = (DV / 16) * NTILES / 8;
    const int lr = lane & 15, lq = lane >> 4; const int mt = (wave * TPW) / NTILES, nt0 = (wave * TPW) % NTILES;
    f32x4 acc[TPW];
#pragma unroll
    for (int i = 0; i < TPW; ++i) acc[i] = (f32x4){0.f, 0.f, 0.f, 0.f};
#pragma unroll
    for (int ks = 0; ks < 4; ++ks) { const bf16x8 xf = *(const LAS bf16x8*)(VT + (mt * 16 + lr) * TP + ks * 32 + lq * 8);
#pragma unroll
        for (int i = 0; i < TPW; ++i) { const bf16x8 yf = *(const LAS bf16x8*)(KT + ((nt0 + i) * 16 + lr) * TP + ks * 32 + lq * 8); acc[i] = mfma16(xf, yf, acc[i]); } }
#pragma unroll
    for (int i = 0; i < TPW; ++i)
#pragma unroll
        for (int t = 0; t < 4; ++t) st[(size_t)(mt * 16 + 4 * lq + t) * DK + (nt0 + i) * 16 + lr] = acc[i][t];
}

template <int DK, int DV, bool RET>
DI void e3_unit(const bf16_t* Qp, int ldq, const bf16_t* Kp, int ldk, const bf16_t* Vp, int ldv, const float* cum, const bf16_t* Sin,
                const bf16_t* gz, int ldgz, const bf16_t* xs, float dskip, bf16_t* outp, int ldo, LAS unsigned char* lds, int tid, int wave, int lane) {
    constexpr int QP = DK + 8;
    LAS bf16_t* Qs = (LAS bf16_t*)lds; LAS bf16_t* Ks = Qs + 128 * QP; LAS bf16_t* VT = Ks + 128 * QP; LAS bf16_t* P = VT + DV * TP; LAS float* cumL = (LAS float*)(P + 128 * TP);
    __syncthreads();
    stage_N<DK>(Qp, ldq, Qs, tid); stage_N<DK>(Kp, ldk, Ks, tid); stage_T<DV, false>(Vp, ldv, VT, cum, tid);
    if (tid < 128) cumL[tid] = cum[tid * 16];
    __syncthreads();
    const int lr = lane & 15, lq = lane >> 4, i0 = wave * 16;
    bf16x8 qf[DK / 32];
#pragma unroll
    for (int ks = 0; ks < DK / 32; ++ks) qf[ks] = *(const LAS bf16x8*)(Qs + (i0 + lr) * QP + ks * 32 + lq * 8);
    float ci[4];
#pragma unroll
    for (int t = 0; t < 4; ++t) ci[t] = cumL[i0 + 4 * lq + t];
#pragma unroll
    for (int nt = 0; nt < 8; ++nt) {
        f32x4 s = (f32x4){0.f, 0.f, 0.f, 0.f};
        if (nt <= wave) {
#pragma unroll
            for (int ks = 0; ks < DK / 32; ++ks) { const bf16x8 kf = *(const LAS bf16x8*)(Ks + (nt * 16 + lr) * QP + ks * 32 + lq * 8); s = mfma16(qf[ks], kf, s); }
        }
        const int j = nt * 16 + lr; const float cj = cumL[j];
#pragma unroll
        for (int t = 0; t < 4; ++t) { const int i = i0 + 4 * lq + t; const float p = (i >= j) ? s[t] * ex2((ci[t] - cj) * LOG2E) : 0.f; P[i * TP + j] = f2bf(p); }
    }
    f32x4 o[DV / 16];
#pragma unroll
    for (int nt = 0; nt < DV / 16; ++nt) { o[nt] = (f32x4){0.f, 0.f, 0.f, 0.f};
#pragma unroll
        for (int ks = 0; ks < DK / 32; ++ks) { const bf16x8 sf = *(const bf16x8*)(Sin + (size_t)(nt * 16 + lr) * DK + ks * 32 + lq * 8); o[nt] = mfma16(qf[ks], sf, o[nt]); }
#pragma unroll
        for (int t = 0; t < 4; ++t) o[nt][t] *= ex2(ci[t] * LOG2E); }
    LDS_WAIT();
#pragma unroll
    for (int ks = 0; ks < 4; ++ks) { const bf16x8 pf = *(const LAS bf16x8*)(P + (i0 + lr) * TP + ks * 32 + lq * 8);
#pragma unroll
        for (int nt = 0; nt < DV / 16; ++nt) { const bf16x8 vf = *(const LAS bf16x8*)(VT + (nt * 16 + lr) * TP + ks * 32 + lq * 8); o[nt] = mfma16(pf, vf, o[nt]); } }
    if (RET) {
        float rs[4];
#pragma unroll
        for (int t = 0; t < 4; ++t) { float ss = 0.f;
#pragma unroll
            for (int nt = 0; nt < DV / 16; ++nt) ss += o[nt][t] * o[nt][t];
            ss = grp16_sum(ss); rs[t] = 1.0f / sqrtf(ss * (1.0f / DV) + EPS); }
#pragma unroll
        for (int nt = 0; nt < DV / 16; ++nt)
#pragma unroll
            for (int t = 0; t < 4; ++t) { const int i = i0 + 4 * lq + t; const float g = bf2f(gz[(size_t)i * ldgz + nt * 16 + lr]);
                outp[(size_t)i * ldo + nt * 16 + lr] = f2bf(o[nt][t] * rs[t] * silu_f(g)); }
    } else {
#pragma unroll
        for (int nt = 0; nt < DV / 16; ++nt)
#pragma unroll
            for (int t = 0; t < 4; ++t) { const int i = i0 + 4 * lq + t; const float z = bf2f(gz[(size_t)i * ldgz + nt * 16 + lr]); const float xv = bf2f(xs[(size_t)i * 768 + nt * 16 + lr]);
                outp[(size_t)i * ldo + nt * 16 + lr] = f2bf((o[nt][t] + dskip * xv) * silu_f(z)); }
    }
}

DI void e1_phase(const Args& a, LAS unsigned char* lds, int tid, int wave, int lane, int bid, int G) {
    unsigned char* R = a.ws + WS_R; const bf16_t* PROJ = (const bf16_t*)(R + R_PROJ); const bf16_t* CONV = (const bf16_t*)(R + R_CONV); const bf16_t* XDT = (const bf16_t*)(R + R_XDT); const float* CUMS = (const float*)(R + R_CUMS);
    for (int u = bid; u < 1536; u += G) {
        if (u < 512) { const int b = u >> 7, c = (u >> 2) & 31, h = u & 3; const size_t row0 = (size_t)b * SEQ + c * 128;
            e1_unit<128, 128>(PROJ + row0 * EV_PITCH + 512 + h * 128, EV_PITCH, PROJ + row0 * EV_PITCH + 1024 + h * 128, EV_PITCH, CUMS + row0 * 16 + 8 + h,
                              (float*)(R + R_STR) + ((size_t)(b * 4 + h) * 32 + c) * 16384, lds, tid, wave, lane);
        } else { const int v = u - 512, b = v >> 8, c = (v >> 3) & 31, hd = v & 7, g = hd >> 2; const size_t row0 = (size_t)b * SEQ + c * 128;
            e1_unit<64, 64>(CONV + row0 * 768 + 512 + g * 64, 768, XDT + row0 * 512 + hd * 64, 512, CUMS + row0 * 16 + hd,
                            (float*)(R + R_STS) + ((size_t)(b * 8 + hd) * 32 + c) * 4096, lds, tid, wave, lane);
        }
    }
}
DI void e2_phase(const Args& a, int tid, int bid, int G) {
    unsigned char* R = a.ws + WS_R; const float* CUMS = (const float*)(R + R_CUMS);
    const float* STR = (const float*)(R + R_STR); const float* STS = (const float*)(R + R_STS); bf16_t* SINR = (bf16_t*)(R + R_SINR); bf16_t* SINS = (bf16_t*)(R + R_SINS);
    for (int idx = bid * 512 + tid; idx < 262144 + 131072; idx += G * 512) {
        if (idx < 262144) { const int bh = idx >> 14, el = idx & 16383, b = bh >> 2, h = bh & 3; float run = 0.f;
            for (int c = 0; c < 32; ++c) { const size_t o = ((size_t)bh * 32 + c) * 16384 + el; SINR[o] = f2bf(run);
                const float dec = expf(CUMS[((size_t)b * SEQ + c * 128 + 127) * 16 + 8 + h]); run = dec * run + STR[o]; }
        } else { const int e = idx - 262144, bh = e >> 12, el = e & 4095, b = bh >> 3, hd = bh & 7; float run = 0.f;
            for (int c = 0; c < 32; ++c) { const size_t o = ((size_t)bh * 32 + c) * 4096 + el; SINS[o] = f2bf(run);
                const float dec = expf(CUMS[((size_t)b * SEQ + c * 128 + 127) * 16 + hd]); run = dec * run + STS[o]; }
        }
    }
}
DI void e3_phase(const Args& a, int li, LAS unsigned char* lds, int tid, int wave, int lane, int bid, int G) {
    unsigned char* R = a.ws + WS_R; const bf16_t* PROJ = (const bf16_t*)(R + R_PROJ); const bf16_t* CONV = (const bf16_t*)(R + R_CONV); const bf16_t* XDT = (const bf16_t*)(R + R_XDT); const float* CUMS = (const float*)(R + R_CUMS);
    bf16_t* MIX = (bf16_t*)(a.ws + WS_H); bf16_t* YP = (bf16_t*)(R + R_YP);
    for (int u = bid; u < 1536; u += G) {
        if (u < 512) { const int b = u >> 7, c = (u >> 2) & 31, h = u & 3; const size_t row0 = (size_t)b * SEQ + c * 128; const bf16_t* pr = PROJ + row0 * EV_PITCH;
            e3_unit<128, 128, true>(pr + h * 128, EV_PITCH, pr + 512 + h * 128, EV_PITCH, pr + 1024 + h * 128, EV_PITCH, CUMS + row0 * 16 + 8 + h,
                                    (const bf16_t*)(R + R_SINR) + ((size_t)(b * 4 + h) * 32 + c) * 16384, pr + 1536 + h * 128, EV_PITCH, nullptr, 0.f,
                                    MIX + row0 * DM + h * 128, DM, lds, tid, wave, lane);
        } else { const int v = u - 512, b = v >> 8, c = (v >> 3) & 31, hd = v & 7, g = hd >> 2; const size_t row0 = (size_t)b * SEQ + c * 128;
            e3_unit<64, 64, false>(CONV + row0 * 768 + 640 + g * 64, 768, CONV + row0 * 768 + 512 + g * 64, 768, XDT + row0 * 512 + hd * 64, 512, CUMS + row0 * 16 + hd,
                                   (const bf16_t*)(R + R_SINS) + ((size_t)(b * 8 + hd) * 32 + c) * 4096, PROJ + row0 * EV_PITCH + 2048 + hd * 64, EV_PITCH,
                                   CONV + row0 * 768 + hd * 64, a.in[I_SSMD][li * 8 + hd], YP + row0 * 512 + hd * 64, 512, lds, tid, wave, lane);
        }
    }
}
DI void e4_phase(const Args& a, int li, int gw, int NGW, int lane) {
    const bf16_t* YP = (const bf16_t*)(a.ws + WS_R + R_YP); bf16_t* MIX = (bf16_t*)(a.ws + WS_H); const float* nw = a.in[I_SSMNW] + (size_t)li * 512;
    const f32x4 w0 = *(const f32x4*)(nw + lane * 8), w1 = *(const f32x4*)(nw + lane * 8 + 4);
    for (int m = gw; m < MTOK; m += NGW) {
        const u32x4 v = *(const u32x4*)(YP + (size_t)m * 512 + lane * 8);
        float f[8] = {bflo(v.x), bfhi(v.x), bflo(v.y), bfhi(v.y), bflo(v.z), bfhi(v.z), bflo(v.w), bfhi(v.w)}; float s = 0.f;
#pragma unroll
        for (int e = 0; e < 8; ++e) s += f[e] * f[e];
        const float r = 1.0f / sqrtf(wave_sum(s) * (1.f / 512.f) + EPS);
        u32x4 o; o.x = pk2(f[0] * r * w0.x, f[1] * r * w0.y); o.y = pk2(f[2] * r * w0.z, f[3] * r * w0.w); o.z = pk2(f[4] * r * w1.x, f[5] * r * w1.y); o.w = pk2(f[6] * r * w1.z, f[7] * r * w1.w);
        *(u32x4*)(MIX + (size_t)m * DM + 512 + lane * 8) = o;
    }
}

template <int MT, int HD, class MaskF>
DI void flash_block(const bf16x8 (&qf)[MT][HD / 32], const bf16_t* Kb, int ldk, const bf16_t* Vt, int ldv,
                    f32x4 (&o)[MT][HD / 16], float (&mrow)[MT][4], float (&lrow)[MT][4], LAS bf16_t* pbuf, float c2, const MaskF& mk, int key0, int lr, int lq) {
    constexpr int PP = 72;
    f32x4 s[MT][4];
#pragma unroll
    for (int mt = 0; mt < MT; ++mt)
#pragma unroll
        for (int nt = 0; nt < 4; ++nt) s[mt][nt] = (f32x4){0.f, 0.f, 0.f, 0.f};
#pragma unroll
    for (int nt = 0; nt < 4; ++nt)
#pragma unroll
        for (int ks = 0; ks < HD / 32; ++ks) { const bf16x8 kf = *(const bf16x8*)(Kb + (size_t)(nt * 16 + lr) * ldk + ks * 32 + lq * 8);
#pragma unroll
            for (int mt = 0; mt < MT; ++mt) s[mt][nt] = mfma16(qf[mt][ks], kf, s[mt][nt]); }
#pragma unroll
    for (int mt = 0; mt < MT; ++mt) {
#pragma unroll
        for (int nt = 0; nt < 4; ++nt) { const bool ok = mk.ok(mt, key0 + nt * 16 + lr);
#pragma unroll
            for (int t = 0; t < 4; ++t) s[mt][nt][t] = ok ? s[mt][nt][t] * c2 : -INFINITY; }
#pragma unroll
        for (int t = 0; t < 4; ++t) {
            float mx = fmaxf(fmaxf(s[mt][0][t], s[mt][1][t]), fmaxf(s[mt][2][t], s[mt][3][t])); mx = grp16_max(mx);
            const float mnew = fmaxf(mrow[mt][t], mx), alpha = ex2(mrow[mt][t] - mnew); mrow[mt][t] = mnew;
            float ps = 0.f;
#pragma unroll
            for (int nt = 0; nt < 4; ++nt) { const float p = ex2(s[mt][nt][t] - mnew); s[mt][nt][t] = p; ps += p; }
            lrow[mt][t] = lrow[mt][t] * alpha + ps;
#pragma unroll
            for (int nt = 0; nt < HD / 16; ++nt) o[mt][nt][t] *= alpha;
        }
#pragma unroll
        for (int nt = 0; nt < 4; ++nt)
#pragma unroll
            for (int t = 0; t < 4; ++t) pbuf[(mt * 16 + 4 * lq + t) * PP + nt * 16 + lr] = f2bf(s[mt][nt][t]);
    }
    LDS_WAIT();
#pragma unroll
    for (int ks = 0; ks < 2; ++ks) { bf16x8 pf[MT];
#pragma unroll
        for (int mt = 0; mt < MT; ++mt) pf[mt] = *(const LAS bf16x8*)(pbuf + (mt * 16 + lr) * PP + ks * 32 + lq * 8);
#pragma unroll
        for (int nt = 0; nt < HD / 16; ++nt) { const bf16x8 vf = *(const bf16x8*)(Vt + (size_t)(nt * 16 + lr) * ldv + ks * 32 + lq * 8);
#pragma unroll
            for (int mt = 0; mt < MT; ++mt) o[mt][nt] = mfma16(pf[mt], vf, o[mt][nt]); } }
    LDS_WAIT();
}
struct NoMask { DI bool ok(int, int) const { return true; } };
struct WinMask { int W; int tpos[2]; DI bool ok(int mt, int key) const { return key <= tpos[mt] && tpos[mt] - key < W; } };
struct SelMask { unsigned long long sm[2]; int jb; int tpos[2]; DI bool ok(int mt, int key) const { return ((sm[mt] >> jb) & 1ull) != 0ull && key <= tpos[mt]; } };

struct CmpOrder {
    int G, c; const char* P; const char* W1;
    DI bool next(int i, pg8::Unit& u) const { const int L = i * G + c; if (L >= 16) return false; u.pm = L & 7; u.pn = L >> 3; const int b = u.pm >> 1, g = u.pm & 1;
        u.a = P + ((size_t)b * SEQ * OD_PITCH + 512 + u.pn * 128 + g * 64) * 2; u.b = W1 + (size_t)u.pn * 256 * 2048 * 2; return true; }
};
DI void o2_phase(const Args& a, int gw, int lane) {
    if (gw >= 128) return;
    unsigned char* R = a.ws + WS_R; const bf16_t* HIDC = (const bf16_t*)(R + R_HIDC); const bf16_t* W2T = (const bf16_t*)(a.ws + WS_W + W_C2);
    bf16_t* KC = (bf16_t*)(R + R_KC); bf16_t* VCT = (bf16_t*)(R + R_VCT);
    const int kv = gw >> 6, bg = (gw >> 3) & 7, n0 = (gw & 7) * 32, lr = lane & 15, lq = lane >> 4;
    const bf16_t* hid = HIDC + ((size_t)(kv * 8 + bg) * 256) * 256; const bf16_t* w2 = W2T + (size_t)kv * 64 * 256;
    if (kv == 0) {
        f32x4 acc[2][4];
#pragma unroll
        for (int mt = 0; mt < 2; ++mt)
#pragma unroll
            for (int nt = 0; nt < 4; ++nt) acc[mt][nt] = (f32x4){0.f, 0.f, 0.f, 0.f};
#pragma unroll
        for (int ks = 0; ks < 8; ++ks) { bf16x8 xf[2];
#pragma unroll
            for (int mt = 0; mt < 2; ++mt) xf[mt] = *(const bf16x8*)(hid + (size_t)(n0 + mt * 16 + lr) * 256 + ks * 32 + lq * 8);
#pragma unroll
            for (int nt = 0; nt < 4; ++nt) { const bf16x8 yf = *(const bf16x8*)(w2 + (size_t)(nt * 16 + lr) * 256 + ks * 32 + lq * 8);
#pragma unroll
                for (int mt = 0; mt < 2; ++mt) acc[mt][nt] = mfma16(xf[mt], yf, acc[mt][nt]); } }
#pragma unroll
        for (int mt = 0; mt < 2; ++mt)
#pragma unroll
            for (int nt = 0; nt < 4; ++nt)
#pragma unroll
                for (int t = 0; t < 4; ++t) KC[((size_t)bg * 256 + n0 + mt * 16 + 4 * lq + t) * 64 + nt * 16 + lr] = f2bf(acc[mt][nt][t]);
    } else {
        f32x4 acc[4][2];
#pragma unroll
        for (int mt = 0; mt < 4; ++mt)
#pragma unroll
            for (int nt = 0; nt < 2; ++nt) acc[mt][nt] = (f32x4){0.f, 0.f, 0.f, 0.f};
#pragma unroll
        for (int ks = 0; ks < 8; ++ks) { bf16x8 yf[2];
#pragma unroll
            for (int nt = 0; nt < 2; ++nt) yf[nt] = *(const bf16x8*)(hid + (size_t)(n0 + nt * 16 + lr) * 256 + ks * 32 + lq * 8);
#pragma unroll
            for (int mt = 0; mt < 4; ++mt) { const bf16x8 xf = *(const bf16x8*)(w2 + (size_t)(mt * 16 + lr) * 256 + ks * 32 + lq * 8);
#pragma unroll
                for (int nt = 0; nt < 2; ++nt) acc[mt][nt] = mfma16(xf, yf[nt], acc[mt][nt]); } }
#pragma unroll
        for (int mt = 0; mt < 4; ++mt)
#pragma unroll
            for (int nt = 0; nt < 2; ++nt)
#pragma unroll
                for (int t = 0; t < 4; ++t) VCT[((size_t)bg * 64 + mt * 16 + 4 * lq + t) * 256 + n0 + nt * 16 + lr] = f2bf(acc[mt][nt][t]);
    }
}

constexpr int O3_WSZ = 16960;
DI void o3_unit(const Args& a, int li, int bg, int tile, LAS unsigned char* lds, int wave, int lane) {
    asm volatile("" : "+v"(lane));
    unsigned char* R = a.ws + WS_R; const bf16_t* PROJ = (const bf16_t*)(R + R_PROJ); const bf16_t* VTb = (const bf16_t*)(R + R_VT);
    const bf16_t* KC = (const bf16_t*)(R + R_KC); const bf16_t* VCT = (const bf16_t*)(R + R_VCT); bf16_t* MIX = (bf16_t*)(a.ws + WS_H);
    const int b = bg >> 1, g = bg & 1, t0 = tile * 64, lr = lane & 15, lq = lane >> 4; const size_t rowb = (size_t)b * SEQ;
    LAS float* PS = (LAS float*)(lds + wave * O3_WSZ); LAS bf16_t* PB = (LAS bf16_t*)(lds + wave * O3_WSZ + 8448); LAS unsigned long long* SELM = (LAS unsigned long long*)(lds + wave * O3_WSZ + 16896);
    const float c2 = 0.125f * LOG2E;
    int tpos[2]; tpos[0] = t0 + 8 * wave + lq; tpos[1] = tpos[0] + 4;
    bf16x8 qf[2][2];
#pragma unroll
    for (int mt = 0; mt < 2; ++mt)
#pragma unroll
        for (int ks = 0; ks < 2; ++ks) qf[mt][ks] = *(const bf16x8*)(PROJ + (rowb + t0 + 8 * wave + 4 * mt + (lr >> 2)) * OD_PITCH + g * 256 + (lr & 3) * 64 + ks * 32 + lq * 8);
#define GATE(mt, t, br) sigmoid_f(bf2f(PROJ[(rowb + tpos[mt]) * OD_PITCH + 1664 + g * 12 + (t) * 3 + (br)]))
#define OTIDX(mt, nt, t) (((mt) * 16 + 4 * lq + (t)) * 64 + (nt) * 16 + lr)
    f32x4 ot[2][4];
#pragma unroll
    for (int mt = 0; mt < 2; ++mt) {
        f32x4 s[16];
#pragma unroll
        for (int nt = 0; nt < 16; ++nt) { s[nt] = (f32x4){0.f, 0.f, 0.f, 0.f};
            if ((nt & 3) == 0) asm volatile("" ::: "memory");
#pragma unroll
            for (int ks = 0; ks < 2; ++ks) { const bf16x8 kf = *(const bf16x8*)(KC + ((size_t)bg * 256 + nt * 16 + lr) * 64 + ks * 32 + lq * 8); s[nt] = mfma16(qf[mt][ks], kf, s[nt]); } }
#pragma unroll
        for (int nt = 0; nt < 16; ++nt) { const int n = nt * 16 + lr; const bool ok = (n < 255) && (16 * n + 31 <= tpos[mt]);
#pragma unroll
            for (int t = 0; t < 4; ++t) s[nt][t] = ok ? s[nt][t] * c2 : -INFINITY; }
#pragma unroll
        for (int t = 0; t < 4; ++t) { float mx = s[0][t];
#pragma unroll
            for (int nt = 1; nt < 16; ++nt) mx = fmaxf(mx, s[nt][t]);
            mx = grp16_max(mx); const float mm = (mx == -INFINITY) ? 0.f : mx; float sum = 0.f;
#pragma unroll
            for (int nt = 0; nt < 16; ++nt) { const float p = ex2(s[nt][t] - mm); s[nt][t] = p; sum += p; }
            sum = grp16_sum(sum); const float inv = 1.0f / fmaxf(sum, 1e-30f);
#pragma unroll
            for (int nt = 0; nt < 16; ++nt) s[nt][t] *= inv; }
#pragma unroll
        for (int nt = 0; nt < 16; ++nt) { PS[(4 * mt + lq) * 264 + nt * 16 + lr] = (s[nt][0] + s[nt][1]) + (s[nt][2] + s[nt][3]);
#pragma unroll
            for (int t = 0; t < 4; ++t) PB[(4 * lq + t) * 264 + nt * 16 + lr] = f2bf(s[nt][t]); }
        LDS_WAIT();
#pragma unroll
        for (int nt = 0; nt < 4; ++nt) ot[mt][nt] = (f32x4){0.f, 0.f, 0.f, 0.f};
#pragma unroll
        for (int ks = 0; ks < 8; ++ks) { const bf16x8 pf = *(const LAS bf16x8*)(PB + lr * 264 + ks * 32 + lq * 8);
            if ((ks & 1) == 0) asm volatile("" ::: "memory");
#pragma unroll
            for (int nt = 0; nt < 4; ++nt) { const bf16x8 vf = *(const bf16x8*)(VCT + ((size_t)bg * 64 + nt * 16 + lr) * 256 + ks * 32 + lq * 8); ot[mt][nt] = mfma16(pf, vf, ot[mt][nt]); } }
        LDS_WAIT();
#pragma unroll
        for (int t = 0; t < 4; ++t) { const float g0 = GATE(mt, t, 0);
#pragma unroll
            for (int nt = 0; nt < 4; ++nt) ot[mt][nt][t] *= g0; }
    }
    unsigned long long wunion = 0ull;
    for (int tk = 0; tk < 8; ++tk) {
        const int j = lane, nlo = (4 * j - 1 < 0) ? 0 : 4 * j - 1, nhi = (4 * j + 3 > 254) ? 254 : 4 * j + 3; float imp = 0.f;
        for (int n = nlo; n <= nhi; ++n) imp += PS[tk * 264 + n];
        const bool valid = j <= tile, forced = valid && (j == 0 || j == tile || j == tile - 1);
        const float sc = forced ? 1e6f : (valid ? imp : -INFINITY);
        int rank = 0;
        for (int jp = 0; jp < 64; ++jp) { const float v = __shfl(sc, jp); rank += ((v > sc) || (v == sc && jp < j)) ? 1 : 0; }
        const unsigned long long m = __ballot(valid && rank < 16);
        wunion |= m; if (lane == 0) SELM[tk] = m;
    }
    LDS_WAIT();
#pragma unroll
    for (int mt = 0; mt < 2; ++mt)
#pragma unroll
        for (int nt = 0; nt < 4; ++nt)
#pragma unroll
            for (int t = 0; t < 4; ++t) PS[OTIDX(mt, nt, t)] = ot[mt][nt][t];
    LAS bf16_t* pbuf = PB;
    {
        SelMask mk; mk.sm[0] = SELM[lq]; mk.sm[1] = SELM[4 + lq]; mk.tpos[0] = tpos[0]; mk.tpos[1] = tpos[1]; mk.jb = 0;
        f32x4 o[2][4]; float mrow[2][4], lrow[2][4];
#pragma unroll
        for (int mt = 0; mt < 2; ++mt) {
#pragma unroll
            for (int nt = 0; nt < 4; ++nt) o[mt][nt] = (f32x4){0.f, 0.f, 0.f, 0.f};
#pragma unroll
            for (int t = 0; t < 4; ++t) { mrow[mt][t] = -1e30f; lrow[mt][t] = 0.f; } }
        for (int jb = 0; jb <= tile; ++jb) { if (!((wunion >> jb) & 1ull)) continue; mk.jb = jb;
            flash_block<2, 64>(qf, PROJ + (rowb + jb * 64) * OD_PITCH + 768 + g * 64, OD_PITCH, VTb + (size_t)(g * 64) * MTOK + rowb + jb * 64, MTOK, o, mrow, lrow, pbuf, c2, mk, jb * 64, lr, lq); }
#pragma unroll
        for (int mt = 0; mt < 2; ++mt)
#pragma unroll
            for (int t = 0; t < 4; ++t) { const float f = GATE(mt, t, 1) / grp16_sum(lrow[mt][t]);
#pragma unroll
                for (int nt = 0; nt < 4; ++nt) PS[OTIDX(mt, nt, t)] += o[mt][nt][t] * f; }
    }
    {
        WinMask mk; mk.W = 512; mk.tpos[0] = tpos[0]; mk.tpos[1] = tpos[1];
        f32x4 o[2][4]; float mrow[2][4], lrow[2][4];
#pragma unroll
        for (int mt = 0; mt < 2; ++mt) {
#pragma unroll
            for (int nt = 0; nt < 4; ++nt) o[mt][nt] = (f32x4){0.f, 0.f, 0.f, 0.f};
#pragma unroll
            for (int t = 0; t < 4; ++t) { mrow[mt][t] = -1e30f; lrow[mt][t] = 0.f; } }
        for (int jb = (tile >= 8 ? tile - 8 : 0); jb <= tile; ++jb)
            flash_block<2, 64>(qf, PROJ + (rowb + jb * 64) * OD_PITCH + 896 + g * 64, OD_PITCH, VTb + (size_t)(128 + g * 64) * MTOK + rowb + jb * 64, MTOK, o, mrow, lrow, pbuf, c2, mk, jb * 64, lr, lq);
#pragma unroll
        for (int mt = 0; mt < 2; ++mt)
#pragma unroll
            for (int t = 0; t < 4; ++t) { const float f = GATE(mt, t, 2) / grp16_sum(lrow[mt][t]);
#pragma unroll
                for (int nt = 0; nt < 4; ++nt) MIX[(rowb + tpos[mt]) * DM + g * 256 + t * 64 + nt * 16 + lr] = f2bf(PS[OTIDX(mt, nt, t)] + o[mt][nt][t] * f); }
    }
    {
#pragma unroll
        for (int mt = 0; mt < 2; ++mt)
#pragma unroll
            for (int ks = 0; ks < 2; ++ks) qf[mt][ks] = *(const bf16x8*)(PROJ + (rowb + t0 + 8 * wave + 4 * mt + (lr >> 2)) * OD_PITCH + 1152 + g * 256 + (lr & 3) * 64 + ks * 32 + lq * 8);
        WinMask mk; mk.W = 128; mk.tpos[0] = tpos[0]; mk.tpos[1] = tpos[1];
        f32x4 o[2][4]; float mrow[2][4], lrow[2][4];
#pragma unroll
        for (int mt = 0; mt < 2; ++mt) {
#pragma unroll
            for (int nt = 0; nt < 4; ++nt) o[mt][nt] = (f32x4){0.f, 0.f, 0.f, 0.f};
#pragma unroll
            for (int t = 0; t < 4; ++t) { mrow[mt][t] = -1e30f; lrow[mt][t] = 0.f; } }
        for (int jb = (tile >= 2 ? tile - 2 : 0); jb <= tile; ++jb)
            flash_block<2, 64>(qf, PROJ + (rowb + jb * 64) * OD_PITCH + 1024 + g * 64, OD_PITCH, VTb + (size_t)(256 + g * 64) * MTOK + rowb + jb * 64, MTOK, o, mrow, lrow, pbuf, c2, mk, jb * 64, lr, lq);
#pragma unroll
        for (int mt = 0; mt < 2; ++mt)
#pragma unroll
            for (int t = 0; t < 4; ++t) { const float sk = a.in[I_SINKS][li * 8 + g * 4 + t] * LOG2E; const float f = 1.0f / (grp16_sum(lrow[mt][t]) + ex2(sk - mrow[mt][t]));
#pragma unroll
                for (int nt = 0; nt < 4; ++nt) MIX[(rowb + tpos[mt]) * DM + 512 + g * 256 + t * 64 + nt * 16 + lr] = f2bf(o[mt][nt][t] * f); }
    }
}
#undef GATE
#undef OTIDX
DI void o3_phase(const Args& a, int li, LAS unsigned char* lds, int wave, int lane, int bid, int G) {
    for (int p = bid; p < 256; p += G) { const int bg = p >> 5, tl = p & 31;
        o3_unit(a, li, bg, 63 - tl, lds, wave, lane);
        o3_unit(a, li, bg, tl, lds, wave, lane); }
}

DI void xattn_phase(const Args& a, LAS unsigned char* lds, int wave, int lane, int bid, int G) {
    bf16_t* Q = (bf16_t*)(a.ws + WS_R + R_Q); const bf16_t* KX = (const bf16_t*)(a.ws + WS_KX); const bf16_t* VTX = (const bf16_t*)(a.ws + WS_VTX);
    const int lr = lane & 15, lq = lane >> 4; LAS bf16_t* pbuf = (LAS bf16_t*)(lds + wave * 2304);
    for (int u = bid; u < 512; u += G) { const int b = u >> 7, hd = (u >> 5) & 3, qt = u & 31;
        const size_t row0 = (size_t)b * SEQ + qt * 128 + wave * 16;
        bf16x8 qf[1][8];
#pragma unroll
        for (int ks = 0; ks < 8; ++ks) qf[0][ks] = *(const bf16x8*)(Q + (row0 + lr) * DM + hd * 256 + ks * 32 + lq * 8);
        f32x4 o[1][16]; float mrow[1][4], lrow[1][4];
#pragma unroll
        for (int nt = 0; nt < 16; ++nt) o[0][nt] = (f32x4){0.f, 0.f, 0.f, 0.f};
#pragma unroll
        for (int t = 0; t < 4; ++t) { mrow[0][t] = -1e30f; lrow[0][t] = 0.f; }
        NoMask mk;
        for (int jb = 0; jb < 4; ++jb)
            flash_block<1, 256>(qf, KX + ((size_t)b * MEMLEN + jb * 64) * DM + hd * 256, DM, VTX + (size_t)(hd * 256) * DM + b * MEMLEN + jb * 64, DM, o, mrow, lrow, pbuf, 0.0625f * LOG2E, mk, jb * 64, lr, lq);
#pragma unroll
        for (int t = 0; t < 4; ++t) { const float f = 1.0f / grp16_sum(lrow[0][t]);
#pragma unroll
            for (int nt = 0; nt < 16; ++nt) Q[(row0 + 4 * lq + t) * DM + hd * 256 + nt * 16 + lr] = f2bf(o[0][nt][t] * f); }
    }
}

#ifndef MK_MODE
#define MK_MODE 0
#endif
constexpr int PH_PER_LAYER = 20, PH_FINAL = DEPTH * PH_PER_LAYER, PH_TOTAL = PH_FINAL + 1;
extern __shared__ __attribute__((aligned(16))) unsigned char lds_raw[];

#define PHASE_SETUP \
    asm volatile("" : "+s"(kp_)); \
    LAS unsigned char* lds = (LAS unsigned char*)lds_raw; \
    int tid = threadIdx.x, bid = blockIdx.x, G = gridDim.x; asm volatile("" : "+v"(tid)); asm volatile("" : "+s"(bid), "+s"(G)); \
    const int lane = tid & 63, wave = __builtin_amdgcn_readfirstlane(tid >> 6); const int gw = bid * 8 + wave, NGW = G * 8; (void)bid; \
    Args a; _Pragma("unroll") for (int i_ = 0; i_ < 25; ++i_) a.in[i_] = kp_->in[i_]; a.out = kp_->out; a.ws = kp_->ws; a.ph_lo = 0; a.ph_hi = 0; \
    unsigned char* ws = a.ws; float* X = (float*)(ws + WS_X); bf16_t* H = (bf16_t*)(ws + WS_H); unsigned char* R = ws + WS_R; unsigned char* W = ws + WS_W; \
    (void)lds; (void)tid; (void)lane; (void)wave; (void)G; (void)gw; (void)NGW; (void)X; (void)H; (void)R; (void)W;
#define UNI(x) __builtin_amdgcn_readfirstlane(x)

DI void P_prologue(KP kp_, int layer) { layer = UNI(layer); PHASE_SETUP layer_prologue(kp_, a, layer, lds, tid, wave, lane, gw, NGW); __syncthreads(); }
DI void P_norm(KP kp_, int layer, int which) { layer = UNI(layer); which = UNI(which); PHASE_SETUP
    norm_phase((layer == 0 && which == 0) ? a.in[I_X] : X, a.in[I_NORMW] + ((size_t)layer * 4 + which) * DM, H, gw, NGW, lane); }
DI void P_final(KP kp_) { PHASE_SETUP final_norm_phase(X, a.in[I_FNORMW], a.out, gw, NGW, lane); }
DI void P_gemm_bf16(KP kp_, int which) { which = UNI(which); PHASE_SETUP
    const bf16_t* A = H; const bf16_t* Bt = (const bf16_t*)(W + W_IN); bf16_t* O = (bf16_t*)(R + R_PROJ); int M = MTOK, N = EV_PITCH, ldc = EV_PITCH, rot = 0;
    if (which == 0) { A = (const bf16_t*)(ws + WS_MEMN); Bt = (const bf16_t*)(W + W_XKV); O = (bf16_t*)(ws + WS_KX); M = NB * MEMLEN; N = DM; ldc = DM; }
    else if (which == 1) { A = (const bf16_t*)(W + W_XKV) + (size_t)DM * DM; Bt = (const bf16_t*)(ws + WS_MEMN); O = (bf16_t*)(ws + WS_VTX); M = DM; N = NB * MEMLEN; ldc = DM; rot = 16; }
    else if (which == 3) { N = OD_PITCH; ldc = OD_PITCH; }
    else if (which == 4) { A = (const bf16_t*)(W + W_IN) + (size_t)OD_PITCH * DM; Bt = H; O = (bf16_t*)(R + R_VT); M = 512; N = MTOK; ldc = MTOK; rot = 64; }
    else if (which == 5) { Bt = (const bf16_t*)(W + W_XQ); O = (bf16_t*)(R + R_Q); N = DM; ldc = DM; }
    pg8::Gemm g{A, Bt, DM, DM, 128, 128, DM}; pg8::StaticOrder S; S.init(g, M, N, G, (bid + G - rot) % G);
    pg8::EpiBf16<0> E{O, ldc, nullptr, 0}; pg8::gemm_phase(lds, g, S, E, tid); }
DI void P_gemm_swiglu(KP kp_, int half) { half = UNI(half); PHASE_SETUP
    pg8::Gemm g{H, (const bf16_t*)(W + W_GU) + (size_t)half * 2 * FF * DM, DM, DM, 128, 128, DM}; pg8::StaticOrder S; S.init(g, MTOK, 2 * FF, G, bid);
    pg8::EpiSwiGLU E{(bf16_t*)(R + R_HID), FF}; pg8::gemm_phase(lds, g, S, E, tid); }
DI void P_gemm_resid(KP kp_, int which, int first) { which = UNI(which); first = UNI(first); PHASE_SETUP
    const bf16_t* A = (const bf16_t*)(R + R_HID); const bf16_t* Bt = (const bf16_t*)(W + W_D) + (size_t)which * DM * FF; int K = FF; float sc = 0.5f;
    if (which == 2) { A = H; Bt = (const bf16_t*)(W + W_OUT); K = DM; sc = 1.0f; }
    else if (which == 3) { A = (const bf16_t*)(R + R_Q); Bt = (const bf16_t*)(W + W_XO); K = DM; sc = 1.0f; }
    pg8::Gemm g{A, Bt, K, K, 128, 128, K}; pg8::StaticOrder S; S.init(g, MTOK, DM, G, bid);
    pg8::EpiResid E{first ? a.in[I_X] : X, X, sc}; pg8::gemm_phase(lds, g, S, E, tid); }
DI void P_gemm_cmp(KP kp_) { PHASE_SETUP
    pg8::Gemm g{nullptr, nullptr, 16 * OD_PITCH, 2048, OD_PITCH * 2, 128, 2048};
    CmpOrder S{G, bid, (const char*)(R + R_PROJ), (const char*)(W + W_C1)};
    pg8::EpiBf16<2> E{(bf16_t*)(R + R_HIDC), 256, (const float*)(ws + WS_BIAS1), 1}; pg8::gemm_phase(lds, g, S, E, tid); }
DI void P_e0(KP kp_, int li) { li = UNI(li); PHASE_SETUP for (int u = bid; u < 256; u += G) e0_unit(a, li, u, lds, tid, wave, lane); }
DI void P_e1(KP kp_) { PHASE_SETUP e1_phase(a, lds, tid, wave, lane, bid, G); }
DI void P_e2(KP kp_) { PHASE_SETUP e2_phase(a, tid, bid, G); }
DI void P_e3(KP kp_, int li) { li = UNI(li); PHASE_SETUP e3_phase(a, li, lds, tid, wave, lane, bid, G); }
DI void P_e4(KP kp_, int li) { li = UNI(li); PHASE_SETUP e4_phase(a, li, gw, NGW, lane); }
DI void P_o2(KP kp_) { PHASE_SETUP o2_phase(a, gw, lane); }
DI void P_o3(KP kp_, int li) { li = UNI(li); PHASE_SETUP o3_phase(a, li, lds, wave, lane, bid, G); }
DI void P_xattn(KP kp_) { PHASE_SETUP xattn_phase(a, lds, wave, lane, bid, G); }

DI void grid_bar(KP kp_) {
    asm volatile("" : "+s"(kp_));
    XcdBarrier b; b.bar = (unsigned*)(kp_->ws + WS_CTL) + 4096 + kp_->li * XCD_BAR_WORDS; b.x = xb_xcc_id(); b.st = (volatile LAS unsigned*)((LAS unsigned char*)lds_raw + LDSCTL_OFF) + 8;
    xcd_barrier(b);
}
__global__ void __launch_bounds__(512, 2) fwd_kernel(KArgs ka) {
    KP kp = (KP)__builtin_amdgcn_kernarg_segment_ptr();
    {
        LAS unsigned char* lds = (LAS unsigned char*)lds_raw;
        volatile LAS unsigned* MISC = (volatile LAS unsigned*)(lds + LDSCTL_OFF);
        for (int u = threadIdx.x; u < 128; u += 512) MISC[u] = 0u;
        __syncthreads();
        if (ka.ph_hi - ka.ph_lo > 1) (void)xcd_barrier_post((unsigned*)(ka.ws + WS_CTL) + 4096 + ka.li * XCD_BAR_WORDS, MISC + 8);
    }
#define PH(id, ...) { KP k_ = kp; asm volatile("" : "+s"(k_)); const int lo_ = k_->ph_lo, hi_ = k_->ph_hi; if (lo_ <= (id) && (id) < hi_) { __VA_ARGS__; if ((id) + 1 < hi_) grid_bar(kp); } }
    for (int layer = 0; layer < DEPTH; ++layer) {
        const int base = layer * PH_PER_LAYER, li = layer >> 1; const bool odd = (layer & 1) != 0;
        PH(base + 0, P_prologue(kp, layer))
        PH(base + 1, P_gemm_bf16(kp, 0); P_gemm_bf16(kp, 1))
        PH(base + 2, P_norm(kp, layer, 0))
        PH(base + 3, P_gemm_swiglu(kp, 0))
        PH(base + 4, P_gemm_resid(kp, 0, layer == 0 ? 1 : 0))
        PH(base + 5, P_norm(kp, layer, 1))
        if (!odd) {
            PH(base + 6, P_gemm_bf16(kp, 2))
            PH(base + 7, P_e0(kp, li))
            PH(base + 8, P_e1(kp))
            PH(base + 9, P_e2(kp))
            PH(base + 10, P_e3(kp, li))
            PH(base + 11, P_e4(kp, li))
        } else {
            PH(base + 6, P_gemm_bf16(kp, 3); P_gemm_bf16(kp, 4))
            PH(base + 7, P_gemm_cmp(kp))
            PH(base + 8, P_o2(kp))
            PH(base + 9, P_o3(kp, li))
        }
        PH(base + 12, P_gemm_resid(kp, 2, 0))
        PH(base + 13, P_norm(kp, layer, 2))
        PH(base + 14, P_gemm_bf16(kp, 5))
        PH(base + 15, P_xattn(kp))
        PH(base + 16, P_gemm_resid(kp, 3, 0))
        PH(base + 17, P_norm(kp, layer, 3))
        PH(base + 18, P_gemm_swiglu(kp, 1))
        PH(base + 19, P_gemm_resid(kp, 1, 0))
    }
    PH(PH_FINAL, P_final(kp))
#undef PH
}

extern "C" void kernel_launch(void* const* d_in, const int* in_sizes, int n_in, void* d_out, int out_size, void* d_ws, size_t ws_size, hipStream_t stream) {
    static int grid = 0;
    if (grid == 0) {
        if (n_in != 25 || out_size != MTOK * DM || ws_size < WS_END) { fprintf(stderr, "kernel_launch: unexpected problem (n_in %d, out %d, ws %zu < %zu)\n", n_in, out_size, ws_size, (size_t)WS_END); grid = -1; return; }
        int dev = 0, cus = 0, per_cu = 0;
        if (hipGetDevice(&dev) != hipSuccess || hipDeviceGetAttribute(&cus, hipDeviceAttributeMultiprocessorCount, dev) != hipSuccess) { grid = -1; return; }
        if (hipFuncSetAttribute((const void*)fwd_kernel, hipFuncAttributeMaxDynamicSharedMemorySize, LDS_BYTES) != hipSuccess) { fprintf(stderr, "kernel_launch: hipFuncSetAttribute failed\n"); grid = -1; return; }
        if (hipOccupancyMaxActiveBlocksPerMultiprocessor(&per_cu, (const void*)fwd_kernel, 512, LDS_BYTES) != hipSuccess || per_cu < 1) fprintf(stderr, "kernel_launch: occupancy query says %d\n", per_cu);
        (void)hipGetLastError();
        grid = cus;
    }
    if (grid < 0) return;
    (void)hipMemsetAsync((char*)d_ws + WS_CTL, 0, CTL_ZERO_BYTES, stream);
    KArgs a{};
    for (int i = 0; i < 25; ++i) a.in[i] = (const float*)d_in[i];
    a.out = (float*)d_out; a.ws = (unsigned char*)d_ws; a.pad = 0;
#if MK_MODE == 1
    a.ph_lo = 0; a.ph_hi = PH_TOTAL; a.li = 0;
    hipLaunchKernelGGL(fwd_kernel, dim3(grid), dim3(512), LDS_BYTES, stream, a);
#else
    for (int p = 0; p < PH_TOTAL; ++p) { const int l = p % PH_PER_LAYER; if (p < PH_FINAL && (((p / PH_PER_LAYER) & 1) != 0) && (l == 10 || l == 11)) continue;
        a.ph_lo = p; a.ph_hi = p + 1; a.li = 0;
        hipLaunchKernelGGL(fwd_kernel, dim3(grid), dim3(512), LDS_BYTES, stream, a); }
#endif
}
```

```cpp
#include <hip/hip_runtime.h>
#include <cstdio>
#include <cstdint>

#define DI __device__ __forceinline__
#define LAS __attribute__((address_space(3)))
#define GAS __attribute__((address_space(1)))
typedef unsigned short bf16_t;
typedef short bf16x8 __attribute__((ext_vector_type(8)));
typedef float f32x4 __attribute__((ext_vector_type(4)));
typedef float f32x2 __attribute__((ext_vector_type(2)));
typedef unsigned u32x4 __attribute__((ext_vector_type(4)));
typedef unsigned u32x2 __attribute__((ext_vector_type(2)));
typedef __bf16 bf16x2_t __attribute__((ext_vector_type(2)));

constexpr int DM = 1024, NB = 4, SEQ = 4096, MTOK = NB * SEQ, DEPTH = 4, FF = 2816, MEMLEN = 256;
constexpr int EV_IN = 3336, EV_PITCH = 3584;
constexpr int OD_IN = 2072, OD_PITCH = 1792;
constexpr float EPS = 1e-6f;
constexpr float LOG2E = 1.4426950408889634f;

constexpr size_t MiB = 1u << 20;
constexpr size_t WS_CTL = 0, CTL_ZERO_BYTES = 1 * MiB;
constexpr size_t WS_COS = 1 * MiB, WS_SIN = 2 * MiB;
constexpr size_t WS_MEMN = 3 * MiB;
constexpr size_t WS_KX = 5 * MiB, WS_VTX = 7 * MiB;
constexpr size_t WS_BIAS1 = 9 * MiB;
constexpr size_t WS_W = 10 * MiB;
constexpr size_t W_GU = 0, W_D = 22 * MiB, W_XQ = 33 * MiB, W_XKV = 35 * MiB, W_XO = 39 * MiB, W_IN = 41 * MiB, W_OUT = 48 * MiB, W_C1 = 50 * MiB, W_C2 = 52 * MiB;
constexpr size_t WS_X = 64 * MiB;
constexpr size_t WS_H = 128 * MiB;
constexpr size_t WS_R = 160 * MiB;
constexpr size_t R_HID = 0;
constexpr size_t R_Q = 0;
constexpr size_t R_PROJ = 0;
constexpr size_t R_CONV = 112 * MiB, R_XDT = 136 * MiB, R_STR = 152 * MiB, R_STS = 184 * MiB, R_SINR = 200 * MiB, R_SINS = 216 * MiB, R_YP = 224 * MiB, R_CUMS = 240 * MiB;
constexpr size_t R_VT = 56 * MiB, R_HIDC = 72 * MiB, R_KC = 74 * MiB, R_VCT = 75 * MiB;
constexpr size_t WS_END = 160 * MiB + 242 * MiB;

constexpr int LDS_BYTES = 147456;
constexpr int LDSCTL_OFF = 147456 - 512;

DI unsigned pk2(float lo, float hi) { f32x2 v = {lo, hi}; bf16x2_t b = __builtin_convertvector(v, bf16x2_t); return __builtin_bit_cast(unsigned, b); }
DI bf16_t f2bf(float f) { return (bf16_t)(pk2(f, 0.f) & 0xffffu); }
DI float bf2f(unsigned h) { return __uint_as_float((h & 0xffffu) << 16); }
DI float bflo(unsigned w) { return __uint_as_float(w << 16); }
DI float bfhi(unsigned w) { return __uint_as_float(w & 0xffff0000u); }
DI float silu_f(float x) { return x * __builtin_amdgcn_rcpf(1.f + __builtin_amdgcn_exp2f(-LOG2E * x)); }
DI float sigmoid_f(float x) { return __builtin_amdgcn_rcpf(1.f + __builtin_amdgcn_exp2f(-LOG2E * x)); }
DI float ex2(float x) { return __builtin_amdgcn_exp2f(x); }
DI f32x4 mfma16(bf16x8 a, bf16x8 b, f32x4 c) { return __builtin_amdgcn_mfma_f32_16x16x32_bf16(a, b, c, 0, 0, 0); }
DI float wave_sum(float v) {
#pragma unroll
    for (int o = 1; o < 64; o <<= 1) v += __shfl_xor(v, o);
    return v;
}
DI float grp16_sum(float v) { v += __shfl_xor(v, 1); v += __shfl_xor(v, 2); v += __shfl_xor(v, 4); v += __shfl_xor(v, 8); return v; }
DI float grp16_max(float v) { v = fmaxf(v, __shfl_xor(v, 1)); v = fmaxf(v, __shfl_xor(v, 2)); v = fmaxf(v, __shfl_xor(v, 4)); v = fmaxf(v, __shfl_xor(v, 8)); return v; }
#define LDS_WAIT() asm volatile("s_waitcnt lgkmcnt(0)" ::: "memory")
#define VM_WAIT() asm volatile("s_waitcnt vmcnt(0)" ::: "memory")

#define XB_TMO      128
#define XB_XCNT(j)  (256  + 64 * (j))
#define XB_XSUB(j)  (1280 + 64 * (j))
#define XB_XGEN(j)  (2304 + 64 * (j))
#define XB_TOP      3328
#define XB_TOPGEN   3392
#define XCD_BAR_WORDS 3456
#define XB_SPIN_CAP (1u << 18)
DI unsigned xb_ld(unsigned* p)              { return __hip_atomic_load(p, __ATOMIC_RELAXED, __HIP_MEMORY_SCOPE_AGENT); }
DI unsigned xb_add(unsigned* p, unsigned v) { return __hip_atomic_fetch_add(p, v, __ATOMIC_RELAXED, __HIP_MEMORY_SCOPE_AGENT); }
DI unsigned xb_xcc_id() { return (unsigned)__builtin_amdgcn_s_getreg((3 << 11) | 20) & 0xFu; }
#define XB_SPIN(cond, bar) do { unsigned _sp = 0; while (cond) { __builtin_amdgcn_s_sleep(1); \
    if ((++_sp & 255u) == 0u) { if (xb_ld(&(bar)[XB_TMO])) break; if (_sp > XB_SPIN_CAP) { atomicAdd(&(bar)[XB_TMO], 1u); break; } } } } while (0)
struct XcdBarrier { unsigned* bar; unsigned x; volatile LAS unsigned* st; };
DI XcdBarrier xcd_barrier_post(unsigned* bar, volatile LAS unsigned* st) {
    XcdBarrier b; b.bar = bar; b.x = xb_xcc_id(); b.st = st;
    if (threadIdx.x == 0) (void)xb_add(&bar[XB_XCNT(b.x)], 1u);
    return b;
}
DI void xcd_barrier_complete(unsigned* bar, unsigned x, unsigned& nloc, unsigned& nx) {
    const unsigned G = gridDim.x * gridDim.y * gridDim.z;
    unsigned sum, cnt, mine, sp = 0u;
    for (;;) {
        sum = 0u; cnt = 0u; mine = 0u;
#pragma unroll
        for (unsigned j = 0; j < 16; ++j) { const unsigned c = xb_ld(&bar[XB_XCNT(j)]); sum += c; cnt += (c > 0u) ? 1u : 0u; mine = (j == x) ? c : mine; }
        if (sum == G) break;
        __builtin_amdgcn_s_sleep(1);
        if ((++sp & 255u) == 0u) { if (xb_ld(&bar[XB_TMO])) break; if (sp > XB_SPIN_CAP) { atomicAdd(&bar[XB_TMO], 1u); break; } }
    }
    nloc = mine > 0u ? mine : 1u; nx = cnt > 0u ? cnt : 1u;
}
DI void xcd_barrier(const XcdBarrier& b) {
    asm volatile("s_waitcnt vmcnt(0)" ::: "memory");
    __syncthreads();
    if (threadIdx.x == 0) {
        unsigned* bar = b.bar;
        __builtin_amdgcn_s_waitcnt(0);
        unsigned nloc = b.st[0], nx = b.st[1];
        if (nloc == 0u) { xcd_barrier_complete(bar, b.x, nloc, nx); b.st[0] = nloc; b.st[1] = nx; }
        const unsigned old = xb_add(&bar[XB_XSUB(b.x)], 1u);
        const unsigned gen = old / nloc;
        if (old + 1u == (gen + 1u) * nloc) {
            __builtin_amdgcn_fence(__ATOMIC_RELEASE, "agent");
            asm volatile("s_waitcnt vmcnt(0)" ::: "memory");
            const unsigned og = xb_add(&bar[XB_TOP], 1u);
            const unsigned tg = og / nx;
            if (og + 1u == (tg + 1u) * nx) xb_add(&bar[XB_TOPGEN], 1u);
            else XB_SPIN(xb_ld(&bar[XB_TOPGEN]) == tg, bar);
            __builtin_amdgcn_fence(__ATOMIC_ACQUIRE, "agent");
            xb_add(&bar[XB_XGEN(b.x)], 1u);
            asm volatile("s_waitcnt vmcnt(0)" ::: "memory");
        } else {
            XB_SPIN(xb_ld(&bar[XB_XGEN(b.x)]) == gen, bar);
            __builtin_amdgcn_fence(__ATOMIC_ACQUIRE, "agent");
            asm volatile("s_waitcnt vmcnt(0)" ::: "memory");
        }
    }
    __syncthreads();
}

namespace pg8 {
constexpr int BM = 256, BK = 64, HALF = 128, HTB = HALF * BK * 2, STAGE_BYTES = 8 * HTB, NXCD = 8, WGM = 8;
__host__ __device__ __forceinline__ int lds_byte(int r, int c) { const int st = (r >> 4) * 2 + (c >> 5), rr = r & 15, cc = c & 31, ob = rr * 64 + cc * 2; return st * 1024 + (ob ^ (((ob >> 9) & 1) << 5)); }
__host__ __device__ __forceinline__ void stage_rc(int b, int& R, int& C) { const int st = b / 1024, sb = b % 1024, swz = sb ^ (((sb >> 9) & 1) << 5); R = (st >> 1) * 16 + swz / 64; C = (st & 1) * 32 + (swz % 64) / 2; }
__host__ __device__ __forceinline__ int perm32(int rho) { const int n = rho >> 4, i = rho & 15; return 8 * (i >> 2) + 4 * n + (i & 3); }

struct Unit { int pm, pn; const char* a; const char* b; };
struct Gemm { const bf16_t* A; const bf16_t* Bt; int lda, ldb, kstepA, kstepB, K; };

struct StaticOrder {
    int nM, nN, nwg, G, c; const char* A; const char* B; size_t tA, tB;
    DI void init(const Gemm& g, int M, int N, int G_, int c_) { nM = M / BM; nN = N / BM; nwg = nM * nN; G = G_; c = c_; A = (const char*)g.A; B = (const char*)g.Bt; tA = (size_t)BM * g.lda * 2; tB = (size_t)BM * g.ldb * 2; }
    DI bool next(int i, Unit& u) const {
        const int L = i * G + c; if (L >= nwg) return false;
        int wgid = L; { const int q = nwg / NXCD, r = nwg % NXCD, xcd = wgid % NXCD, off = wgid / NXCD; wgid = (xcd < r ? xcd * (q + 1) : r * (q + 1) + (xcd - r) * q) + off; }
        const int nig = WGM * nN, gid = wgid / nig, fm = gid * WGM, gsz = (nM - fm) < WGM ? (nM - fm) : WGM;
        u.pm = fm + ((wgid % nig) % gsz); u.pn = (wgid % nig) / gsz; u.a = A + (size_t)u.pm * tA; u.b = B + (size_t)u.pn * tB; return true;
    }
};

DI unsigned cvt_pk_bf16(float lo, float hi) { return pk2(lo, hi); }

template <int ACT> struct EpiBf16 {
    static constexpr bool PERM = true;
    bf16_t* O; int ldc; const float* bias; int cmp_mode;
    DI void operator()(const f32x4 (&acc)[2][2][4][2], const Unit& u, int wr, int wc, int fr, int fq) const {
        const int rt = cmp_mode ? (u.pn * 8 + u.pm) : u.pm, ct = cmp_mode ? 0 : u.pn;
        const int row0 = rt * BM + wr * 64 + fr; const int col0 = ct * BM + wc * 32 + 8 * fq;
        f32x4 bv[2][2];
#pragma unroll
        for (int bj = 0; bj < 2; ++bj)
#pragma unroll
            for (int n = 0; n < 2; ++n) bv[bj][n] = bias ? *(const f32x4*)(bias + u.pn * BM + (wc * 32 + 8 * fq) + bj * HALF + 4 * n) : (f32x4){0.f, 0.f, 0.f, 0.f};
#pragma unroll
        for (int ai = 0; ai < 2; ++ai)
#pragma unroll
            for (int m = 0; m < 4; ++m) { bf16_t* rowp = O + (size_t)(row0 + ai * HALF + m * 16) * ldc + col0;
#pragma unroll
                for (int bj = 0; bj < 2; ++bj) { f32x4 v0 = acc[ai][bj][m][0] + bv[bj][0], v1 = acc[ai][bj][m][1] + bv[bj][1];
                    if (ACT == 2) { v0 = (f32x4){silu_f(v0[0]), silu_f(v0[1]), silu_f(v0[2]), silu_f(v0[3])}; v1 = (f32x4){silu_f(v1[0]), silu_f(v1[1]), silu_f(v1[2]), silu_f(v1[3])}; }
                    u32x4 w; w.x = cvt_pk_bf16(v0[0], v0[1]); w.y = cvt_pk_bf16(v0[2], v0[3]); w.z = cvt_pk_bf16(v1[0], v1[1]); w.w = cvt_pk_bf16(v1[2], v1[3]);
                    *(u32x4*)(rowp + bj * HALF) = w; } }
    }
};
struct EpiSwiGLU {
    static constexpr bool PERM = true;
    bf16_t* O; int ldc;
    DI void operator()(const f32x4 (&acc)[2][2][4][2], const Unit& u, int wr, int wc, int fr, int fq) const {
        const int row0 = u.pm * BM + wr * 64 + fr; const int col0 = u.pn * HALF + wc * 32 + 8 * fq;
#pragma unroll
        for (int ai = 0; ai < 2; ++ai)
#pragma unroll
            for (int m = 0; m < 4; ++m) { bf16_t* rowp = O + (size_t)(row0 + ai * HALF + m * 16) * ldc + col0;
                const f32x4 g0 = acc[ai][0][m][0], g1 = acc[ai][0][m][1], u0 = acc[ai][1][m][0], u1 = acc[ai][1][m][1];
                u32x4 w; w.x = cvt_pk_bf16(silu_f(g0[0]) * u0[0], silu_f(g0[1]) * u0[1]); w.y = cvt_pk_bf16(silu_f(g0[2]) * u0[2], silu_f(g0[3]) * u0[3]);
                w.z = cvt_pk_bf16(silu_f(g1[0]) * u1[0], silu_f(g1[1]) * u1[1]); w.w = cvt_pk_bf16(silu_f(g1[2]) * u1[2], silu_f(g1[3]) * u1[3]);
                *(u32x4*)rowp = w; }
    }
};
struct EpiResid {
    static constexpr bool PERM = false;
    const float* base; float* out; float scale;
    DI void operator()(const f32x4 (&acc)[2][2][4][2], const Unit& u, int wr, int wc, int fr, int fq) const {
        const int col0 = u.pn * BM + wc * 32 + 4 * fq;
#pragma unroll
        for (int ai = 0; ai < 2; ++ai)
#pragma unroll
            for (int m = 0; m < 4; ++m) { const size_t off = (size_t)(u.pm * BM + ai * HALF + wr * 64 + m * 16 + fr) * DM + col0;
#pragma unroll
                for (int bj = 0; bj < 2; ++bj)
#pragma unroll
                    for (int n = 0; n < 2; ++n) { const f32x4 bs = *(const f32x4*)(base + off + bj * HALF + n * 16); *(f32x4*)(out + off + bj * HALF + n * 16) = bs + acc[ai][bj][m][n] * scale; } }
    }
};

template <class Epi, class Sched>
DI void gemm_phase(LAS unsigned char* lds, const Gemm g, const Sched& S, const Epi& E, const int tid) {
    const int wid = __builtin_amdgcn_readfirstlane(tid >> 6), lane = tid & 63, wr = wid >> 2, wc = wid & 3, fr = lane & 15, fq = lane >> 4;
    const int K = g.K, nt = K / BK;
    unsigned voffA[2], voffB[2];
#pragma unroll
    for (int i = 0; i < 2; ++i) { int R, C; stage_rc(tid * 16 + i * 8192, R, C); const int Rb = Epi::PERM ? ((R & ~31) + perm32(R & 31)) : R;
        voffA[i] = (unsigned)(R * g.lda + C) * 2u; voffB[i] = (unsigned)(Rb * g.ldb + C) * 2u; }
    const size_t kA = (size_t)g.kstepA, kB = (size_t)g.kstepB;
    const size_t hA = (size_t)HALF * g.lda * 2, hB = (size_t)HALF * g.ldb * 2;
    const unsigned ldsw = (unsigned)wid * 1024u;
    const int aoff = lds_byte(wr * 64 + fr, fq * 8), boff = lds_byte(wc * 32 + fr, fq * 8);
#define PG8_SA(b, h) (((b) * 2 + (h)) * HTB)
#define PG8_SB(b, h) ((4 + (b) * 2 + (h)) * HTB)
#define PG8_STAGE(bufoff, gbase, voff) do { _Pragma("unroll") for (int _i = 0; _i < 2; ++_i) \
        __builtin_amdgcn_global_load_lds((const unsigned*)((const char*)(gbase) + (voff)[_i]), (LAS unsigned*)(lds + (bufoff) + ldsw + _i * 8192), 16, 0, 0); } while (0)
#define PG8_LDA(dst, b, h) do { _Pragma("unroll") for (int m = 0; m < 4; ++m) _Pragma("unroll") for (int k = 0; k < 2; ++k) dst[m][k] = *(const LAS bf16x8*)(lds + PG8_SA(b, h) + aoff + m * 2048 + k * 1024); } while (0)
#define PG8_LDB(dst, b, h) do { _Pragma("unroll") for (int n = 0; n < 2; ++n) _Pragma("unroll") for (int k = 0; k < 2; ++k) dst[n][k] = *(const LAS bf16x8*)(lds + PG8_SB(b, h) + boff + n * 2048 + k * 1024); } while (0)
#define PG8_MMA(ai, bj, At, Bt) do { __builtin_amdgcn_s_setprio(1); _Pragma("unroll") for (int m = 0; m < 4; ++m) _Pragma("unroll") for (int n = 0; n < 2; ++n) _Pragma("unroll") for (int k = 0; k < 2; ++k) \
        acc[ai][bj][m][n] = __builtin_amdgcn_mfma_f32_16x16x32_bf16(Bt[n][k], At[m][k], acc[ai][bj][m][n], 0, 0, 0); __builtin_amdgcn_s_setprio(0); } while (0)
#define PG8_WAIT_V(n) asm volatile("s_waitcnt vmcnt(" #n ")" ::: "memory")
#define PG8_WAIT_L(n) asm volatile("s_waitcnt lgkmcnt(" #n ")" ::: "memory")
#define PG8_BAR __builtin_amdgcn_s_barrier()
#define PG8_SCHED __builtin_amdgcn_sched_barrier(0)
    Unit cur, nxt; int ui = 0;
    if (!S.next(0, cur)) return;
    f32x4 acc[2][2][4][2];
#pragma unroll
    for (int a = 0; a < 2; ++a)
#pragma unroll
        for (int b = 0; b < 2; ++b)
#pragma unroll
            for (int m = 0; m < 4; ++m)
#pragma unroll
                for (int n = 0; n < 2; ++n) acc[a][b][m][n] = (f32x4){0.f, 0.f, 0.f, 0.f};
    bf16x8 At[4][2], B0[2][2], B1[2][2];
    const char* cA = cur.a; const char* cB = cur.b;
    PG8_STAGE(PG8_SB(0, 0), cB, voffB); PG8_STAGE(PG8_SB(0, 1), cB + hB, voffB); PG8_STAGE(PG8_SA(0, 0), cA, voffA); PG8_STAGE(PG8_SA(0, 1), cA + hA, voffA);
    if (wr == 1) PG8_BAR;
    PG8_WAIT_V(2); PG8_BAR;
    PG8_STAGE(PG8_SB(1, 0), cB + kB, voffB); PG8_STAGE(PG8_SA(1, 0), cA + kA, voffA); PG8_STAGE(PG8_SB(1, 1), cB + hB + kB, voffB);
    PG8_WAIT_V(6); PG8_BAR;
    for (;;) {
        const bool has_next = S.next(ui + 1, nxt);
        const char* nA = has_next ? nxt.a : cA; const char* nB = has_next ? nxt.b : cB;
        for (int t = 0; t < nt; t += 2) {
            const bool last = (t == nt - 2);
            const char* a1 = cA + (size_t)(t + 1) * kA;
            const char* a2 = last ? nA : cA + (size_t)(t + 2) * kA; const char* b2 = last ? nB : cB + (size_t)(t + 2) * kB;
            const char* a3 = a2 + kA; const char* b3 = b2 + kB;
            PG8_LDB(B0, 0, 0); PG8_LDB(B1, 0, 1); PG8_SCHED; PG8_LDA(At, 0, 0); PG8_STAGE(PG8_SA(1, 1), a1 + hA, voffA);
            PG8_WAIT_V(8); PG8_WAIT_L(0); PG8_BAR; PG8_MMA(0, 0, At, B0); PG8_MMA(0, 1, At, B1); PG8_BAR; PG8_SCHED;
            PG8_LDA(At, 0, 1); PG8_STAGE(PG8_SB(0, 0), b2, voffB); PG8_STAGE(PG8_SB(0, 1), b2 + hB, voffB); PG8_STAGE(PG8_SA(0, 0), a2, voffA);
            PG8_WAIT_V(8); PG8_WAIT_L(0); PG8_BAR; PG8_MMA(1, 0, At, B0); PG8_MMA(1, 1, At, B1); PG8_BAR; PG8_SCHED;
            PG8_LDB(B0, 1, 0); PG8_LDB(B1, 1, 1); PG8_SCHED; PG8_LDA(At, 1, 0); PG8_STAGE(PG8_SA(0, 1), a2 + hA, voffA);
            PG8_WAIT_V(8); PG8_WAIT_L(0); PG8_BAR; PG8_MMA(0, 0, At, B0); PG8_MMA(0, 1, At, B1); PG8_BAR; PG8_SCHED;
            PG8_LDA(At, 1, 1); PG8_STAGE(PG8_SB(1, 0), b3, voffB); PG8_STAGE(PG8_SB(1, 1), b3 + hB, voffB); PG8_STAGE(PG8_SA(1, 0), a3, voffA);
            PG8_WAIT_V(8); PG8_WAIT_L(0); PG8_BAR; PG8_MMA(1, 0, At, B0); PG8_MMA(1, 1, At, B1); PG8_BAR; PG8_SCHED;
        }
        if (wr == 0) PG8_BAR;
        E(acc, cur, wr, wc, fr, fq);
        if (!has_next) break;
#pragma unroll
        for (int a = 0; a < 2; ++a)
#pragma unroll
            for (int b = 0; b < 2; ++b)
#pragma unroll
                for (int m = 0; m < 4; ++m)
#pragma unroll
                    for (int n = 0; n < 2; ++n) acc[a][b][m][n] = (f32x4){0.f, 0.f, 0.f, 0.f};
        cur = nxt; cA = nA; cB = nB; ++ui;
        if (wr == 1) PG8_BAR;
    }
    PG8_WAIT_V(0);
    PG8_BAR;
#undef PG8_SA
#undef PG8_SB
#undef PG8_STAGE
#undef PG8_LDA
#undef PG8_LDB
#undef PG8_MMA
#undef PG8_WAIT_V
#undef PG8_WAIT_L
#undef PG8_BAR
#undef PG8_SCHED
}
}

struct Args { const float* in[25]; float* out; unsigned char* ws; int ph_lo, ph_hi; };
struct KArgs { const float* in[25]; float* out; unsigned char* ws; int ph_lo, ph_hi, li, pad; };
typedef const KArgs __attribute__((address_space(4)))* KP;
enum { I_X = 0, I_MEM, I_NORMW, I_FNORMW, I_MNORMW, I_WG, I_WU, I_WD, I_XWQ, I_XWKV, I_XWO, I_EWIN, I_EWOUT, I_CONVW, I_CONVB, I_DTB, I_ALOG, I_SSMD, I_SSMNW, I_OWIN, I_OWOUT, I_CPE, I_CW1, I_CW2, I_SINKS };


__device__ const float INVF[64] = {1.000000000e+00f, 8.639885187e-01f, 7.464760542e-01f, 6.449466944e-01f, 5.572264791e-01f, 4.814372659e-01f, 4.159561992e-01f, 3.593813777e-01f, 3.105013072e-01f, 2.682695687e-01f, 2.317818254e-01f, 2.002568096e-01f, 1.730195731e-01f, 1.494869143e-01f, 1.291549653e-01f, 1.115884036e-01f, 9.641107917e-02f, 8.329805732e-02f, 7.196855545e-02f, 6.218000501e-02f, 5.372281000e-02f, 4.641588405e-02f, 4.010278732e-02f, 3.464834765e-02f, 2.993576974e-02f, 2.586415969e-02f, 2.234633639e-02f, 1.930697635e-02f, 1.668100618e-02f, 1.441219542e-02f, 1.245197095e-02f, 1.075835899e-02f, 9.295095690e-03f, 8.030855097e-03f, 6.938566454e-03f, 5.994840525e-03f, 5.179473199e-03f, 4.475005437e-03f, 3.866353072e-03f, 3.340484342e-03f, 2.886139555e-03f, 2.493591513e-03f, 2.154434333e-03f, 1.861406374e-03f, 1.608233666e-03f, 1.389495214e-03f, 1.200507861e-03f, 1.037224894e-03f, 8.961504791e-04f, 7.742635789e-04f, 6.689548027e-04f, 5.779692437e-04f, 4.993587499e-04f, 4.314401885e-04f, 3.727593285e-04f, 3.220597573e-04f, 2.782559313e-04f, 2.404098923e-04f, 2.077113895e-04f, 1.794602285e-04f, 1.550515735e-04f, 1.339627634e-04f, 1.157422957e-04f, 9.999999747e-05f};
DI void sincos_acc(float x, float& s, float& c) {
    const float kf = __builtin_rintf(x * 0.636619772367581343f); const int k = (int)kf;
    float r = __builtin_fmaf(-kf, 1.57079637050628662109375f, x); r = __builtin_fmaf(-kf, -4.37113900018624283e-8f, r);
    const float r2 = r * r;
    const float sp = r + r * r2 * (-1.0f / 6.0f + r2 * (1.0f / 120.0f + r2 * (-1.0f / 5040.0f + r2 * (1.0f / 362880.0f))));
    const float cp = 1.0f + r2 * (-0.5f + r2 * (1.0f / 24.0f + r2 * (-1.0f / 720.0f + r2 * (1.0f / 40320.0f + r2 * (-1.0f / 3628800.0f)))));
    const int q = k & 3;
    s = (q == 0) ? sp : (q == 1) ? cp : (q == 2) ? -sp : -cp;
    c = (q == 0) ? cp : (q == 1) ? -sp : (q == 2) ? -cp : sp;
}

#define JNO (1 << 20)
constexpr int NJ_EVEN = 11, NJ_ODD = 25;
__device__ const int JT_EVEN[NJ_EVEN][12] = {
    {I_WG, 2 * DM * FF, 0, 0, FF, DM, 0, FF, (int)W_GU, 128, 256, 0}, {I_WU, 2 * DM * FF, 0, 0, FF, DM, 0, FF, (int)W_GU, 128, 256, 128}, {I_WD, 2 * DM * FF, 0, 0, DM, FF, 0, DM, (int)W_D, JNO, 0, 0},
    {I_WG, 2 * DM * FF, 0, DM * FF, FF, DM, 0, FF, (int)(W_GU + 4 * FF * DM), 128, 256, 0}, {I_WU, 2 * DM * FF, 0, DM * FF, FF, DM, 0, FF, (int)(W_GU + 4 * FF * DM), 128, 256, 128}, {I_WD, 2 * DM * FF, 0, DM * FF, DM, FF, 0, DM, (int)(W_D + 2 * DM * FF), JNO, 0, 0},
    {I_XWQ, DM * DM, 0, 0, DM, DM, 0, DM, (int)W_XQ, JNO, 0, 0}, {I_XWKV, 2 * DM * DM, 0, 0, 2 * DM, DM, 0, 2 * DM, (int)W_XKV, JNO, 0, 0}, {I_XWO, DM * DM, 0, 0, DM, DM, 0, DM, (int)W_XO, JNO, 0, 0},
    {I_EWIN, 0, DM * EV_IN, 0, EV_IN, DM, 0, EV_IN, (int)W_IN, JNO, 0, 0}, {I_EWOUT, 0, DM * DM, 0, DM, DM, 0, DM, (int)W_OUT, JNO, 0, 0} };
__device__ const int JT_ODD[NJ_ODD][12] = {
    {I_WG, 2 * DM * FF, 0, 0, FF, DM, 0, FF, (int)W_GU, 128, 256, 0}, {I_WU, 2 * DM * FF, 0, 0, FF, DM, 0, FF, (int)W_GU, 128, 256, 128}, {I_WD, 2 * DM * FF, 0, 0, DM, FF, 0, DM, (int)W_D, JNO, 0, 0},
    {I_WG, 2 * DM * FF, 0, DM * FF, FF, DM, 0, FF, (int)(W_GU + 4 * FF * DM), 128, 256, 0}, {I_WU, 2 * DM * FF, 0, DM * FF, FF, DM, 0, FF, (int)(W_GU + 4 * FF * DM), 128, 256, 128}, {I_WD, 2 * DM * FF, 0, DM * FF, DM, FF, 0, DM, (int)(W_D + 2 * DM * FF), JNO, 0, 0},
    {I_XWQ, DM * DM, 0, 0, DM, DM, 0, DM, (int)W_XQ, JNO, 0, 0}, {I_XWKV, 2 * DM * DM, 0, 0, 2 * DM, DM, 0, 2 * DM, (int)W_XKV, JNO, 0, 0}, {I_XWO, DM * DM, 0, 0, DM, DM, 0, DM, (int)W_XO, JNO, 0, 0},
    {I_OWIN, 0, DM * OD_IN, 0, OD_IN, DM, 0, 512, (int)W_IN, JNO, 0, 0}, {I_OWIN, 0, DM * OD_IN, 0, OD_IN, DM, 512, 128, (int)W_IN, JNO, 0, 512}, {I_OWIN, 0, DM * OD_IN, 0, OD_IN, DM, 640, 128, (int)W_IN, JNO, 0, 640},
    {I_OWIN, 0, DM * OD_IN, 0, OD_IN, DM, 768, 128, (int)W_IN, JNO, 0, 768}, {I_OWIN, 0, DM * OD_IN, 0, OD_IN, DM, 1024, 128, (int)W_IN, JNO, 0, 896}, {I_OWIN, 0, DM * OD_IN, 0, OD_IN, DM, 1816, 128, (int)W_IN, JNO, 0, 1024},
    {I_OWIN, 0, DM * OD_IN, 0, OD_IN, DM, 1304, 512, (int)W_IN, JNO, 0, 1152}, {I_OWIN, 0, DM * OD_IN, 0, OD_IN, DM, 1280, 24, (int)W_IN, JNO, 0, 1664},
    {I_OWIN, 0, DM * OD_IN, 0, OD_IN, DM, 896, 128, (int)(W_IN + 2 * OD_PITCH * DM), JNO, 0, 0}, {I_OWIN, 0, DM * OD_IN, 0, OD_IN, DM, 1152, 128, (int)(W_IN + 2 * OD_PITCH * DM), JNO, 0, 128}, {I_OWIN, 0, DM * OD_IN, 0, OD_IN, DM, 1944, 128, (int)(W_IN + 2 * OD_PITCH * DM), JNO, 0, 256},
    {I_OWOUT, 0, DM * DM, 0, DM, DM, 0, DM, (int)W_OUT, JNO, 0, 0},
    {I_CW1, 0, 2 * 2048 * 256, 0, 256, 2048, 0, 256, (int)W_C1, JNO, 0, 0}, {I_CW1, 0, 2 * 2048 * 256, 2048 * 256, 256, 2048, 0, 256, (int)(W_C1 + 2 * 256 * 2048), JNO, 0, 0},
    {I_CW2, 0, 2 * 256 * 64, 0, 64, 256, 0, 64, (int)W_C2, JNO, 0, 0}, {I_CW2, 0, 2 * 256 * 64, 256 * 64, 64, 256, 0, 64, (int)(W_C2 + 2 * 64 * 256), JNO, 0, 0} };

DI void transpose_item(const float* src, bf16_t* dst, int ldw, int K, int c0, int ncols, int G, int GS, int off, int nblk, int item, LAS float* scr, int lane) {
    const int kb = item / nblk, nb = item % nblk, k0 = 64 * kb, n0 = 32 * nb;
    const int cl = n0 + (lane & 31); const bool okc = cl < ncols;
#pragma unroll 8
    for (int i = 0; i < 32; ++i) { const int kk = 2 * i + (lane >> 5); scr[kk * 33 + (lane & 31)] = okc ? src[(size_t)(k0 + kk) * ldw + c0 + cl] : 0.f; }
    LDS_WAIT(); asm volatile("" ::: "memory");
    const int c = lane & 7;
#pragma unroll
    for (int j = 0; j < 4; ++j) { const int n = (lane >> 3) + 8 * j; const LAS float* s = scr + (8 * c) * 33 + n;
        u32x4 o; o.x = pk2(s[0 * 33], s[1 * 33]); o.y = pk2(s[2 * 33], s[3 * 33]); o.z = pk2(s[4 * 33], s[5 * 33]); o.w = pk2(s[6 * 33], s[7 * 33]);
        const int cc = n0 + n; const int drow = (cc / G) * GS + off + (cc % G);
        *(u32x4*)(dst + (size_t)drow * K + k0 + 8 * c) = o; }
    LDS_WAIT(); asm volatile("" ::: "memory");
}
DI void layer_prologue(KP kp, const Args& a, int layer, LAS unsigned char* lds, int tid, int wave, int lane, int gw, int NGW) {
    LAS int* item0 = (LAS int*)(lds + 8 * 8448);
    unsigned char* ws = a.ws; unsigned char* W = ws + WS_W; const int li = layer >> 1; const bool odd = (layer & 1) != 0;
    const int nj = odd ? NJ_ODD : NJ_EVEN; const int (*JT)[12] = odd ? JT_ODD : JT_EVEN;
    if (tid == 0) { int items = 0; for (int j = 0; j < nj; ++j) { item0[j] = items; items += ((JT[j][7] + 31) / 32) * (JT[j][5] / 64); } item0[nj] = items; }
    __syncthreads();
    const int nitems = item0[nj];
    LAS float* scr = (LAS float*)(lds + wave * 8448);
    for (int it = gw; it < nitems; it += NGW) {
        int j = 0;
        while (j + 1 < nj && item0[j + 1] <= it) ++j;
        j = __builtin_amdgcn_readfirstlane(j);
        const int* J = JT[j];
        const float* src = kp->in[J[0]] + ((size_t)layer * J[1] + (size_t)li * J[2] + J[3]);
        transpose_item(src, (bf16_t*)(W + J[8]), J[4], J[5], J[6], J[7], J[9], J[10], J[11], (J[7] + 31) / 32, it - item0[j], scr, lane);
    }
    if (odd) {
        float* bias1 = (float*)(ws + WS_BIAS1);
        for (int o = gw; o < 512; o += NGW) { const int kv = o >> 8, col = o & 255;
            const float* pe = a.in[I_CPE] + (size_t)(li * 2 + kv) * 2048; const float* w1 = a.in[I_CW1] + (size_t)(li * 2 + kv) * 2048 * 256 + col;
            float s = 0.f;
            for (int k = lane; k < 2048; k += 64) s += pe[k] * w1[(size_t)k * 256];
            s = wave_sum(s); if (lane == 0) bias1[o] = s; }
    }
    if (layer == 0) {
        float* ct = (float*)(ws + WS_COS); float* st = (float*)(ws + WS_SIN);
        const int gt = gw * 64 + lane, NT = NGW * 64;
        for (int e = gt; e < SEQ * 64; e += NT) { const int pos = e >> 6, i = e & 63;
            const float ang = (float)pos * INVF[i];
            float sv, cv; sincos_acc(ang, sv, cv); ct[e] = cv; st[e] = sv; }
        const float* mem = a.in[I_MEM]; const float* mw = a.in[I_MNORMW]; bf16_t* memn = (bf16_t*)(ws + WS_MEMN);
        for (int m = gw; m < NB * MEMLEN; m += NGW) {
            const f32x4* xr = (const f32x4*)(mem + (size_t)m * DM) + lane; f32x4 v[4]; float s = 0.f;
#pragma unroll
            for (int j = 0; j < 4; ++j) { v[j] = xr[64 * j]; s += (v[j].x * v[j].x + v[j].y * v[j].y) + (v[j].z * v[j].z + v[j].w * v[j].w); }
            const float r = 1.0f / sqrtf(wave_sum(s) * (1.f / DM) + EPS);
#pragma unroll
            for (int j = 0; j < 4; ++j) { const f32x4 w = ((const f32x4*)mw)[lane + 64 * j];
                u32x2 o; o.x = pk2(v[j].x * r * w.x, v[j].y * r * w.y); o.y = pk2(v[j].z * r * w.z, v[j].w * r * w.w);
                *(u32x2*)(memn + (size_t)m * DM + 4 * (lane + 64 * j)) = o; }
        }
    }
}

DI void norm_phase(const float* x, const float* w, bf16_t* h, int gw, int NGW, int lane) {
    f32x4 wv[4];
#pragma unroll
    for (int j = 0; j < 4; ++j) wv[j] = ((const f32x4*)w)[lane + 64 * j];
    for (int m = gw; m < MTOK; m += NGW) {
        const f32x4* xr = (const f32x4*)(x + (size_t)m * DM) + lane; f32x4 v[4]; float s = 0.f;
#pragma unroll
        for (int j = 0; j < 4; ++j) { v[j] = xr[64 * j]; s += (v[j].x * v[j].x + v[j].y * v[j].y) + (v[j].z * v[j].z + v[j].w * v[j].w); }
        const float r = 1.0f / sqrtf(wave_sum(s) * (1.f / DM) + EPS);
#pragma unroll
        for (int j = 0; j < 4; ++j) { u32x2 o; o.x = pk2(v[j].x * r * wv[j].x, v[j].y * r * wv[j].y); o.y = pk2(v[j].z * r * wv[j].z, v[j].w * r * wv[j].w);
            *(u32x2*)(h + (size_t)m * DM + 4 * (lane + 64 * j)) = o; }
    }
}
DI void final_norm_phase(const float* x, const float* w, float* out, int gw, int NGW, int lane) {
    f32x4 wv[4];
#pragma unroll
    for (int j = 0; j < 4; ++j) wv[j] = ((const f32x4*)w)[lane + 64 * j];
    for (int m = gw; m < MTOK; m += NGW) {
        const f32x4* xr = (const f32x4*)(x + (size_t)m * DM) + lane; f32x4 v[4]; float s = 0.f;
#pragma unroll
        for (int j = 0; j < 4; ++j) { v[j] = xr[64 * j]; s += (v[j].x * v[j].x + v[j].y * v[j].y) + (v[j].z * v[j].z + v[j].w * v[j].w); }
        const float r = 1.0f / sqrtf(wave_sum(s) * (1.f / DM) + EPS);
#pragma unroll
        for (int j = 0; j < 4; ++j) ((f32x4*)(out + (size_t)m * DM))[lane + 64 * j] = v[j] * r * wv[j];
    }
}

constexpr int TP = 136;

DI void e0_unit(const Args& a, int li, int unit, LAS unsigned char* lds, int tid, int wave, int lane) {
    unsigned char* R = a.ws + WS_R;
    bf16_t* PROJ = (bf16_t*)(R + R_PROJ); bf16_t* CONV = (bf16_t*)(R + R_CONV); bf16_t* XDT = (bf16_t*)(R + R_XDT); float* CUMS = (float*)(R + R_CUMS);
    const float* COS = (const float*)(a.ws + WS_COS); const float* SIN = (const float*)(a.ws + WS_SIN);
    const int half = unit & 1, c = (unit >> 1) & 31, b = unit >> 6;
    const int crow0 = b * SEQ + c * 128;
    LAS float* dts = (LAS float*)lds;
    LAS float* das = dts + 1024;
    LAS float* cus = das + 1024;
    __syncthreads();
#pragma unroll
    for (int k = 0; k < 2; ++k) { const int idx = tid + 512 * k, l = idx >> 3, hd = idx & 7;
        const float raw = bf2f(PROJ[(size_t)(crow0 + l) * EV_PITCH + 3328 + hd]) + a.in[I_DTB][li * 8 + hd];
        const float dt = raw > 20.f ? raw : log1pf(expf(raw));
        const float av = -expf(a.in[I_ALOG][li * 8 + hd]);
        dts[l * 8 + hd] = dt; das[l * 8 + hd] = dt * av; }
    __syncthreads();
    {
        const float v0 = das[(2 * lane) * 8 + wave], v1 = das[(2 * lane + 1) * 8 + wave]; float s = v0 + v1;
#pragma unroll
        for (int o = 1; o < 64; o <<= 1) { const float t = __shfl_up(s, o); if (lane >= o) s += t; }
        cus[(2 * lane) * 8 + wave] = s - v1; cus[(2 * lane + 1) * 8 + wave] = s; }
    __syncthreads();
    for (int idx = tid; idx < 64 * 16; idx += 512) { const int rl = idx >> 4, k = idx & 15, l = half * 64 + rl; float v = 0.f;
        if (k < 8) v = cus[l * 8 + k]; else if (k < 12) v = (float)(l + 1) * log1pf(-exp2f(-5.0f - (float)(k - 8)));
        CUMS[(size_t)(crow0 + l) * 16 + k] = v; }
    const int r0 = crow0 + half * 64, pos0 = c * 128 + half * 64;
    for (int it = tid; it < 64 * 128; it += 512) { const int rl = it >> 7, ch = it & 127, col = ch * 8, i0 = (col & 127) >> 1;
        const f32x4 cs = *(const f32x4*)(COS + (size_t)(pos0 + rl) * 64 + i0), sn = *(const f32x4*)(SIN + (size_t)(pos0 + rl) * 64 + i0);
        u32x4* p = (u32x4*)(PROJ + (size_t)(r0 + rl) * EV_PITCH + col); const u32x4 v = *p; const float sc = col >= 512 ? 0.08838834764831845f : 1.0f; u32x4 o;
#pragma unroll
        for (int e = 0; e < 4; ++e) { const float t1 = bflo(v[e]), t2 = bfhi(v[e]); o[e] = pk2((t1 * cs[e] - t2 * sn[e]) * sc, (t1 * sn[e] + t2 * cs[e]) * sc); }
        *p = o; }
    const float* cw = a.in[I_CONVW] + (size_t)li * 4 * 768; const float* cb = a.in[I_CONVB] + (size_t)li * 768;
    for (int it = tid; it < 64 * 96; it += 512) { const int rl = it / 96, ch = (it % 96) * 8; const int pos = pos0 + rl;
        float acc[8];
        { const f32x4 b0 = *(const f32x4*)(cb + ch), b1 = *(const f32x4*)(cb + ch + 4); acc[0] = b0.x; acc[1] = b0.y; acc[2] = b0.z; acc[3] = b0.w; acc[4] = b1.x; acc[5] = b1.y; acc[6] = b1.z; acc[7] = b1.w; }
#pragma unroll
        for (int i = 0; i < 4; ++i) { const int ps = pos - 3 + i; if (ps >= 0) {
            const u32x4 v = *(const u32x4*)(PROJ + (size_t)(b * SEQ + ps) * EV_PITCH + 2560 + ch);
            const f32x4 w0 = *(const f32x4*)(cw + i * 768 + ch), w1 = *(const f32x4*)(cw + i * 768 + ch + 4);
            acc[0] += w0.x * bflo(v.x); acc[1] += w0.y * bfhi(v.x); acc[2] += w0.z * bflo(v.y); acc[3] += w0.w * bfhi(v.y);
            acc[4] += w1.x * bflo(v.z); acc[5] += w1.y * bfhi(v.z); acc[6] += w1.z * bflo(v.w); acc[7] += w1.w * bfhi(v.w); } }
#pragma unroll
        for (int e = 0; e < 8; ++e) acc[e] = silu_f(acc[e]);
        u32x4 o; o.x = pk2(acc[0], acc[1]); o.y = pk2(acc[2], acc[3]); o.z = pk2(acc[4], acc[5]); o.w = pk2(acc[6], acc[7]);
        *(u32x4*)(CONV + (size_t)(r0 + rl) * 768 + ch) = o;
        if (ch < 512) { const float dt = dts[(half * 64 + rl) * 8 + (ch >> 6)];
            u32x4 x; x.x = pk2(acc[0] * dt, acc[1] * dt); x.y = pk2(acc[2] * dt, acc[3] * dt); x.z = pk2(acc[4] * dt, acc[5] * dt); x.w = pk2(acc[6] * dt, acc[7] * dt);
            *(u32x4*)(XDT + (size_t)(r0 + rl) * 512 + ch) = x; } }
}

template <int NCOL, bool WEIGHT>
DI void stage_T(const bf16_t* src, int ld, LAS bf16_t* dstT, const float* cum, int tid) {
    constexpr int CPR = NCOL / 8;
    float cl = 0.f; if (WEIGHT) cl = cum[127 * 16];
    for (int it = tid; it < 128 * CPR; it += 512) { const int j = it / CPR, ch = it % CPR;
        const u32x4 v = *(const u32x4*)(src + (size_t)j * ld + ch * 8);
        float w = 1.f; if (WEIGHT) w = ex2((cl - cum[j * 16]) * LOG2E);
#pragma unroll
        for (int e = 0; e < 4; ++e) { float lo = bflo(v[e]), hi = bfhi(v[e]); if (WEIGHT) { lo *= w; hi *= w; }
            dstT[(ch * 8 + 2 * e) * TP + j] = f2bf(lo); dstT[(ch * 8 + 2 * e + 1) * TP + j] = f2bf(hi); } }
}
template <int NCOL>
DI void stage_N(const bf16_t* src, int ld, LAS bf16_t* dst, int tid) {
    constexpr int CPR = NCOL / 8;
    for (int it = tid; it < 128 * CPR; it += 512) { const int j = it / CPR, ch = it % CPR;
        *(LAS u32x4*)(dst + j * (NCOL + 8) + ch * 8) = *(const u32x4*)(src + (size_t)j * ld + ch * 8); }
}

template <int DK, int DV>
DI void e1_unit(const bf16_t* Kp, int ldk, const bf16_t* Vp, int ldv, const float* cum, float* st, LAS unsigned char* lds, int tid, int wave, int lane) {
    LAS bf16_t* KT = (LAS bf16_t*)lds; LAS bf16_t* VT = KT + DK * TP;
    __syncthreads();
    stage_T<DK, false>(Kp, ldk, KT, cum, tid);
    stage_T<DV, true>(Vp, ldv, VT, cum, tid);
    __syncthreads();
    constexpr int NTILES = DK / 16, TPW = (DV / 16) * NTILES / 8;
    const int lr = lane & 15, lq = lane >> 4; const int mt = (wave * TPW) / NTILES, nt0 = (wave * TPW) % NTILES;
    f32x4 acc[TPW];
#pragma unroll
    for (int i = 0; i < TPW; ++i) acc[i] = (f32x4){0.f, 0.f, 0.f, 0.f};
#pragma unroll
    for (int ks = 0; ks < 4; ++ks) { const bf16x8 xf = *(const LAS bf16x8*)(VT + (mt * 16 + lr) * TP + ks * 32 + lq * 8);
#pragma unroll
        for (int i = 0; i < TPW; ++i) { const bf16x8 yf = *(const LAS bf16x8*)(KT + ((nt0 + i) * 16 + lr) * TP + ks * 32 + lq * 8); acc[i] = mfma16(xf, yf, acc[i]); } }
#pragma unroll
    for (int i = 0; i < TPW; ++i)
#pragma unroll
        for (int t = 0; t < 4; ++t) st[(size_t)(mt * 16 + 4 * lq + t) * DK + (nt0 + i) * 16 + lr] = acc[i][t];
}

template <int DK, int DV, bool RET>
DI void e3_unit(const bf16_t* Qp, int ldq, const bf16_t* Kp, int ldk, const bf16_t* Vp, int ldv, const float* cum, const bf16_t* Sin,
                const bf16_t* gz, int ldgz, const bf16_t* xs, float dskip, bf16_t* outp, int ldo, LAS unsigned char* lds, int tid, int wave, int lane) {
    constexpr int QP = DK + 8;
    LAS bf16_t* Qs = (LAS bf16_t*)lds; LAS bf16_t* Ks = Qs + 128 * QP; LAS bf16_t* VT = Ks + 128 * QP; LAS bf16_t* P = VT + DV * TP; LAS float* cumL = (LAS float*)(P + 128 * TP);
    __syncthreads();
    stage_N<DK>(Qp, ldq, Qs, tid); stage_N<DK>(Kp, ldk, Ks, tid); stage_T<DV, false>(Vp, ldv, VT, cum, tid);
    if (tid < 128) cumL[tid] = cum[tid * 16];
    __syncthreads();
    const int lr = lane & 15, lq = lane >> 4, i0 = wave * 16;
    bf16x8 qf[DK / 32];
#pragma unroll
    for (int ks = 0; ks < DK / 32; ++ks) qf[ks] = *(const LAS bf16x8*)(Qs + (i0 + lr) * QP + ks * 32 + lq * 8);
    float ci[4];
#pragma unroll
    for (int t = 0; t < 4; ++t) ci[t] = cumL[i0 + 4 * lq + t];
#pragma unroll
    for (int nt = 0; nt < 8; ++nt) {
        f32x4 s = (f32x4){0.f, 0.f, 0.f, 0.f};
        if (nt <= wave) {
#pragma unroll
            for (int ks = 0; ks < DK / 32; ++ks) { const bf16x8 kf = *(const LAS bf16x8*)(Ks + (nt * 16 + lr) * QP + ks * 32 + lq * 8); s = mfma16(qf[ks], kf, s); }
        }
        const int j = nt * 16 + lr; const float cj = cumL[j];
#pragma unroll
        for (int t = 0; t < 4; ++t) { const int i = i0 + 4 * lq + t; const float p = (i >= j) ? s[t] * ex2((ci[t] - cj) * LOG2E) : 0.f; P[i * TP + j] = f2bf(p); }
    }
    f32x4 o[DV / 16];
#pragma unroll
    for (int nt = 0; nt < DV / 16; ++nt) { o[nt] = (f32x4){0.f, 0.f, 0.f, 0.f};
#pragma unroll
        for (int ks = 0; ks < DK / 32; ++ks) { const bf16x8 sf = *(const bf16x8*)(Sin + (size_t)(nt * 16 + lr) * DK + ks * 32 + lq * 8); o[nt] = mfma16(qf[ks], sf, o[nt]); }
#pragma unroll
        for (int t = 0; t < 4; ++t) o[nt][t] *= ex2(ci[t] * LOG2E); }
    LDS_WAIT();
#pragma unroll
    for (int ks = 0; ks < 4; ++ks) { const bf16x8 pf = *(const LAS bf16x8*)(P + (i0 + lr) * TP + ks * 32 + lq * 8);
#pragma unroll
        for (int nt = 0; nt < DV / 16; ++nt) { const bf16x8 vf = *(const LAS bf16x8*)(VT + (nt * 16 + lr) * TP + ks * 32 + lq * 8); o[nt] = mfma16(pf, vf, o[nt]); } }
    if (RET) {
        float rs[4];
#pragma unroll
        for (int t = 0; t < 4; ++t) { float ss = 0.f;
#pragma unroll
            for (int nt = 0; nt < DV / 16; ++nt) ss += o[nt][t] * o[nt][t];
            ss = grp16_sum(ss); rs[t] = 1.0f / sqrtf(ss * (1.0f / DV) + EPS); }
#pragma unroll
        for (int nt = 0; nt < DV / 16; ++nt)
#pragma unroll
            for (int t = 0; t < 4; ++t) { const int i = i0 + 4 * lq + t; const float g = bf2f(gz[(size_t)i * ldgz + nt * 16 + lr]);
                outp[(size_t)i * ldo + nt * 16 + lr] = f2bf(o[nt][t] * rs[t] * silu_f(g)); }
    } else {
#pragma unroll
        for (int nt = 0; nt < DV / 16; ++nt)
#pragma unroll
            for (int t = 0; t < 4; ++t) { const int i = i0 + 4 * lq + t; const float z = bf2f(gz[(size_t)i * ldgz + nt * 16 + lr]); const float xv = bf2f(xs[(size_t)i * 768 + nt * 16 + lr]);
                outp[(size_t)i * ldo + nt * 16 + lr] = f2bf((o[nt][t] + dskip * xv) * silu_f(z)); }
    }
}

DI void e1_phase(const Args& a, LAS unsigned char* lds, int tid, int wave, int lane, int bid, int G) {
    unsigned char* R = a.ws + WS_R; const bf16_t* PROJ = (const bf16_t*)(R + R_PROJ); const bf16_t* CONV = (const bf16_t*)(R + R_CONV); const bf16_t* XDT = (const bf16_t*)(R + R_XDT); const float* CUMS = (const float*)(R + R_CUMS);
    for (int u = bid; u < 1536; u += G) {
        if (u < 512) { const int b = u >> 7, c = (u >> 2) & 31, h = u & 3; const size_t row0 = (size_t)b * SEQ + c * 128;
            e1_unit<128, 128>(PROJ + row0 * EV_PITCH + 512 + h * 128, EV_PITCH, PROJ + row0 * EV_PITCH + 1024 + h * 128, EV_PITCH, CUMS + row0 * 16 + 8 + h,
                              (float*)(R + R_STR) + ((size_t)(b * 4 + h) * 32 + c) * 16384, lds, tid, wave, lane);
        } else { const int v = u - 512, b = v >> 8, c = (v >> 3) & 31, hd = v & 7, g = hd >> 2; const size_t row0 = (size_t)b * SEQ + c * 128;
            e1_unit<64, 64>(CONV + row0 * 768 + 512 + g * 64, 768, XDT + row0 * 512 + hd * 64, 512, CUMS + row0 * 16 + hd,
                            (float*)(R + R_STS) + ((size_t)(b * 8 + hd) * 32 + c) * 4096, lds, tid, wave, lane);
        }
    }
}
DI void e2_phase(const Args& a, int tid, int bid, int G) {
    unsigned char* R = a.ws + WS_R; const float* CUMS = (const float*)(R + R_CUMS);
    const float* STR = (const float*)(R + R_STR); const float* STS = (const float*)(R + R_STS); bf16_t* SINR = (bf16_t*)(R + R_SINR); bf16_t* SINS = (bf16_t*)(R + R_SINS);
    for (int idx = bid * 512 + tid; idx < 262144 + 131072; idx += G * 512) {
        if (idx < 262144) { const int bh = idx >> 14, el = idx & 16383, b = bh >> 2, h = bh & 3; float run = 0.f;
            for (int c = 0; c < 32; ++c) { const size_t o = ((size_t)bh * 32 + c) * 16384 + el; SINR[o] = f2bf(run);
                const float dec = expf(CUMS[((size_t)b * SEQ + c * 128 + 127) * 16 + 8 + h]); run = dec * run + STR[o]; }
        } else { const int e = idx - 262144, bh = e >> 12, el = e & 4095, b = bh >> 3, hd = bh & 7; float run = 0.f;
            for (int c = 0; c < 32; ++c) { const size_t o = ((size_t)bh * 32 + c) * 4096 + el; SINS[o] = f2bf(run);
                const float dec = expf(CUMS[((size_t)b * SEQ + c * 128 + 127) * 16 + hd]); run = dec * run + STS[o]; }
        }
    }
}
DI void e3_phase(const Args& a, int li, LAS unsigned char* lds, int tid, int wave, int lane, int bid, int G) {
    unsigned char* R = a.ws + WS_R; const bf16_t* PROJ = (const bf16_t*)(R + R_PROJ); const bf16_t* CONV = (const bf16_t*)(R + R_CONV); const bf16_t* XDT = (const bf16_t*)(R + R_XDT); const float* CUMS = (const float*)(R + R_CUMS);
    bf16_t* MIX = (bf16_t*)(a.ws + WS_H); bf16_t* YP = (bf16_t*)(R + R_YP);
    for (int u = bid; u < 1536; u += G) {
        if (u < 512) { const int b = u >> 7, c = (u >> 2) & 31, h = u & 3; const size_t row0 = (size_t)b * SEQ + c * 128; const bf16_t* pr = PROJ + row0 * EV_PITCH;
            e3_unit<128, 128, true>(pr + h * 128, EV_PITCH, pr + 512 + h * 128, EV_PITCH, pr + 1024 + h * 128, EV_PITCH, CUMS + row0 * 16 + 8 + h,
                                    (const bf16_t*)(R + R_SINR) + ((size_t)(b * 4 + h) * 32 + c) * 16384, pr + 1536 + h * 128, EV_PITCH, nullptr, 0.f,
                                    MIX + row0 * DM + h * 128, DM, lds, tid, wave, lane);
        } else { const int v = u - 512, b = v >> 8, c = (v >> 3) & 31, hd = v & 7, g = hd >> 2; const size_t row0 = (size_t)b * SEQ + c * 128;
            e3_unit<64, 64, false>(CONV + row0 * 768 + 640 + g * 64, 768, CONV + row0 * 768 + 512 + g * 64, 768, XDT + row0 * 512 + hd * 64, 512, CUMS + row0 * 16 + hd,
                                   (const bf16_t*)(R + R_SINS) + ((size_t)(b * 8 + hd) * 32 + c) * 4096, PROJ + row0 * EV_PITCH + 2048 + hd * 64, EV_PITCH,
                                   CONV + row0 * 768 + hd * 64, a.in[I_SSMD][li * 8 + hd], YP + row0 * 512 + hd * 64, 512, lds, tid, wave, lane);
        }
    }
}
DI void e4_phase(const Args& a, int li, int gw, int NGW, int lane) {
    const bf16_t* YP = (const bf16_t*)(a.ws + WS_R + R_YP); bf16_t* MIX = (bf16_t*)(a.ws + WS_H); const float* nw = a.in[I_SSMNW] + (size_t)li * 512;
    const f32x4 w0 = *(const f32x4*)(nw + lane * 8), w1 = *(const f32x4*)(nw + lane * 8 + 4);
    for (int m = gw; m < MTOK; m += NGW) {
        const u32x4 v = *(const u32x4*)(YP + (size_t)m * 512 + lane * 8);
        float f[8] = {bflo(v.x), bfhi(v.x), bflo(v.y), bfhi(v.y), bflo(v.z), bfhi(v.z), bflo(v.w), bfhi(v.w)}; float s = 0.f;
#pragma unroll
        for (int e = 0; e < 8; ++e) s += f[e] * f[e];
        const float r = 1.0f / sqrtf(wave_sum(s) * (1.f / 512.f) + EPS);
        u32x4 o; o.x = pk2(f[0] * r * w0.x, f[1] * r * w0.y); o.y = pk2(f[2] * r * w0.z, f[3] * r * w0.w); o.z = pk2(f[4] * r * w1.x, f[5] * r * w1.y); o.w = pk2(f[6] * r * w1.z, f[7] * r * w1.w);
        *(u32x4*)(MIX + (size_t)m * DM + 512 + lane * 8) = o;
    }
}

template <int MT, int HD, class MaskF>
DI void flash_block(const bf16x8 (&qf)[MT][HD / 32], const bf16_t* Kb, int ldk, const bf16_t* Vt, int ldv,
                    f32x4 (&o)[MT][HD / 16], float (&mrow)[MT][4], float (&lrow)[MT][4], LAS bf16_t* pbuf, float c2, const MaskF& mk, int key0, int lr, int lq) {
    constexpr int PP = 72;
    f32x4 s[MT][4];
#pragma unroll
    for (int mt = 0; mt < MT; ++mt)
#pragma unroll
        for (int nt = 0; nt < 4; ++nt) s[mt][nt] = (f32x4){0.f, 0.f, 0.f, 0.f};
#pragma unroll
    for (int nt = 0; nt < 4; ++nt)
#pragma unroll
        for (int ks = 0; ks < HD / 32; ++ks) { const bf16x8 kf = *(const bf16x8*)(Kb + (size_t)(nt * 16 + lr) * ldk + ks * 32 + lq * 8);
#pragma unroll
            for (int mt = 0; mt < MT; ++mt) s[mt][nt] = mfma16(qf[mt][ks], kf, s[mt][nt]); }
#pragma unroll
    for (int mt = 0; mt < MT; ++mt) {
#pragma unroll
        for (int nt = 0; nt < 4; ++nt) { const bool ok = mk.ok(mt, key0 + nt * 16 + lr);
#pragma unroll
            for (int t = 0; t < 4; ++t) s[mt][nt][t] = ok ? s[mt][nt][t] * c2 : -INFINITY; }
#pragma unroll
        for (int t = 0; t < 4; ++t) {
            float mx = fmaxf(fmaxf(s[mt][0][t], s[mt][1][t]), fmaxf(s[mt][2][t], s[mt][3][t])); mx = grp16_max(mx);
            const float mnew = fmaxf(mrow[mt][t], mx), alpha = ex2(mrow[mt][t] - mnew); mrow[mt][t] = mnew;
            float ps = 0.f;
#pragma unroll
            for (int nt = 0; nt < 4; ++nt) { const float p = ex2(s[mt][nt][t] - mnew); s[mt][nt][t] = p; ps += p; }
            lrow[mt][t] = lrow[mt][t] * alpha + ps;
#pragma unroll
            for (int nt = 0; nt < HD / 16; ++nt) o[mt][nt][t] *= alpha;
        }
#pragma unroll
        for (int nt = 0; nt < 4; ++nt)
#pragma unroll
            for (int t = 0; t < 4; ++t) pbuf[(mt * 16 + 4 * lq + t) * PP + nt * 16 + lr] = f2bf(s[mt][nt][t]);
    }
    LDS_WAIT();
#pragma unroll
    for (int ks = 0; ks < 2; ++ks) { bf16x8 pf[MT];
#pragma unroll
        for (int mt = 0; mt < MT; ++mt) pf[mt] = *(const LAS bf16x8*)(pbuf + (mt * 16 + lr) * PP + ks * 32 + lq * 8);
#pragma unroll
        for (int nt = 0; nt < HD / 16; ++nt) { const bf16x8 vf = *(const bf16x8*)(Vt + (size_t)(nt * 16 + lr) * ldv + ks * 32 + lq * 8);
#pragma unroll
            for (int mt = 0; mt < MT; ++mt) o[mt][nt] = mfma16(pf[mt], vf, o[mt][nt]); } }
    LDS_WAIT();
}
struct NoMask { DI bool ok(int, int) const { return true; } };
struct WinMask { int W; int tpos[2]; DI bool ok(int mt, int key) const { return key <= tpos[mt] && tpos[mt] - key < W; } };
struct SelMask { unsigned long long sm[2]; int jb; int tpos[2]; DI bool ok(int mt, int key) const { return ((sm[mt] >> jb) & 1ull) != 0ull && key <= tpos[mt]; } };

struct CmpOrder {
    int G, c; const char* P; const char* W1;
    DI bool next(int i, pg8::Unit& u) const { const int L = i * G + c; if (L >= 16) return false; u.pm = L & 7; u.pn = L >> 3; const int b = u.pm >> 1, g = u.pm & 1;
        u.a = P + ((size_t)b * SEQ * OD_PITCH + 512 + u.pn * 128 + g * 64) * 2; u.b = W1 + (size_t)u.pn * 256 * 2048 * 2; return true; }
};
DI void o2_phase(const Args& a, int gw, int lane) {
    if (gw >= 128) return;
    unsigned char* R = a.ws + WS_R; const bf16_t* HIDC = (const bf16_t*)(R + R_HIDC); const bf16_t* W2T = (const bf16_t*)(a.ws + WS_W + W_C2);
    bf16_t* KC = (bf16_t*)(R + R_KC); bf16_t* VCT = (bf16_t*)(R + R_VCT);
    const int kv = gw >> 6, bg = (gw >> 3) & 7, n0 = (gw & 7) * 32, lr = lane & 15, lq = lane >> 4;
    const bf16_t* hid = HIDC + ((size_t)(kv * 8 + bg) * 256) * 256; const bf16_t* w2 = W2T + (size_t)kv * 64 * 256;
    if (kv == 0) {
        f32x4 acc[2][4];
#pragma unroll
        for (int mt = 0; mt < 2; ++mt)
#pragma unroll
            for (int nt = 0; nt < 4; ++nt) acc[mt][nt] = (f32x4){0.f, 0.f, 0.f, 0.f};
#pragma unroll
        for (int ks = 0; ks < 8; ++ks) { bf16x8 xf[2];
#pragma unroll
            for (int mt = 0; mt < 2; ++mt) xf[mt] = *(const bf16x8*)(hid + (size_t)(n0 + mt * 16 + lr) * 256 + ks * 32 + lq * 8);
#pragma unroll
            for (int nt = 0; nt < 4; ++nt) { const bf16x8 yf = *(const bf16x8*)(w2 + (size_t)(nt * 16 + lr) * 256 + ks * 32 + lq * 8);
#pragma unroll
                for (int mt = 0; mt < 2; ++mt) acc[mt][nt] = mfma16(xf[mt], yf, acc[mt][nt]); } }
#pragma unroll
        for (int mt = 0; mt < 2; ++mt)
#pragma unroll
            for (int nt = 0; nt < 4; ++nt)
#pragma unroll
                for (int t = 0; t < 4; ++t) KC[((size_t)bg * 256 + n0 + mt * 16 + 4 * lq + t) * 64 + nt * 16 + lr] = f2bf(acc[mt][nt][t]);
    } else {
        f32x4 acc[4][2];
#pragma unroll
        for (int mt = 0; mt < 4; ++mt)
#pragma unroll
            for (int nt = 0; nt < 2; ++nt) acc[mt][nt] = (f32x4){0.f, 0.f, 0.f, 0.f};
#pragma unroll
        for (int ks = 0; ks < 8; ++ks) { bf16x8 yf[2];
#pragma unroll
            for (int nt = 0; nt < 2; ++nt) yf[nt] = *(const bf16x8*)(hid + (size_t)(n0 + nt * 16 + lr) * 256 + ks * 32 + lq * 8);
#pragma unroll
            for (int mt = 0; mt < 4; ++mt) { const bf16x8 xf = *(const bf16x8*)(w2 + (size_t)(mt * 16 + lr) * 256 + ks * 32 + lq * 8);
#pragma unroll
                for (int nt = 0; nt < 2; ++nt) acc[mt][nt] = mfma16(xf, yf[nt], acc[mt][nt]); } }
#pragma unroll
        for (int mt = 0; mt < 4; ++mt)
#pragma unroll
            for (int nt = 0; nt < 2; ++nt)
#pragma unroll
                for (int t = 0; t < 4; ++t) VCT[((size_t)bg * 64 + mt * 16 + 4 * lq + t) * 256 + n0 + nt * 16 + lr] = f2bf(acc[mt][nt][t]);
    }
}

constexpr int O3_WSZ = 16960;
DI void o3_unit(const Args& a, int li, int bg, int tile, LAS unsigned char* lds, int wave, int lane) {
    asm volatile("" : "+v"(lane));
    unsigned char* R = a.ws + WS_R; const bf16_t* PROJ = (const bf16_t*)(R + R_PROJ); const bf16_t* VTb = (const bf16_t*)(R + R_VT);
    const bf16_t* KC = (const bf16_t*)(R + R_KC); const bf16_t* VCT = (const bf16_t*)(R + R_VCT); bf16_t* MIX = (bf16_t*)(a.ws + WS_H);
    const int b = bg >> 1, g = bg & 1, t0 = tile * 64, lr = lane & 15, lq = lane >> 4; const size_t rowb = (size_t)b * SEQ;
    LAS float* PS = (LAS float*)(lds + wave * O3_WSZ); LAS bf16_t* PB = (LAS bf16_t*)(lds + wave * O3_WSZ + 8448); LAS unsigned long long* SELM = (LAS unsigned long long*)(lds + wave * O3_WSZ + 16896);
    const float c2 = 0.125f * LOG2E;
    int tpos[2]; tpos[0] = t0 + 8 * wave + lq; tpos[1] = tpos[0] + 4;
    bf16x8 qf[2][2];
#pragma unroll
    for (int mt = 0; mt < 2; ++mt)
#pragma unroll
        for (int ks = 0; ks < 2; ++ks) qf[mt][ks] = *(const bf16x8*)(PROJ + (rowb + t0 + 8 * wave + 4 * mt + (lr >> 2)) * OD_PITCH + g * 256 + (lr & 3) * 64 + ks * 32 + lq * 8);
#define GATE(mt, t, br) sigmoid_f(bf2f(PROJ[(rowb + tpos[mt]) * OD_PITCH + 1664 + g * 12 + (t) * 3 + (br)]))
#define OTIDX(mt, nt, t) (((mt) * 16 + 4 * lq + (t)) * 64 + (nt) * 16 + lr)
    f32x4 ot[2][4];
#pragma unroll
    for (int mt = 0; mt < 2; ++mt) {
        f32x4 s[16];
#pragma unroll
        for (int nt = 0; nt < 16; ++nt) { s[nt] = (f32x4){0.f, 0.f, 0.f, 0.f};
            if ((nt & 3) == 0) asm volatile("" ::: "memory");
#pragma unroll
            for (int ks = 0; ks < 2; ++ks) { const bf16x8 kf = *(const bf16x8*)(KC + ((size_t)bg * 256 + nt * 16 + lr) * 64 + ks * 32 + lq * 8); s[nt] = mfma16(qf[mt][ks], kf, s[nt]); } }
#pragma unroll
        for (int nt = 0; nt < 16; ++nt) { const int n = nt * 16 + lr; const bool ok = (n < 255) && (16 * n + 31 <= tpos[mt]);
#pragma unroll
            for (int t = 0; t < 4; ++t) s[nt][t] = ok ? s[nt][t] * c2 : -INFINITY; }
#pragma unroll
        for (int t = 0; t < 4; ++t) { float mx = s[0][t];
#pragma unroll
            for (int nt = 1; nt < 16; ++nt) mx = fmaxf(mx, s[nt][t]);
            mx = grp16_max(mx); const float mm = (mx == -INFINITY) ? 0.f : mx; float sum = 0.f;
#pragma unroll
            for (int nt = 0; nt < 16; ++nt) { const float p = ex2(s[nt][t] - mm); s[nt][t] = p; sum += p; }
            sum = grp16_sum(sum); const float inv = 1.0f / fmaxf(sum, 1e-30f);
#pragma unroll
            for (int nt = 0; nt < 16; ++nt) s[nt][t] *= inv; }
#pragma unroll
        for (int nt = 0; nt < 16; ++nt) { PS[(4 * mt + lq) * 264 + nt * 16 + lr] = (s[nt][0] + s[nt][1]) + (s[nt][2] + s[nt][3]);
#pragma unroll
            for (int t = 0; t < 4; ++t) PB[(4 * lq + t) * 264 + nt * 16 + lr] = f2bf(s[nt][t]); }
        LDS_WAIT();
#pragma unroll
        for (int nt = 0; nt < 4; ++nt) ot[mt][nt] = (f32x4){0.f, 0.f, 0.f, 0.f};
#pragma unroll
        for (int ks = 0; ks < 8; ++ks) { const bf16x8 pf = *(const LAS bf16x8*)(PB + lr * 264 + ks * 32 + lq * 8);
            if ((ks & 1) == 0) asm volatile("" ::: "memory");
#pragma unroll
            for (int nt = 0; nt < 4; ++nt) { const bf16x8 vf = *(const bf16x8*)(VCT + ((size_t)bg * 64 + nt * 16 + lr) * 256 + ks * 32 + lq * 8); ot[mt][nt] = mfma16(pf, vf, ot[mt][nt]); } }
        LDS_WAIT();
#pragma unroll
        for (int t = 0; t < 4; ++t) { const float g0 = GATE(mt, t, 0);
#pragma unroll
            for (int nt = 0; nt < 4; ++nt) ot[mt][nt][t] *= g0; }
    }
    unsigned long long wunion = 0ull;
    for (int tk = 0; tk < 8; ++tk) {
        const int j = lane, nlo = (4 * j - 1 < 0) ? 0 : 4 * j - 1, nhi = (4 * j + 3 > 254) ? 254 : 4 * j + 3; float imp = 0.f;
        for (int n = nlo; n <= nhi; ++n) imp += PS[tk * 264 + n];
        const bool valid = j <= tile, forced = valid && (j == 0 || j == tile || j == tile - 1);
        const float sc = forced ? 1e6f : (valid ? imp : -INFINITY);
        int rank = 0;
        for (int jp = 0; jp < 64; ++jp) { const float v = __shfl(sc, jp); rank += ((v > sc) || (v == sc && jp < j)) ? 1 : 0; }
        const unsigned long long m = __ballot(valid && rank < 16);
        wunion |= m; if (lane == 0) SELM[tk] = m;
    }
    LDS_WAIT();
#pragma unroll
    for (int mt = 0; mt < 2; ++mt)
#pragma unroll
        for (int nt = 0; nt < 4; ++nt)
#pragma unroll
            for (int t = 0; t < 4; ++t) PS[OTIDX(mt, nt, t)] = ot[mt][nt][t];
    LAS bf16_t* pbuf = PB;
    {
        SelMask mk; mk.sm[0] = SELM[lq]; mk.sm[1] = SELM[4 + lq]; mk.tpos[0] = tpos[0]; mk.tpos[1] = tpos[1]; mk.jb = 0;
        f32x4 o[2][4]; float mrow[2][4], lrow[2][4];
#pragma unroll
        for (int mt = 0; mt < 2; ++mt) {
#pragma unroll
            for (int nt = 0; nt < 4; ++nt) o[mt][nt] = (f32x4){0.f, 0.f, 0.f, 0.f};
#pragma unroll
            for (int t = 0; t < 4; ++t) { mrow[mt][t] = -1e30f; lrow[mt][t] = 0.f; } }
        for (int jb = 0; jb <= tile; ++jb) { if (!((wunion >> jb) & 1ull)) continue; mk.jb = jb;
            flash_block<2, 64>(qf, PROJ + (rowb + jb * 64) * OD_PITCH + 768 + g * 64, OD_PITCH, VTb + (size_t)(g * 64) * MTOK + rowb + jb * 64, MTOK, o, mrow, lrow, pbuf, c2, mk, jb * 64, lr, lq); }
#pragma unroll
        for (int mt = 0; mt < 2; ++mt)
#pragma unroll
            for (int t = 0; t < 4; ++t) { const float f = GATE(mt, t, 1) / grp16_sum(lrow[mt][t]);
#pragma unroll
                for (int nt = 0; nt < 4; ++nt) PS[OTIDX(mt, nt, t)] += o[mt][nt][t] * f; }
    }
    {
        WinMask mk; mk.W = 512; mk.tpos[0] = tpos[0]; mk.tpos[1] = tpos[1];
        f32x4 o[2][4]; float mrow[2][4], lrow[2][4];
#pragma unroll
        for (int mt = 0; mt < 2; ++mt) {
#pragma unroll
            for (int nt = 0; nt < 4; ++nt) o[mt][nt] = (f32x4){0.f, 0.f, 0.f, 0.f};
#pragma unroll
            for (int t = 0; t < 4; ++t) { mrow[mt][t] = -1e30f; lrow[mt][t] = 0.f; } }
        for (int jb = (tile >= 8 ? tile - 8 : 0); jb <= tile; ++jb)
            flash_block<2, 64>(qf, PROJ + (rowb + jb * 64) * OD_PITCH + 896 + g * 64, OD_PITCH, VTb + (size_t)(128 + g * 64) * MTOK + rowb + jb * 64, MTOK, o, mrow, lrow, pbuf, c2, mk, jb * 64, lr, lq);
#pragma unroll
        for (int mt = 0; mt < 2; ++mt)
#pragma unroll
            for (int t = 0; t < 4; ++t) { const float f = GATE(mt, t, 2) / grp16_sum(lrow[mt][t]);
#pragma unroll
                for (int nt = 0; nt < 4; ++nt) MIX[(rowb + tpos[mt]) * DM + g * 256 + t * 64 + nt * 16 + lr] = f2bf(PS[OTIDX(mt, nt, t)] + o[mt][nt][t] * f); }
    }
    {
#pragma unroll
        for (int mt = 0; mt < 2; ++mt)
#pragma unroll
            for (int ks = 0; ks < 2; ++ks) qf[mt][ks] = *(const bf16x8*)(PROJ + (rowb + t0 + 8 * wave + 4 * mt + (lr >> 2)) * OD_PITCH + 1152 + g * 256 + (lr & 3) * 64 + ks * 32 + lq * 8);
        WinMask mk; mk.W = 128; mk.tpos[0] = tpos[0]; mk.tpos[1] = tpos[1];
        f32x4 o[2][4]; float mrow[2][4], lrow[2][4];
#pragma unroll
        for (int mt = 0; mt < 2; ++mt) {
#pragma unroll
            for (int nt = 0; nt < 4; ++nt) o[mt][nt] = (f32x4){0.f, 0.f, 0.f, 0.f};
#pragma unroll
            for (int t = 0; t < 4; ++t) { mrow[mt][t] = -1e30f; lrow[mt][t] = 0.f; } }
        for (int jb = (tile >= 2 ? tile - 2 : 0); jb <= tile; ++jb)
            flash_block<2, 64>(qf, PROJ + (rowb + jb * 64) * OD_PITCH + 1024 + g * 64, OD_PITCH, VTb + (size_t)(256 + g * 64) * MTOK + rowb + jb * 64, MTOK, o, mrow, lrow, pbuf, c2, mk, jb * 64, lr, lq);
#pragma unroll
        for (int mt = 0; mt < 2; ++mt)
#pragma unroll
            for (int t = 0; t < 4; ++t) { const float sk = a.in[I_SINKS][li * 8 + g * 4 + t] * LOG2E; const float f = 1.0f / (grp16_sum(lrow[mt][t]) + ex2(sk - mrow[mt][t]));
#pragma unroll
                for (int nt = 0; nt < 4; ++nt) MIX[(rowb + tpos[mt]) * DM + 512 + g * 256 + t * 64 + nt * 16 + lr] = f2bf(o[mt][nt][t] * f); }
    }
}
#undef GATE
#undef OTIDX
DI void o3_phase(const Args& a, int li, LAS unsigned char* lds, int wave, int lane, int bid, int G) {
    for (int p = bid; p < 256; p += G) { const int bg = p >> 5, tl = p & 31;
        o3_unit(a, li, bg, 63 - tl, lds, wave, lane);
        o3_unit(a, li, bg, tl, lds, wave, lane); }
}

DI void xattn_phase(const Args& a, LAS unsigned char* lds, int wave, int lane, int bid, int G) {
    bf16_t* Q = (bf16_t*)(a.ws + WS_R + R_Q); const bf16_t* KX = (const bf16_t*)(a.ws + WS_KX); const bf16_t* VTX = (const bf16_t*)(a.ws + WS_VTX);
    const int lr = lane & 15, lq = lane >> 4; LAS bf16_t* pbuf = (LAS bf16_t*)(lds + wave * 2304);
    for (int u = bid; u < 512; u += G) { const int b = u >> 7, hd = (u >> 5) & 3, qt = u & 31;
        const size_t row0 = (size_t)b * SEQ + qt * 128 + wave * 16;
        bf16x8 qf[1][8];
#pragma unroll
        for (int ks = 0; ks < 8; ++ks) qf[0][ks] = *(const bf16x8*)(Q + (row0 + lr) * DM + hd * 256 + ks * 32 + lq * 8);
        f32x4 o[1][16]; float mrow[1][4], lrow[1][4];
#pragma unroll
        for (int nt = 0; nt < 16; ++nt) o[0][nt] = (f32x4){0.f, 0.f, 0.f, 0.f};
#pragma unroll
        for (int t = 0; t < 4; ++t) { mrow[0][t] = -1e30f; lrow[0][t] = 0.f; }
        NoMask mk;
        for (int jb = 0; jb < 4; ++jb)
            flash_block<1, 256>(qf, KX + ((size_t)b * MEMLEN + jb * 64) * DM + hd * 256, DM, VTX + (size_t)(hd * 256) * DM + b * MEMLEN + jb * 64, DM, o, mrow, lrow, pbuf, 0.0625f * LOG2E, mk, jb * 64, lr, lq);
#pragma unroll
        for (int t = 0; t < 4; ++t) { const float f = 1.0f / grp16_sum(lrow[0][t]);
#pragma unroll
            for (int nt = 0; nt < 16; ++nt) Q[(row0 + 4 * lq + t) * DM + hd * 256 + nt * 16 + lr] = f2bf(o[0][nt][t] * f); }
    }
}

#ifndef MK_MODE
#define MK_MODE 1
#endif
constexpr int PH_PER_LAYER = 20, PH_FINAL = DEPTH * PH_PER_LAYER, PH_TOTAL = PH_FINAL + 1;
extern __shared__ __attribute__((aligned(16))) unsigned char lds_raw[];

#define PHASE_SETUP \
    asm volatile("" : "+s"(kp_)); \
    LAS unsigned char* lds = (LAS unsigned char*)lds_raw; \
    int tid = threadIdx.x, bid = blockIdx.x, G = gridDim.x; asm volatile("" : "+v"(tid)); asm volatile("" : "+s"(bid), "+s"(G)); \
    const int lane = tid & 63, wave = __builtin_amdgcn_readfirstlane(tid >> 6); const int gw = bid * 8 + wave, NGW = G * 8; (void)bid; \
    Args a; _Pragma("unroll") for (int i_ = 0; i_ < 25; ++i_) a.in[i_] = kp_->in[i_]; a.out = kp_->out; a.ws = kp_->ws; a.ph_lo = 0; a.ph_hi = 0; \
    unsigned char* ws = a.ws; float* X = (float*)(ws + WS_X); bf16_t* H = (bf16_t*)(ws + WS_H); unsigned char* R = ws + WS_R; unsigned char* W = ws + WS_W; \
    (void)lds; (void)tid; (void)lane; (void)wave; (void)G; (void)gw; (void)NGW; (void)X; (void)H; (void)R; (void)W;
#define UNI(x) __builtin_amdgcn_readfirstlane(x)

DI void P_prologue(KP kp_, int layer) { layer = UNI(layer); PHASE_SETUP layer_prologue(kp_, a, layer, lds, tid, wave, lane, gw, NGW); __syncthreads(); }
DI void P_norm(KP kp_, int layer, int which) { layer = UNI(layer); which = UNI(which); PHASE_SETUP
    norm_phase((layer == 0 && which == 0) ? a.in[I_X] : X, a.in[I_NORMW] + ((size_t)layer * 4 + which) * DM, H, gw, NGW, lane); }
DI void P_final(KP kp_) { PHASE_SETUP final_norm_phase(X, a.in[I_FNORMW], a.out, gw, NGW, lane); }
DI void P_gemm_bf16(KP kp_, int which) { which = UNI(which); PHASE_SETUP
    const bf16_t* A = H; const bf16_t* Bt = (const bf16_t*)(W + W_IN); bf16_t* O = (bf16_t*)(R + R_PROJ); int M = MTOK, N = EV_PITCH, ldc = EV_PITCH, rot = 0;
    if (which == 0) { A = (const bf16_t*)(ws + WS_MEMN); Bt = (const bf16_t*)(W + W_XKV); O = (bf16_t*)(ws + WS_KX); M = NB * MEMLEN; N = DM; ldc = DM; }
    else if (which == 1) { A = (const bf16_t*)(W + W_XKV) + (size_t)DM * DM; Bt = (const bf16_t*)(ws + WS_MEMN); O = (bf16_t*)(ws + WS_VTX); M = DM; N = NB * MEMLEN; ldc = DM; rot = 16; }
    else if (which == 3) { N = OD_PITCH; ldc = OD_PITCH; }
    else if (which == 4) { A = (const bf16_t*)(W + W_IN) + (size_t)OD_PITCH * DM; Bt = H; O = (bf16_t*)(R + R_VT); M = 512; N = MTOK; ldc = MTOK; rot = 64; }
    else if (which == 5) { Bt = (const bf16_t*)(W + W_XQ); O = (bf16_t*)(R + R_Q); N = DM; ldc = DM; }
    pg8::Gemm g{A, Bt, DM, DM, 128, 128, DM}; pg8::StaticOrder S; S.init(g, M, N, G, (bid + G - rot) % G);
    pg8::EpiBf16<0> E{O, ldc, nullptr, 0}; pg8::gemm_phase(lds, g, S, E, tid); }
DI void P_gemm_swiglu(KP kp_, int half) { half = UNI(half); PHASE_SETUP
    pg8::Gemm g{H, (const bf16_t*)(W + W_GU) + (size_t)half * 2 * FF * DM, DM, DM, 128, 128, DM}; pg8::StaticOrder S; S.init(g, MTOK, 2 * FF, G, bid);
    pg8::EpiSwiGLU E{(bf16_t*)(R + R_HID), FF}; pg8::gemm_phase(lds, g, S, E, tid); }
DI void P_gemm_resid(KP kp_, int which, int first) { which = UNI(which); first = UNI(first); PHASE_SETUP
    const bf16_t* A = (const bf16_t*)(R + R_HID); const bf16_t* Bt = (const bf16_t*)(W + W_D) + (size_t)which * DM * FF; int K = FF; float sc = 0.5f;
    if (which == 2) { A = H; Bt = (const bf16_t*)(W + W_OUT); K = DM; sc = 1.0f; }
    else if (which == 3) { A = (const bf16_t*)(R + R_Q); Bt = (const bf16_t*)(W + W_XO); K = DM; sc = 1.0f; }
    pg8::Gemm g{A, Bt, K, K, 128, 128, K}; pg8::StaticOrder S; S.init(g, MTOK, DM, G, bid);
    pg8::EpiResid E{first ? a.in[I_X] : X, X, sc}; pg8::gemm_phase(lds, g, S, E, tid); }
DI void P_gemm_cmp(KP kp_) { PHASE_SETUP
    pg8::Gemm g{nullptr, nullptr, 16 * OD_PITCH, 2048, OD_PITCH * 2, 128, 2048};
    CmpOrder S{G, bid, (const char*)(R + R_PROJ), (const char*)(W + W_C1)};
    pg8::EpiBf16<2> E{(bf16_t*)(R + R_HIDC), 256, (const float*)(ws + WS_BIAS1), 1}; pg8::gemm_phase(lds, g, S, E, tid); }
DI void P_e0(KP kp_, int li) { li = UNI(li); PHASE_SETUP for (int u = bid; u < 256; u += G) e0_unit(a, li, u, lds, tid, wave, lane); }
DI void P_e1(KP kp_) { PHASE_SETUP e1_phase(a, lds, tid, wave, lane, bid, G); }
DI void P_e2(KP kp_) { PHASE_SETUP e2_phase(a, tid, bid, G); }
DI void P_e3(KP kp_, int li) { li = UNI(li); PHASE_SETUP e3_phase(a, li, lds, tid, wave, lane, bid, G); }
DI void P_e4(KP kp_, int li) { li = UNI(li); PHASE_SETUP e4_phase(a, li, gw, NGW, lane); }
DI void P_o2(KP kp_) { PHASE_SETUP o2_phase(a, gw, lane); }
DI void P_o3(KP kp_, int li) { li = UNI(li); PHASE_SETUP o3_phase(a, li, lds, wave, lane, bid, G); }
DI void P_xattn(KP kp_) { PHASE_SETUP xattn_phase(a, lds, wave, lane, bid, G); }

DI void grid_bar(KP kp_) {
    asm volatile("" : "+s"(kp_));
    XcdBarrier b; b.bar = (unsigned*)(kp_->ws + WS_CTL) + 4096 + kp_->li * XCD_BAR_WORDS; b.x = xb_xcc_id(); b.st = (volatile LAS unsigned*)((LAS unsigned char*)lds_raw + LDSCTL_OFF) + 8;
    xcd_barrier(b);
}
__global__ void __launch_bounds__(512, 2) fwd_kernel(KArgs ka) {
    KP kp = (KP)__builtin_amdgcn_kernarg_segment_ptr();
    {
        LAS unsigned char* lds = (LAS unsigned char*)lds_raw;
        volatile LAS unsigned* MISC = (volatile LAS unsigned*)(lds + LDSCTL_OFF);
        for (int u = threadIdx.x; u < 128; u += 512) MISC[u] = 0u;
        __syncthreads();
        if (ka.ph_hi - ka.ph_lo > 1) (void)xcd_barrier_post((unsigned*)(ka.ws + WS_CTL) + 4096 + ka.li * XCD_BAR_WORDS, MISC + 8);
    }
#define PH(id, ...) { KP k_ = kp; asm volatile("" : "+s"(k_)); const int lo_ = k_->ph_lo, hi_ = k_->ph_hi; if (lo_ <= (id) && (id) < hi_) { __VA_ARGS__; if ((id) + 1 < hi_) grid_bar(kp); } }
    for (int layer = 0; layer < DEPTH; ++layer) {
        const int base = layer * PH_PER_LAYER, li = layer >> 1; const bool odd = (layer & 1) != 0;
        PH(base + 0, P_prologue(kp, layer))
        PH(base + 1, P_gemm_bf16(kp, 0); P_gemm_bf16(kp, 1))
        PH(base + 2, P_norm(kp, layer, 0))
        PH(base + 3, P_gemm_swiglu(kp, 0))
        PH(base + 4, P_gemm_resid(kp, 0, layer == 0 ? 1 : 0))
        PH(base + 5, P_norm(kp, layer, 1))
        if (!odd) {
            PH(base + 6, P_gemm_bf16(kp, 2))
            PH(base + 7, P_e0(kp, li))
            PH(base + 8, P_e1(kp))
            PH(base + 9, P_e2(kp))
            PH(base + 10, P_e3(kp, li))
            PH(base + 11, P_e4(kp, li))
        } else {
            PH(base + 6, P_gemm_bf16(kp, 3); P_gemm_bf16(kp, 4))
            PH(base + 7, P_gemm_cmp(kp))
            PH(base + 8, P_o2(kp))
            PH(base + 9, P_o3(kp, li))
        }
        PH(base + 12, P_gemm_resid(kp, 2, 0))
        PH(base + 13, P_norm(kp, layer, 2))
        PH(base + 14, P_gemm_bf16(kp, 5))
        PH(base + 15, P_xattn(kp))
        PH(base + 16, P_gemm_resid(kp, 3, 0))
        PH(base + 17, P_norm(kp, layer, 3))
        PH(base + 18, P_gemm_swiglu(kp, 1))
        PH(base + 19, P_gemm_resid(kp, 1, 0))
    }
    PH(PH_FINAL, P_final(kp))
#undef PH
}

extern "C" void kernel_launch(void* const* d_in, const int* in_sizes, int n_in, void* d_out, int out_size, void* d_ws, size_t ws_size, hipStream_t stream) {
    static int grid = 0;
    if (grid == 0) {
        if (n_in != 25 || out_size != MTOK * DM || ws_size < WS_END) { fprintf(stderr, "kernel_launch: unexpected problem (n_in %d, out %d, ws %zu < %zu)\n", n_in, out_size, ws_size, (size_t)WS_END); grid = -1; return; }
        int dev = 0, cus = 0, per_cu = 0;
        if (hipGetDevice(&dev) != hipSuccess || hipDeviceGetAttribute(&cus, hipDeviceAttributeMultiprocessorCount, dev) != hipSuccess) { grid = -1; return; }
        if (hipFuncSetAttribute((const void*)fwd_kernel, hipFuncAttributeMaxDynamicSharedMemorySize, LDS_BYTES) != hipSuccess) { fprintf(stderr, "kernel_launch: hipFuncSetAttribute failed\n"); grid = -1; return; }
        if (hipOccupancyMaxActiveBlocksPerMultiprocessor(&per_cu, (const void*)fwd_kernel, 512, LDS_BYTES) != hipSuccess || per_cu < 1) fprintf(stderr, "kernel_launch: occupancy query says %d\n", per_cu);
        (void)hipGetLastError();
        grid = cus;
    }
    if (grid < 0) return;
    (void)hipMemsetAsync((char*)d_ws + WS_CTL, 0, CTL_ZERO_BYTES, stream);
    KArgs a{};
    for (int i = 0; i < 25; ++i) a.in[i] = (const float*)d_in[i];
    a.out = (float*)d_out; a.ws = (unsigned char*)d_ws; a.pad = 0;
#if MK_MODE == 1
    a.ph_lo = 0; a.ph_hi = PH_TOTAL; a.li = 0;
    hipLaunchKernelGGL(fwd_kernel, dim3(grid), dim3(512), LDS_BYTES, stream, a);
#else
    for (int p = 0; p < PH_TOTAL; ++p) { const int l = p % PH_PER_LAYER; if (p < PH_FINAL && (((p / PH_PER_LAYER) & 1) != 0) && (l == 10 || l == 11)) continue;
        a.ph_lo = p; a.ph_hi = p + 1; a.li = 0;
        hipLaunchKernelGGL(fwd_kernel, dim3(grid), dim3(512), LDS_BYTES, stream, a); }
#endif
}
```

```cpp
#include <hip/hip_runtime.h>
#include <cstdio>
#include <cstdint>

#define DI __device__ __forceinline__
#define LAS __attribute__((address_space(3)))
#define GAS __attribute__((address_space(1)))
typedef unsigned short bf16_t;
typedef short bf16x8 __attribute__((ext_vector_type(8)));
typedef float f32x4 __attribute__((ext_vector_type(4)));
typedef float f32x2 __attribute__((ext_vector_type(2)));
typedef unsigned u32x4 __attribute__((ext_vector_type(4)));
typedef unsigned u32x2 __attribute__((ext_vector_type(2)));
typedef __bf16 bf16x2_t __attribute__((ext_vector_type(2)));

#ifndef DUP_MASK
#define DUP_MASK 0
#endif
constexpr int DM = 1024, NB = 4, SEQ = 4096, MTOK = NB * SEQ, DEPTH = 4, FF = 2816, MEMLEN = 256;
constexpr int EV_IN = 3336, EV_PITCH = 3584;
constexpr int OD_IN = 2072, OD_PITCH = 1792;
constexpr float EPS = 1e-6f;
constexpr float LOG2E = 1.4426950408889634f;

constexpr size_t MiB = 1u << 20;
constexpr size_t WS_CTL = 0, CTL_ZERO_BYTES = 1 * MiB;
constexpr size_t WS_COS = 1 * MiB, WS_SIN = 2 * MiB;
constexpr size_t WS_MEMN = 3 * MiB;
constexpr size_t WS_KX = 5 * MiB, WS_VTX = 7 * MiB;
constexpr size_t WS_BIAS1 = 9 * MiB;
constexpr size_t WS_W = 10 * MiB;
constexpr size_t W_GU = 0, W_D = 22 * MiB, W_XQ = 33 * MiB, W_XKV = 35 * MiB, W_XO = 39 * MiB, W_IN = 41 * MiB, W_OUT = 48 * MiB, W_C1 = 50 * MiB, W_C2 = 52 * MiB;
constexpr size_t WS_X = 64 * MiB;
constexpr size_t WS_H = 128 * MiB;
constexpr size_t WS_R = 160 * MiB;
constexpr size_t R_HID = 0;
constexpr size_t R_Q = 0;
constexpr size_t R_PROJ = 0;
constexpr size_t R_CONV = 112 * MiB, R_XDT = 136 * MiB, R_STR = 152 * MiB, R_STS = 184 * MiB, R_SINR = 200 * MiB, R_SINS = 216 * MiB, R_YP = 224 * MiB, R_CUMS = 240 * MiB;
constexpr size_t R_VT = 56 * MiB, R_HIDC = 72 * MiB, R_KC = 74 * MiB, R_VCT = 75 * MiB;
constexpr size_t WS_END = 160 * MiB + 242 * MiB;

constexpr int LDS_BYTES = 147456;
constexpr int LDSCTL_OFF = 147456 - 512;

DI unsigned pk2(float lo, float hi) { f32x2 v = {lo, hi}; bf16x2_t b = __builtin_convertvector(v, bf16x2_t); return __builtin_bit_cast(unsigned, b); }
DI bf16_t f2bf(float f) { return (bf16_t)(pk2(f, 0.f) & 0xffffu); }
DI float bf2f(unsigned h) { return __uint_as_float((h & 0xffffu) << 16); }
DI float bflo(unsigned w) { return __uint_as_float(w << 16); }
DI float bfhi(unsigned w) { return __uint_as_float(w & 0xffff0000u); }
DI float silu_f(float x) { return x * __builtin_amdgcn_rcpf(1.f + __builtin_amdgcn_exp2f(-LOG2E * x)); }
DI float sigmoid_f(float x) { return __builtin_amdgcn_rcpf(1.f + __builtin_amdgcn_exp2f(-LOG2E * x)); }
DI float ex2(float x) { return __builtin_amdgcn_exp2f(x); }
DI f32x4 mfma16(bf16x8 a, bf16x8 b, f32x4 c) { return __builtin_amdgcn_mfma_f32_16x16x32_bf16(a, b, c, 0, 0, 0); }
DI float wave_sum(float v) {
#pragma unroll
    for (int o = 1; o < 64; o <<= 1) v += __shfl_xor(v, o);
    return v;
}
DI float grp16_sum(float v) { v += __shfl_xor(v, 1); v += __shfl_xor(v, 2); v += __shfl_xor(v, 4); v += __shfl_xor(v, 8); return v; }
DI float grp16_max(float v) { v = fmaxf(v, __shfl_xor(v, 1)); v = fmaxf(v, __shfl_xor(v, 2)); v = fmaxf(v, __shfl_xor(v, 4)); v = fmaxf(v, __shfl_xor(v, 8)); return v; }
#define LDS_WAIT() asm volatile("s_waitcnt lgkmcnt(0)" ::: "memory")
#define VM_WAIT() asm volatile("s_waitcnt vmcnt(0)" ::: "memory")

#define XB_TMO      128
#define XB_XCNT(j)  (256  + 64 * (j))
#define XB_XSUB(j)  (1280 + 64 * (j))
#define XB_XGEN(j)  (2304 + 64 * (j))
#define XB_TOP      3328
#define XB_TOPGEN   3392
#define XCD_BAR_WORDS 3456
#define XB_SPIN_CAP (1u << 18)
DI unsigned xb_ld(unsigned* p)              { return __hip_atomic_load(p, __ATOMIC_RELAXED, __HIP_MEMORY_SCOPE_AGENT); }
DI unsigned xb_add(unsigned* p, unsigned v) { return __hip_atomic_fetch_add(p, v, __ATOMIC_RELAXED, __HIP_MEMORY_SCOPE_AGENT); }
DI unsigned xb_xcc_id() { return (unsigned)__builtin_amdgcn_s_getreg((3 << 11) | 20) & 0xFu; }
#define XB_SPIN(cond, bar) do { unsigned _sp = 0; while (cond) { __builtin_amdgcn_s_sleep(1); \
    if ((++_sp & 255u) == 0u) { if (xb_ld(&(bar)[XB_TMO])) break; if (_sp > XB_SPIN_CAP) { atomicAdd(&(bar)[XB_TMO], 1u); break; } } } } while (0)
struct XcdBarrier { unsigned* bar; unsigned x; volatile LAS unsigned* st; };
DI XcdBarrier xcd_barrier_post(unsigned* bar, volatile LAS unsigned* st) {
    XcdBarrier b; b.bar = bar; b.x = xb_xcc_id(); b.st = st;
    if (threadIdx.x == 0) (void)xb_add(&bar[XB_XCNT(b.x)], 1u);
    return b;
}
DI void xcd_barrier_complete(unsigned* bar, unsigned x, unsigned& nloc, unsigned& nx) {
    const unsigned G = gridDim.x * gridDim.y * gridDim.z;
    unsigned sum, cnt, mine, sp = 0u;
    for (;;) {
        sum = 0u; cnt = 0u; mine = 0u;
#pragma unroll
        for (unsigned j = 0; j < 16; ++j) { const unsigned c = xb_ld(&bar[XB_XCNT(j)]); sum += c; cnt += (c > 0u) ? 1u : 0u; mine = (j == x) ? c : mine; }
        if (sum == G) break;
        __builtin_amdgcn_s_sleep(1);
        if ((++sp & 255u) == 0u) { if (xb_ld(&bar[XB_TMO])) break; if (sp > XB_SPIN_CAP) { atomicAdd(&bar[XB_TMO], 1u); break; } }
    }
    nloc = mine > 0u ? mine : 1u; nx = cnt > 0u ? cnt : 1u;
}
DI void xcd_barrier(const XcdBarrier& b) {
    asm volatile("s_waitcnt vmcnt(0)" ::: "memory");
    __syncthreads();
    if (threadIdx.x == 0) {
        unsigned* bar = b.bar;
        __builtin_amdgcn_s_waitcnt(0);
        unsigned nloc = b.st[0], nx = b.st[1];
        if (nloc == 0u) { xcd_barrier_complete(bar, b.x, nloc, nx); b.st[0] = nloc; b.st[1] = nx; }
        const unsigned old = xb_add(&bar[XB_XSUB(b.x)], 1u);
        const unsigned gen = old / nloc;
        if (old + 1u == (gen + 1u) * nloc) {
            __builtin_amdgcn_fence(__ATOMIC_RELEASE, "agent");
            asm volatile("s_waitcnt vmcnt(0)" ::: "memory");
            const unsigned og = xb_add(&bar[XB_TOP], 1u);
            const unsigned tg = og / nx;
            if (og + 1u == (tg + 1u) * nx) xb_add(&bar[XB_TOPGEN], 1u);
            else XB_SPIN(xb_ld(&bar[XB_TOPGEN]) == tg, bar);
            __builtin_amdgcn_fence(__ATOMIC_ACQUIRE, "agent");
            xb_add(&bar[XB_XGEN(b.x)], 1u);
            asm volatile("s_waitcnt vmcnt(0)" ::: "memory");
        } else {
            XB_SPIN(xb_ld(&bar[XB_XGEN(b.x)]) == gen, bar);
            __builtin_amdgcn_fence(__ATOMIC_ACQUIRE, "agent");
            asm volatile("s_waitcnt vmcnt(0)" ::: "memory");
        }
    }
    __syncthreads();
}

namespace pg8 {
constexpr int BM = 256, BK = 64, HALF = 128, HTB = HALF * BK * 2, STAGE_BYTES = 8 * HTB, NXCD = 8, WGM = 8;
__host__ __device__ __forceinline__ int lds_byte(int r, int c) { const int st = (r >> 4) * 2 + (c >> 5), rr = r & 15, cc = c & 31, ob = rr * 64 + cc * 2; return st * 1024 + (ob ^ (((ob >> 9) & 1) << 5)); }
__host__ __device__ __forceinline__ void stage_rc(int b, int& R, int& C) { const int st = b / 1024, sb = b % 1024, swz = sb ^ (((sb >> 9) & 1) << 5); R = (st >> 1) * 16 + swz / 64; C = (st & 1) * 32 + (swz % 64) / 2; }
__host__ __device__ __forceinline__ int perm32(int rho) { const int n = rho >> 4, i = rho & 15; return 8 * (i >> 2) + 4 * n + (i & 3); }

struct Unit { int pm, pn; const char* a; const char* b; };
struct Gemm { const bf16_t* A; const bf16_t* Bt; int lda, ldb, kstepA, kstepB, K; };

struct StaticOrder {
    int nM, nN, nwg, G, c; const char* A; const char* B; size_t tA, tB;
    DI void init(const Gemm& g, int M, int N, int G_, int c_) { nM = M / BM; nN = N / BM; nwg = nM * nN; G = G_; c = c_; A = (const char*)g.A; B = (const char*)g.Bt; tA = (size_t)BM * g.lda * 2; tB = (size_t)BM * g.ldb * 2; }
    DI bool next(int i, Unit& u) const {
        const int L = i * G + c; if (L >= nwg) return false;
        int wgid = L; { const int q = nwg / NXCD, r = nwg % NXCD, xcd = wgid % NXCD, off = wgid / NXCD; wgid = (xcd < r ? xcd * (q + 1) : r * (q + 1) + (xcd - r) * q) + off; }
        const int nig = WGM * nN, gid = wgid / nig, fm = gid * WGM, gsz = (nM - fm) < WGM ? (nM - fm) : WGM;
        u.pm = fm + ((wgid % nig) % gsz); u.pn = (wgid % nig) / gsz; u.a = A + (size_t)u.pm * tA; u.b = B + (size_t)u.pn * tB; return true;
    }
};

DI unsigned cvt_pk_bf16(float lo, float hi) { return pk2(lo, hi); }

template <int ACT> struct EpiBf16 {
    static constexpr bool PERM = true;
    bf16_t* O; int ldc; const float* bias; int cmp_mode;
    DI void operator()(const f32x4 (&acc)[2][2][4][2], const Unit& u, int wr, int wc, int fr, int fq) const {
        const int rt = cmp_mode ? (u.pn * 8 + u.pm) : u.pm, ct = cmp_mode ? 0 : u.pn;
        const int row0 = rt * BM + wr * 64 + fr; const int col0 = ct * BM + wc * 32 + 8 * fq;
        f32x4 bv[2][2];
#pragma unroll
        for (int bj = 0; bj < 2; ++bj)
#pragma unroll
            for (int n = 0; n < 2; ++n) bv[bj][n] = bias ? *(const f32x4*)(bias + u.pn * BM + (wc * 32 + 8 * fq) + bj * HALF + 4 * n) : (f32x4){0.f, 0.f, 0.f, 0.f};
#pragma unroll
        for (int ai = 0; ai < 2; ++ai)
#pragma unroll
            for (int m = 0; m < 4; ++m) { bf16_t* rowp = O + (size_t)(row0 + ai * HALF + m * 16) * ldc + col0;
#pragma unroll
                for (int bj = 0; bj < 2; ++bj) { f32x4 v0 = acc[ai][bj][m][0] + bv[bj][0], v1 = acc[ai][bj][m][1] + bv[bj][1];
                    if (ACT == 2) { v0 = (f32x4){silu_f(v0[0]), silu_f(v0[1]), silu_f(v0[2]), silu_f(v0[3])}; v1 = (f32x4){silu_f(v1[0]), silu_f(v1[1]), silu_f(v1[2]), silu_f(v1[3])}; }
                    u32x4 w; w.x = cvt_pk_bf16(v0[0], v0[1]); w.y = cvt_pk_bf16(v0[2], v0[3]); w.z = cvt_pk_bf16(v1[0], v1[1]); w.w = cvt_pk_bf16(v1[2], v1[3]);
                    *(u32x4*)(rowp + bj * HALF) = w; } }
    }
};
struct EpiSwiGLU {
    static constexpr bool PERM = true;
    bf16_t* O; int ldc;
    DI void operator()(const f32x4 (&acc)[2][2][4][2], const Unit& u, int wr, int wc, int fr, int fq) const {
        const int row0 = u.pm * BM + wr * 64 + fr; const int col0 = u.pn * HALF + wc * 32 + 8 * fq;
#pragma unroll
        for (int ai = 0; ai < 2; ++ai)
#pragma unroll
            for (int m = 0; m < 4; ++m) { bf16_t* rowp = O + (size_t)(row0 + ai * HALF + m * 16) * ldc + col0;
                const f32x4 g0 = acc[ai][0][m][0], g1 = acc[ai][0][m][1], u0 = acc[ai][1][m][0], u1 = acc[ai][1][m][1];
                u32x4 w; w.x = cvt_pk_bf16(silu_f(g0[0]) * u0[0], silu_f(g0[1]) * u0[1]); w.y = cvt_pk_bf16(silu_f(g0[2]) * u0[2], silu_f(g0[3]) * u0[3]);
                w.z = cvt_pk_bf16(silu_f(g1[0]) * u1[0], silu_f(g1[1]) * u1[1]); w.w = cvt_pk_bf16(silu_f(g1[2]) * u1[2], silu_f(g1[3]) * u1[3]);
                *(u32x4*)rowp = w; }
    }
};
struct EpiResid {
    static constexpr bool PERM = false;
    const float* base; float* out; float scale;
    DI void operator()(const f32x4 (&acc)[2][2][4][2], const Unit& u, int wr, int wc, int fr, int fq) const {
        const int col0 = u.pn * BM + wc * 32 + 4 * fq;
#pragma unroll
        for (int ai = 0; ai < 2; ++ai)
#pragma unroll
            for (int m = 0; m < 4; ++m) { const size_t off = (size_t)(u.pm * BM + ai * HALF + wr * 64 + m * 16 + fr) * DM + col0;
#pragma unroll
                for (int bj = 0; bj < 2; ++bj)
#pragma unroll
                    for (int n = 0; n < 2; ++n) { const f32x4 bs = *(const f32x4*)(base + off + bj * HALF + n * 16); *(f32x4*)(out + off + bj * HALF + n * 16) = bs + acc[ai][bj][m][n] * scale; } }
    }
};

template <class Epi, class Sched>
DI void gemm_phase(LAS unsigned char* lds, const Gemm g, const Sched& S, const Epi& E, const int tid) {
    const int wid = __builtin_amdgcn_readfirstlane(tid >> 6), lane = tid & 63, wr = wid >> 2, wc = wid & 3, fr = lane & 15, fq = lane >> 4;
    const int K = g.K, nt = K / BK;
    unsigned voffA[2], voffB[2];
#pragma unroll
    for (int i = 0; i < 2; ++i) { int R, C; stage_rc(tid * 16 + i * 8192, R, C); const int Rb = Epi::PERM ? ((R & ~31) + perm32(R & 31)) : R;
        voffA[i] = (unsigned)(R * g.lda + C) * 2u; voffB[i] = (unsigned)(Rb * g.ldb + C) * 2u; }
    const size_t kA = (size_t)g.kstepA, kB = (size_t)g.kstepB;
    const size_t hA = (size_t)HALF * g.lda * 2, hB = (size_t)HALF * g.ldb * 2;
    const unsigned ldsw = (unsigned)wid * 1024u;
    const int aoff = lds_byte(wr * 64 + fr, fq * 8), boff = lds_byte(wc * 32 + fr, fq * 8);
#define PG8_SA(b, h) (((b) * 2 + (h)) * HTB)
#define PG8_SB(b, h) ((4 + (b) * 2 + (h)) * HTB)
#define PG8_STAGE(bufoff, gbase, voff) do { _Pragma("unroll") for (int _i = 0; _i < 2; ++_i) \
        __builtin_amdgcn_global_load_lds((const unsigned*)((const char*)(gbase) + (voff)[_i]), (LAS unsigned*)(lds + (bufoff) + ldsw + _i * 8192), 16, 0, 0); } while (0)
#define PG8_LDA(dst, b, h) do { _Pragma("unroll") for (int m = 0; m < 4; ++m) _Pragma("unroll") for (int k = 0; k < 2; ++k) dst[m][k] = *(const LAS bf16x8*)(lds + PG8_SA(b, h) + aoff + m * 2048 + k * 1024); } while (0)
#define PG8_LDB(dst, b, h) do { _Pragma("unroll") for (int n = 0; n < 2; ++n) _Pragma("unroll") for (int k = 0; k < 2; ++k) dst[n][k] = *(const LAS bf16x8*)(lds + PG8_SB(b, h) + boff + n * 2048 + k * 1024); } while (0)
#define PG8_MMA(ai, bj, At, Bt) do { __builtin_amdgcn_s_setprio(1); _Pragma("unroll") for (int m = 0; m < 4; ++m) _Pragma("unroll") for (int n = 0; n < 2; ++n) _Pragma("unroll") for (int k = 0; k < 2; ++k) \
        acc[ai][bj][m][n] = __builtin_amdgcn_mfma_f32_16x16x32_bf16(Bt[n][k], At[m][k], acc[ai][bj][m][n], 0, 0, 0); __builtin_amdgcn_s_setprio(0); } while (0)
#define PG8_WAIT_V(n) asm volatile("s_waitcnt vmcnt(" #n ")" ::: "memory")
#define PG8_WAIT_L(n) asm volatile("s_waitcnt lgkmcnt(" #n ")" ::: "memory")
#define PG8_BAR __builtin_amdgcn_s_barrier()
#define PG8_SCHED __builtin_amdgcn_sched_barrier(0)
    Unit cur, nxt; int ui = 0;
    if (!S.next(0, cur)) return;
    f32x4 acc[2][2][4][2];
#pragma unroll
    for (int a = 0; a < 2; ++a)
#pragma unroll
        for (int b = 0; b < 2; ++b)
#pragma unroll
            for (int m = 0; m < 4; ++m)
#pragma unroll
                for (int n = 0; n < 2; ++n) acc[a][b][m][n] = (f32x4){0.f, 0.f, 0.f, 0.f};
    bf16x8 At[4][2], B0[2][2], B1[2][2];
    const char* cA = cur.a; const char* cB = cur.b;
    PG8_STAGE(PG8_SB(0, 0), cB, voffB); PG8_STAGE(PG8_SB(0, 1), cB + hB, voffB); PG8_STAGE(PG8_SA(0, 0), cA, voffA); PG8_STAGE(PG8_SA(0, 1), cA + hA, voffA);
    if (wr == 1) PG8_BAR;
    PG8_WAIT_V(2); PG8_BAR;
    PG8_STAGE(PG8_SB(1, 0), cB + kB, voffB); PG8_STAGE(PG8_SA(1, 0), cA + kA, voffA); PG8_STAGE(PG8_SB(1, 1), cB + hB + kB, voffB);
    PG8_WAIT_V(6); PG8_BAR;
    for (;;) {
        const bool has_next = S.next(ui + 1, nxt);
        const char* nA = has_next ? nxt.a : cA; const char* nB = has_next ? nxt.b : cB;
        for (int t = 0; t < nt; t += 2) {
            const bool last = (t == nt - 2);
            const char* a1 = cA + (size_t)(t + 1) * kA;
            const char* a2 = last ? nA : cA + (size_t)(t + 2) * kA; const char* b2 = last ? nB : cB + (size_t)(t + 2) * kB;
            const char* a3 = a2 + kA; const char* b3 = b2 + kB;
            PG8_LDB(B0, 0, 0); PG8_LDB(B1, 0, 1); PG8_SCHED; PG8_LDA(At, 0, 0); PG8_STAGE(PG8_SA(1, 1), a1 + hA, voffA);
            PG8_WAIT_V(8); PG8_WAIT_L(0); PG8_BAR; PG8_MMA(0, 0, At, B0); PG8_MMA(0, 1, At, B1); PG8_BAR; PG8_SCHED;
            PG8_LDA(At, 0, 1); PG8_STAGE(PG8_SB(0, 0), b2, voffB); PG8_STAGE(PG8_SB(0, 1), b2 + hB, voffB); PG8_STAGE(PG8_SA(0, 0), a2, voffA);
            PG8_WAIT_V(8); PG8_WAIT_L(0); PG8_BAR; PG8_MMA(1, 0, At, B0); PG8_MMA(1, 1, At, B1); PG8_BAR; PG8_SCHED;
            PG8_LDB(B0, 1, 0); PG8_LDB(B1, 1, 1); PG8_SCHED; PG8_LDA(At, 1, 0); PG8_STAGE(PG8_SA(0, 1), a2 + hA, voffA);
            PG8_WAIT_V(8); PG8_WAIT_L(0); PG8_BAR; PG8_MMA(0, 0, At, B0); PG8_MMA(0, 1, At, B1); PG8_BAR; PG8_SCHED;
            PG8_LDA(At, 1, 1); PG8_STAGE(PG8_SB(1, 0), b3, voffB); PG8_STAGE(PG8_SB(1, 1), b3 + hB, voffB); PG8_STAGE(PG8_SA(1, 0), a3, voffA);
            PG8_WAIT_V(8); PG8_WAIT_L(0); PG8_BAR; PG8_MMA(1, 0, At, B0); PG8_MMA(1, 1, At, B1); PG8_BAR; PG8_SCHED;
        }
        if (wr == 0) PG8_BAR;
        E(acc, cur, wr, wc, fr, fq);
        if (!has_next) break;
#pragma unroll
        for (int a = 0; a < 2; ++a)
#pragma unroll
            for (int b = 0; b < 2; ++b)
#pragma unroll
                for (int m = 0; m < 4; ++m)
#pragma unroll
                    for (int n = 0; n < 2; ++n) acc[a][b][m][n] = (f32x4){0.f, 0.f, 0.f, 0.f};
        cur = nxt; cA = nA; cB = nB; ++ui;
        if (wr == 1) PG8_BAR;
    }
    PG8_WAIT_V(0);
    PG8_BAR;
#undef PG8_SA
#undef PG8_SB
#undef PG8_STAGE
#undef PG8_LDA
#undef PG8_LDB
#undef PG8_MMA
#undef PG8_WAIT_V
#undef PG8_WAIT_L
#undef PG8_BAR
#undef PG8_SCHED
}
}

struct Args { const float* in[25]; float* out; unsigned char* ws; int ph_lo, ph_hi; };
struct KArgs { const float* in[25]; float* out; unsigned char* ws; int ph_lo, ph_hi, li, pad; };
typedef const KArgs __attribute__((address_space(4)))* KP;
enum { I_X = 0, I_MEM, I_NORMW, I_FNORMW, I_MNORMW, I_WG, I_WU, I_WD, I_XWQ, I_XWKV, I_XWO, I_EWIN, I_EWOUT, I_CONVW, I_CONVB, I_DTB, I_ALOG, I_SSMD, I_SSMNW, I_OWIN, I_OWOUT, I_CPE, I_CW1, I_CW2, I_SINKS };


__device__ const float INVF[64] = {1.000000000e+00f, 8.639885187e-01f, 7.464760542e-01f, 6.449466944e-01f, 5.572264791e-01f, 4.814372659e-01f, 4.159561992e-01f, 3.593813777e-01f, 3.105013072e-01f, 2.682695687e-01f, 2.317818254e-01f, 2.002568096e-01f, 1.730195731e-01f, 1.494869143e-01f, 1.291549653e-01f, 1.115884036e-01f, 9.641107917e-02f, 8.329805732e-02f, 7.196855545e-02f, 6.218000501e-02f, 5.372281000e-02f, 4.641588405e-02f, 4.010278732e-02f, 3.464834765e-02f, 2.993576974e-02f, 2.586415969e-02f, 2.234633639e-02f, 1.930697635e-02f, 1.668100618e-02f, 1.441219542e-02f, 1.245197095e-02f, 1.075835899e-02f, 9.295095690e-03f, 8.030855097e-03f, 6.938566454e-03f, 5.994840525e-03f, 5.179473199e-03f, 4.475005437e-03f, 3.866353072e-03f, 3.340484342e-03f, 2.886139555e-03f, 2.493591513e-03f, 2.154434333e-03f, 1.861406374e-03f, 1.608233666e-03f, 1.389495214e-03f, 1.200507861e-03f, 1.037224894e-03f, 8.961504791e-04f, 7.742635789e-04f, 6.689548027e-04f, 5.779692437e-04f, 4.993587499e-04f, 4.314401885e-04f, 3.727593285e-04f, 3.220597573e-04f, 2.782559313e-04f, 2.404098923e-04f, 2.077113895e-04f, 1.794602285e-04f, 1.550515735e-04f, 1.339627634e-04f, 1.157422957e-04f, 9.999999747e-05f};
DI void sincos_acc(float x, float& s, float& c) {
    const float kf = __builtin_rintf(x * 0.636619772367581343f); const int k = (int)kf;
    float r = __builtin_fmaf(-kf, 1.57079637050628662109375f, x); r = __builtin_fmaf(-kf, -4.37113900018624283e-8f, r);
    const float r2 = r * r;
    const float sp = r + r * r2 * (-1.0f / 6.0f + r2 * (1.0f / 120.0f + r2 * (-1.0f / 5040.0f + r2 * (1.0f / 362880.0f))));
    const float cp = 1.0f + r2 * (-0.5f + r2 * (1.0f / 24.0f + r2 * (-1.0f / 720.0f + r2 * (1.0f / 40320.0f + r2 * (-1.0f / 3628800.0f)))));
    const int q = k & 3;
    s = (q == 0) ? sp : (q == 1) ? cp : (q == 2) ? -sp : -cp;
    c = (q == 0) ? cp : (q == 1) ? -sp : (q == 2) ? -cp : sp;
}

#define JNO (1 << 20)
constexpr int NJ_EVEN = 11, NJ_ODD = 25;
__device__ const int JT_EVEN[NJ_EVEN][12] = {
    {I_WG, 2 * DM * FF, 0, 0, FF, DM, 0, FF, (int)W_GU, 128, 256, 0}, {I_WU, 2 * DM * FF, 0, 0, FF, DM, 0, FF, (int)W_GU, 128, 256, 128}, {I_WD, 2 * DM * FF, 0, 0, DM, FF, 0, DM, (int)W_D, JNO, 0, 0},
    {I_WG, 2 * DM * FF, 0, DM * FF, FF, DM, 0, FF, (int)(W_GU + 4 * FF * DM), 128, 256, 0}, {I_WU, 2 * DM * FF, 0, DM * FF, FF, DM, 0, FF, (int)(W_GU + 4 * FF * DM), 128, 256, 128}, {I_WD, 2 * DM * FF, 0, DM * FF, DM, FF, 0, DM, (int)(W_D + 2 * DM * FF), JNO, 0, 0},
    {I_XWQ, DM * DM, 0, 0, DM, DM, 0, DM, (int)W_XQ, JNO, 0, 0}, {I_XWKV, 2 * DM * DM, 0, 0, 2 * DM, DM, 0, 2 * DM, (int)W_XKV, JNO, 0, 0}, {I_XWO, DM * DM, 0, 0, DM, DM, 0, DM, (int)W_XO, JNO, 0, 0},
    {I_EWIN, 0, DM * EV_IN, 0, EV_IN, DM, 0, EV_IN, (int)W_IN, JNO, 0, 0}, {I_EWOUT, 0, DM * DM, 0, DM, DM, 0, DM, (int)W_OUT, JNO, 0, 0} };
__device__ const int JT_ODD[NJ_ODD][12] = {
    {I_WG, 2 * DM * FF, 0, 0, FF, DM, 0, FF, (int)W_GU, 128, 256, 0}, {I_WU, 2 * DM * FF, 0, 0, FF, DM, 0, FF, (int)W_GU, 128, 256, 128}, {I_WD, 2 * DM * FF, 0, 0, DM, FF, 0, DM, (int)W_D, JNO, 0, 0},
    {I_WG, 2 * DM * FF, 0, DM * FF, FF, DM, 0, FF, (int)(W_GU + 4 * FF * DM), 128, 256, 0}, {I_WU, 2 * DM * FF, 0, DM * FF, FF, DM, 0, FF, (int)(W_GU + 4 * FF * DM), 128, 256, 128}, {I_WD, 2 * DM * FF, 0, DM * FF, DM, FF, 0, DM, (int)(W_D + 2 * DM * FF), JNO, 0, 0},
    {I_XWQ, DM * DM, 0, 0, DM, DM, 0, DM, (int)W_XQ, JNO, 0, 0}, {I_XWKV, 2 * DM * DM, 0, 0, 2 * DM, DM, 0, 2 * DM, (int)W_XKV, JNO, 0, 0}, {I_XWO, DM * DM, 0, 0, DM, DM, 0, DM, (int)W_XO, JNO, 0, 0},
    {I_OWIN, 0, DM * OD_IN, 0, OD_IN, DM, 0, 512, (int)W_IN, JNO, 0, 0}, {I_OWIN, 0, DM * OD_IN, 0, OD_IN, DM, 512, 128, (int)W_IN, JNO, 0, 512}, {I_OWIN, 0, DM * OD_IN, 0, OD_IN, DM, 640, 128, (int)W_IN, JNO, 0, 640},
    {I_OWIN, 0, DM * OD_IN, 0, OD_IN, DM, 768, 128, (int)W_IN, JNO, 0, 768}, {I_OWIN, 0, DM * OD_IN, 0, OD_IN, DM, 1024, 128, (int)W_IN, JNO, 0, 896}, {I_OWIN, 0, DM * OD_IN, 0, OD_IN, DM, 1816, 128, (int)W_IN, JNO, 0, 1024},
    {I_OWIN, 0, DM * OD_IN, 0, OD_IN, DM, 1304, 512, (int)W_IN, JNO, 0, 1152}, {I_OWIN, 0, DM * OD_IN, 0, OD_IN, DM, 1280, 24, (int)W_IN, JNO, 0, 1664},
    {I_OWIN, 0, DM * OD_IN, 0, OD_IN, DM, 896, 128, (int)(W_IN + 2 * OD_PITCH * DM), JNO, 0, 0}, {I_OWIN, 0, DM * OD_IN, 0, OD_IN, DM, 1152, 128, (int)(W_IN + 2 * OD_PITCH * DM), JNO, 0, 128}, {I_OWIN, 0, DM * OD_IN, 0, OD_IN, DM, 1944, 128, (int)(W_IN + 2 * OD_PITCH * DM), JNO, 0, 256},
    {I_OWOUT, 0, DM * DM, 0, DM, DM, 0, DM, (int)W_OUT, JNO, 0, 0},
    {I_CW1, 0, 2 * 2048 * 256, 0, 256, 2048, 0, 256, (int)W_C1, JNO, 0, 0}, {I_CW1, 0, 2 * 2048 * 256, 2048 * 256, 256, 2048, 0, 256, (int)(W_C1 + 2 * 256 * 2048), JNO, 0, 0},
    {I_CW2, 0, 2 * 256 * 64, 0, 64, 256, 0, 64, (int)W_C2, JNO, 0, 0}, {I_CW2, 0, 2 * 256 * 64, 256 * 64, 64, 256, 0, 64, (int)(W_C2 + 2 * 64 * 256), JNO, 0, 0} };

DI void transpose_item(const float* src, bf16_t* dst, int ldw, int K, int c0, int ncols, int G, int GS, int off, int nblk, int item, LAS float* scr, int lane) {
    const int kb = item / nblk, nb = item % nblk, k0 = 64 * kb, n0 = 32 * nb;
    const int cl = n0 + (lane & 31); const bool okc = cl < ncols;
#pragma unroll 8
    for (int i = 0; i < 32; ++i) { const int kk = 2 * i + (lane >> 5); scr[kk * 33 + (lane & 31)] = okc ? src[(size_t)(k0 + kk) * ldw + c0 + cl] : 0.f; }
    LDS_WAIT(); asm volatile("" ::: "memory");
    const int c = lane & 7;
#pragma unroll
    for (int j = 0; j < 4; ++j) { const int n = (lane >> 3) + 8 * j; const LAS float* s = scr + (8 * c) * 33 + n;
        u32x4 o; o.x = pk2(s[0 * 33], s[1 * 33]); o.y = pk2(s[2 * 33], s[3 * 33]); o.z = pk2(s[4 * 33], s[5 * 33]); o.w = pk2(s[6 * 33], s[7 * 33]);
        const int cc = n0 + n; const int drow = (cc / G) * GS + off + (cc % G);
        *(u32x4*)(dst + (size_t)drow * K + k0 + 8 * c) = o; }
    LDS_WAIT(); asm volatile("" ::: "memory");
}
DI void layer_prologue(KP kp, const Args& a, int layer, LAS unsigned char* lds, int tid, int wave, int lane, int gw, int NGW) {
    LAS int* item0 = (LAS int*)(lds + 8 * 8448);
    unsigned char* ws = a.ws; unsigned char* W = ws + WS_W; const int li = layer >> 1; const bool odd = (layer & 1) != 0;
    const int nj = odd ? NJ_ODD : NJ_EVEN; const int (*JT)[12] = odd ? JT_ODD : JT_EVEN;
    if (tid == 0) { int items = 0; for (int j = 0; j < nj; ++j) { item0[j] = items; items += ((JT[j][7] + 31) / 32) * (JT[j][5] / 64); } item0[nj] = items; }
    __syncthreads();
    const int nitems = item0[nj];
    LAS float* scr = (LAS float*)(lds + wave * 8448);
    for (int it = gw; it < nitems; it += NGW) {
        int j = 0;
        while (j + 1 < nj && item0[j + 1] <= it) ++j;
        j = __builtin_amdgcn_readfirstlane(j);
        const int* J = JT[j];
        const float* src = kp->in[J[0]] + ((size_t)layer * J[1] + (size_t)li * J[2] + J[3]);
        transpose_item(src, (bf16_t*)(W + J[8]), J[4], J[5], J[6], J[7], J[9], J[10], J[11], (J[7] + 31) / 32, it - item0[j], scr, lane);
    }
    if (odd) {
        float* bias1 = (float*)(ws + WS_BIAS1);
        for (int o = gw; o < 512; o += NGW) { const int kv = o >> 8, col = o & 255;
            const float* pe = a.in[I_CPE] + (size_t)(li * 2 + kv) * 2048; const float* w1 = a.in[I_CW1] + (size_t)(li * 2 + kv) * 2048 * 256 + col;
            float s = 0.f;
            for (int k = lane; k < 2048; k += 64) s += pe[k] * w1[(size_t)k * 256];
            s = wave_sum(s); if (lane == 0) bias1[o] = s; }
    }
    if (layer == 0) {
        float* ct = (float*)(ws + WS_COS); float* st = (float*)(ws + WS_SIN);
        const int gt = gw * 64 + lane, NT = NGW * 64;
        for (int e = gt; e < SEQ * 64; e += NT) { const int pos = e >> 6, i = e & 63;
            const float ang = (float)pos * INVF[i];
            float sv, cv; sincos_acc(ang, sv, cv); ct[e] = cv; st[e] = sv; }
        const float* mem = a.in[I_MEM]; const float* mw = a.in[I_MNORMW]; bf16_t* memn = (bf16_t*)(ws + WS_MEMN);
        for (int m = gw; m < NB * MEMLEN; m += NGW) {
            const f32x4* xr = (const f32x4*)(mem + (size_t)m * DM) + lane; f32x4 v[4]; float s = 0.f;
#pragma unroll
            for (int j = 0; j < 4; ++j) { v[j] = xr[64 * j]; s += (v[j].x * v[j].x + v[j].y * v[j].y) + (v[j].z * v[j].z + v[j].w * v[j].w); }
            const float r = 1.0f / sqrtf(wave_sum(s) * (1.f / DM) + EPS);
#pragma unroll
            for (int j = 0; j < 4; ++j) { const f32x4 w = ((const f32x4*)mw)[lane + 64 * j];
                u32x2 o; o.x = pk2(v[j].x * r * w.x, v[j].y * r * w.y); o.y = pk2(v[j].z * r * w.z, v[j].w * r * w.w);
                *(u32x2*)(memn + (size_t)m * DM + 4 * (lane + 64 * j)) = o; }
        }
    }
}

DI void norm_phase(const float* x, const float* w, bf16_t* h, int gw, int NGW, int lane) {
    f32x4 wv[4];
#pragma unroll
    for (int j = 0; j < 4; ++j) wv[j] = ((const f32x4*)w)[lane + 64 * j];
    for (int m = gw; m < MTOK; m += NGW) {
        const f32x4* xr = (const f32x4*)(x + (size_t)m * DM) + lane; f32x4 v[4]; float s = 0.f;
#pragma unroll
        for (int j = 0; j < 4; ++j) { v[j] = xr[64 * j]; s += (v[j].x * v[j].x + v[j].y * v[j].y) + (v[j].z * v[j].z + v[j].w * v[j].w); }
        const float r = 1.0f / sqrtf(wave_sum(s) * (1.f / DM) + EPS);
#pragma unroll
        for (int j = 0; j < 4; ++j) { u32x2 o; o.x = pk2(v[j].x * r * wv[j].x, v[j].y * r * wv[j].y); o.y = pk2(v[j].z * r * wv[j].z, v[j].w * r * wv[j].w);
            *(u32x2*)(h + (size_t)m * DM + 4 * (lane + 64 * j)) = o; }
    }
}
DI void final_norm_phase(const float* x, const float* w, float* out, int gw, int NGW, int lane) {
    f32x4 wv[4];
#pragma unroll
    for (int j = 0; j < 4; ++j) wv[j] = ((const f32x4*)w)[lane + 64 * j];
    for (int m = gw; m < MTOK; m += NGW) {
        const f32x4* xr = (const f32x4*)(x + (size_t)m * DM) + lane; f32x4 v[4]; float s = 0.f;
#pragma unroll
        for (int j = 0; j < 4; ++j) { v[j] = xr[64 * j]; s += (v[j].x * v[j].x + v[j].y * v[j].y) + (v[j].z * v[j].z + v[j].w * v[j].w); }
        const float r = 1.0f / sqrtf(wave_sum(s) * (1.f / DM) + EPS);
#pragma unroll
        for (int j = 0; j < 4; ++j) ((f32x4*)(out + (size_t)m * DM))[lane + 64 * j] = v[j] * r * wv[j];
    }
}

constexpr int TP = 136;

DI void e0_unit(const Args& a, int li, int unit, LAS unsigned char* lds, int tid, int wave, int lane) {
    unsigned char* R = a.ws + WS_R;
    bf16_t* PROJ = (bf16_t*)(R + R_PROJ); bf16_t* CONV = (bf16_t*)(R + R_CONV); bf16_t* XDT = (bf16_t*)(R + R_XDT); float* CUMS = (float*)(R + R_CUMS);
    const float* COS = (const float*)(a.ws + WS_COS); const float* SIN = (const float*)(a.ws + WS_SIN);
    const int half = unit & 1, c = (unit >> 1) & 31, b = unit >> 6;
    const int crow0 = b * SEQ + c * 128;
    LAS float* dts = (LAS float*)lds;
    LAS float* das = dts + 1024;
    LAS float* cus = das + 1024;
    __syncthreads();
#pragma unroll
    for (int k = 0; k < 2; ++k) { const int idx = tid + 512 * k, l = idx >> 3, hd = idx & 7;
        const float raw = bf2f(PROJ[(size_t)(crow0 + l) * EV_PITCH + 3328 + hd]) + a.in[I_DTB][li * 8 + hd];
        const float dt = raw > 20.f ? raw : log1pf(expf(raw));
        const float av = -expf(a.in[I_ALOG][li * 8 + hd]);
        dts[l * 8 + hd] = dt; das[l * 8 + hd] = dt * av; }
    __syncthreads();
    {
        const float v0 = das[(2 * lane) * 8 + wave], v1 = das[(2 * lane + 1) * 8 + wave]; float s = v0 + v1;
#pragma unroll
        for (int o = 1; o < 64; o <<= 1) { const float t = __shfl_up(s, o); if (lane >= o) s += t; }
        cus[(2 * lane) * 8 + wave] = s - v1; cus[(2 * lane + 1) * 8 + wave] = s; }
    __syncthreads();
    for (int idx = tid; idx < 64 * 16; idx += 512) { const int rl = idx >> 4, k = idx & 15, l = half * 64 + rl; float v = 0.f;
        if (k < 8) v = cus[l * 8 + k]; else if (k < 12) v = (float)(l + 1) * log1pf(-exp2f(-5.0f - (float)(k - 8)));
        CUMS[(size_t)(crow0 + l) * 16 + k] = v; }
    const int r0 = crow0 + half * 64, pos0 = c * 128 + half * 64;
    for (int it = tid; it < 64 * 128; it += 512) { const int rl = it >> 7, ch = it & 127, col = ch * 8, i0 = (col & 127) >> 1;
        const f32x4 cs = *(const f32x4*)(COS + (size_t)(pos0 + rl) * 64 + i0), sn = *(const f32x4*)(SIN + (size_t)(pos0 + rl) * 64 + i0);
        u32x4* p = (u32x4*)(PROJ + (size_t)(r0 + rl) * EV_PITCH + col); const u32x4 v = *p; const float sc = col >= 512 ? 0.08838834764831845f : 1.0f; u32x4 o;
#pragma unroll
        for (int e = 0; e < 4; ++e) { const float t1 = bflo(v[e]), t2 = bfhi(v[e]); o[e] = pk2((t1 * cs[e] - t2 * sn[e]) * sc, (t1 * sn[e] + t2 * cs[e]) * sc); }
        *p = o; }
    const float* cw = a.in[I_CONVW] + (size_t)li * 4 * 768; const float* cb = a.in[I_CONVB] + (size_t)li * 768;
    for (int it = tid; it < 64 * 96; it += 512) { const int rl = it / 96, ch = (it % 96) * 8; const int pos = pos0 + rl;
        float acc[8];
        { const f32x4 b0 = *(const f32x4*)(cb + ch), b1 = *(const f32x4*)(cb + ch + 4); acc[0] = b0.x; acc[1] = b0.y; acc[2] = b0.z; acc[3] = b0.w; acc[4] = b1.x; acc[5] = b1.y; acc[6] = b1.z; acc[7] = b1.w; }
#pragma unroll
        for (int i = 0; i < 4; ++i) { const int ps = pos - 3 + i; if (ps >= 0) {
            const u32x4 v = *(const u32x4*)(PROJ + (size_t)(b * SEQ + ps) * EV_PITCH + 2560 + ch);
            const f32x4 w0 = *(const f32x4*)(cw + i * 768 + ch), w1 = *(const f32x4*)(cw + i * 768 + ch + 4);
            acc[0] += w0.x * bflo(v.x); acc[1] += w0.y * bfhi(v.x); acc[2] += w0.z * bflo(v.y); acc[3] += w0.w * bfhi(v.y);
            acc[4] += w1.x * bflo(v.z); acc[5] += w1.y * bfhi(v.z); acc[6] += w1.z * bflo(v.w); acc[7] += w1.w * bfhi(v.w); } }
#pragma unroll
        for (int e = 0; e < 8; ++e) acc[e] = silu_f(acc[e]);
        u32x4 o; o.x = pk2(acc[0], acc[1]); o.y = pk2(acc[2], acc[3]); o.z = pk2(acc[4], acc[5]); o.w = pk2(acc[6], acc[7]);
        *(u32x4*)(CONV + (size_t)(r0 + rl) * 768 + ch) = o;
        if (ch < 512) { const float dt = dts[(half * 64 + rl) * 8 + (ch >> 6)];
            u32x4 x; x.x = pk2(acc[0] * dt, acc[1] * dt); x.y = pk2(acc[2] * dt, acc[3] * dt); x.z = pk2(acc[4] * dt, acc[5] * dt); x.w = pk2(acc[6] * dt, acc[7] * dt);
            *(u32x4*)(XDT + (size_t)(r0 + rl) * 512 + ch) = x; } }
}

template <int NCOL, bool WEIGHT>
DI void stage_T(const bf16_t* src, int ld, LAS bf16_t* dstT, const float* cum, int tid) {
    constexpr int CPR = NCOL / 8;
    float cl = 0.f; if (WEIGHT) cl = cum[127 * 16];
    for (int it = tid; it < 128 * CPR; it += 512) { const int j = it / CPR, ch = it % CPR;
        const u32x4 v = *(const u32x4*)(src + (size_t)j * ld + ch * 8);
        float w = 1.f; if (WEIGHT) w = ex2((cl - cum[j * 16]) * LOG2E);
#pragma unroll
        for (int e = 0; e < 4; ++e) { float lo = bflo(v[e]), hi = bfhi(v[e]); if (WEIGHT) { lo *= w; hi *= w; }
            dstT[(ch * 8 + 2 * e) * TP + j] = f2bf(lo); dstT[(ch * 8 + 2 * e + 1) * TP + j] = f2bf(hi); } }
}
template <int NCOL>
DI void stage_N(const bf16_t* src, int ld, LAS bf16_t* dst, int tid) {
    constexpr int CPR = NCOL / 8;
    for (int it = tid; it < 128 * CPR; it += 512) { const int j = it / CPR, ch = it % CPR;
        *(LAS u32x4*)(dst + j * (NCOL + 8) + ch * 8) = *(const u32x4*)(src + (size_t)j * ld + ch * 8); }
}

template <int DK, int DV>
DI void e1_unit(const bf16_t* Kp, int ldk, const bf16_t* Vp, int ldv, const float* cum, float* st, LAS unsigned char* lds, int tid, int wave, int lane) {
    LAS bf16_t* KT = (LAS bf16_t*)lds; LAS bf16_t* VT = KT + DK * TP;
    __syncthreads();
    stage_T<DK, false>(Kp, ldk, KT, cum, tid);
    stage_T<DV, true>(Vp, ldv, VT, cum, tid);
    __syncthreads();
    constexpr int NTILES = DK / 16, TPW = (DV / 16) * NTILES / 8;
    const int lr = lane & 15, lq = lane >> 4; const int mt = (wave * TPW) / NTILES, nt0 = (wave * TPW) % NTILES;
    f32x4 acc[TPW];
#pragma unroll
    for (int i = 0; i < TPW; ++i) acc[i] = (f32x4){0.f, 0.f, 0.f, 0.f};
#pragma unroll
    for (int ks = 0; ks < 4; ++ks) { const bf16x8 xf = *(const LAS bf16x8*)(VT + (mt * 16 + lr) * TP + ks * 32 + lq * 8);
#pragma unroll
        for (int i = 0; i < TPW; ++i) { const bf16x8 yf = *(const LAS bf16x8*)(KT + ((nt0 + i) * 16 + lr) * TP + ks * 32 + lq * 8); acc[i] = mfma16(xf, yf, acc[i]); } }
#pragma unroll
    for (int i = 0; i < TPW; ++i)
#pragma unroll
        for (int t = 0; t < 4; ++t) st[(size_t)(mt * 16 + 4 * lq + t) * DK + (nt0 + i) * 16 + lr] = acc[i][t];
}

template <int DK, int DV, bool RET>
DI void e3_unit(const bf16_t* Qp, int ldq, const bf16_t* Kp, int ldk, const bf16_t* Vp, int ldv, const float* cum, const bf16_t* Sin,
                const bf16_t* gz, int ldgz, const bf16_t* xs, float dskip, bf16_t* outp, int ldo, LAS unsigned char* lds, int tid, int wave, int lane) {
    constexpr int QP = DK + 8;
    LAS bf16_t* Qs = (LAS bf16_t*)lds; LAS bf16_t* Ks = Qs + 128 * QP; LAS bf16_t* VT = Ks + 128 * QP; LAS bf16_t* P = VT + DV * TP; LAS float* cumL = (LAS float*)(P + 128 * TP);
    __syncthreads();
    stage_N<DK>(Qp, ldq, Qs, tid); stage_N<DK>(Kp, ldk, Ks, tid); stage_T<DV, false>(Vp, ldv, VT, cum, tid);
    if (tid < 128) cumL[tid] = cum[tid * 16];
    __syncthreads();
    const int lr = lane & 15, lq = lane >> 4, i0 = wave * 16;
    bf16x8 qf[DK / 32];
#pragma unroll
    for (int ks = 0; ks < DK / 32; ++ks) qf[ks] = *(const LAS bf16x8*)(Qs + (i0 + lr) * QP + ks * 32 + lq * 8);
    float ci[4];
#pragma unroll
    for (int t = 0; t < 4; ++t) ci[t] = cumL[i0 + 4 * lq + t];
#pragma unroll
    for (int nt = 0; nt < 8; ++nt) {
        f32x4 s = (f32x4){0.f, 0.f, 0.f, 0.f};
        if (nt <= wave) {
#pragma unroll
            for (int ks = 0; ks < DK / 32; ++ks) { const bf16x8 kf = *(const LAS bf16x8*)(Ks + (nt * 16 + lr) * QP + ks * 32 + lq * 8); s = mfma16(qf[ks], kf, s); }
        }
        const int j = nt * 16 + lr; const float cj = cumL[j];
#pragma unroll
        for (int t = 0; t < 4; ++t) { const int i = i0 + 4 * lq + t; const float p = (i >= j) ? s[t] * ex2((ci[t] - cj) * LOG2E) : 0.f; P[i * TP + j] = f2bf(p); }
    }
    f32x4 o[DV / 16];
#pragma unroll
    for (int nt = 0; nt < DV / 16; ++nt) { o[nt] = (f32x4){0.f, 0.f, 0.f, 0.f};
#pragma unroll
        for (int ks = 0; ks < DK / 32; ++ks) { const bf16x8 sf = *(const bf16x8*)(Sin + (size_t)(nt * 16 + lr) * DK + ks * 32 + lq * 8); o[nt] = mfma16(qf[ks], sf, o[nt]); }
#pragma unroll
        for (int t = 0; t < 4; ++t) o[nt][t] *= ex2(ci[t] * LOG2E); }
    LDS_WAIT();
#pragma unroll
    for (int ks = 0; ks < 4; ++ks) { const bf16x8 pf = *(const LAS bf16x8*)(P + (i0 + lr) * TP + ks * 32 + lq * 8);
#pragma unroll
        for (int nt = 0; nt < DV / 16; ++nt) { const bf16x8 vf = *(const LAS bf16x8*)(VT + (nt * 16 + lr) * TP + ks * 32 + lq * 8); o[nt] = mfma16(pf, vf, o[nt]); } }
    if (RET) {
        float rs[4];
#pragma unroll
        for (int t = 0; t < 4; ++t) { float ss = 0.f;
#pragma unroll
            for (int nt = 0; nt < DV / 16; ++nt) ss += o[nt][t] * o[nt][t];
            ss = grp16_sum(ss); rs[t] = 1.0f / sqrtf(ss * (1.0f / DV) + EPS); }
#pragma unroll
        for (int nt = 0; nt < DV / 16; ++nt)
#pragma unroll
            for (int t = 0; t < 4; ++t) { const int i = i0 + 4 * lq + t; const float g = bf2f(gz[(size_t)i * ldgz + nt * 16 + lr]);
                outp[(size_t)i * ldo + nt * 16 + lr] = f2bf(o[nt][t] * rs[t] * silu_f(g)); }
    } else {
#pragma unroll
        for (int nt = 0; nt < DV / 16; ++nt)
#pragma unroll
            for (int t = 0; t < 4; ++t) { const int i = i0 + 4 * lq + t; const float z = bf2f(gz[(size_t)i * ldgz + nt * 16 + lr]); const float xv = bf2f(xs[(size_t)i * 768 + nt * 16 + lr]);
                outp[(size_t)i * ldo + nt * 16 + lr] = f2bf((o[nt][t] + dskip * xv) * silu_f(z)); }
    }
}

DI void e1_phase(const Args& a, LAS unsigned char* lds, int tid, int wave, int lane, int bid, int G) {
    unsigned char* R = a.ws + WS_R; const bf16_t* PROJ = (const bf16_t*)(R + R_PROJ); const bf16_t* CONV = (const bf16_t*)(R + R_CONV); const bf16_t* XDT = (const bf16_t*)(R + R_XDT); const float* CUMS = (const float*)(R + R_CUMS);
    for (int u = bid; u < 1536; u += G) {
        if (u < 512) { const int b = u >> 7, c = (u >> 2) & 31, h = u & 3; const size_t row0 = (size_t)b * SEQ + c * 128;
            e1_unit<128, 128>(PROJ + row0 * EV_PITCH + 512 + h * 128, EV_PITCH, PROJ + row0 * EV_PITCH + 1024 + h * 128, EV_PITCH, CUMS + row0 * 16 + 8 + h,
                              (float*)(R + R_STR) + ((size_t)(b * 4 + h) * 32 + c) * 16384, lds, tid, wave, lane);
        } else { const int v = u - 512, b = v >> 8, c = (v >> 3) & 31, hd = v & 7, g = hd >> 2; const size_t row0 = (size_t)b * SEQ + c * 128;
            e1_unit<64, 64>(CONV + row0 * 768 + 512 + g * 64, 768, XDT + row0 * 512 + hd * 64, 512, CUMS + row0 * 16 + hd,
                            (float*)(R + R_STS) + ((size_t)(b * 8 + hd) * 32 + c) * 4096, lds, tid, wave, lane);
        }
    }
}
DI void e2_phase(const Args& a, int tid, int bid, int G) {
    unsigned char* R = a.ws + WS_R; const float* CUMS = (const float*)(R + R_CUMS);
    const float* STR = (const float*)(R + R_STR); const float* STS = (const float*)(R + R_STS); bf16_t* SINR = (bf16_t*)(R + R_SINR); bf16_t* SINS = (bf16_t*)(R + R_SINS);
    for (int idx = bid * 512 + tid; idx < 262144 + 131072; idx += G * 512) {
        if (idx < 262144) { const int bh = idx >> 14, el = idx & 16383, b = bh >> 2, h = bh & 3; float run = 0.f;
            for (int c = 0; c < 32; ++c) { const size_t o = ((size_t)bh * 32 + c) * 16384 + el; SINR[o] = f2bf(run);
                const float dec = expf(CUMS[((size_t)b * SEQ + c * 128 + 127) * 16 + 8 + h]); run = dec * run + STR[o]; }
        } else { const int e = idx - 262144, bh = e >> 12, el = e & 4095, b = bh >> 3, hd = bh & 7; float run = 0.f;
            for (int c = 0; c < 32; ++c) { const size_t o = ((size_t)bh * 32 + c) * 4096 + el; SINS[o] = f2bf(run);
                const float dec = expf(CUMS[((size_t)b * SEQ + c * 128 + 127) * 16 + hd]); run = dec * run + STS[o]; }
        }
    }
}
DI void e3_phase(const Args& a, int li, LAS unsigned char* lds, int tid, int wave, int lane, int bid, int G) {
    unsigned char* R = a.ws + WS_R; const bf16_t* PROJ = (const bf16_t*)(R + R_PROJ); const bf16_t* CONV = (const bf16_t*)(R + R_CONV); const bf16_t* XDT = (const bf16_t*)(R + R_XDT); const float* CUMS = (const float*)(R + R_CUMS);
    bf16_t* MIX = (bf16_t*)(a.ws + WS_H); bf16_t* YP = (bf16_t*)(R + R_YP);
    for (int u = bid; u < 1536; u += G) {
        if (u < 512) { const int b = u >> 7, c = (u >> 2) & 31, h = u & 3; const size_t row0 = (size_t)b * SEQ + c * 128; const bf16_t* pr = PROJ + row0 * EV_PITCH;
            e3_unit<128, 128, true>(pr + h * 128, EV_PITCH, pr + 512 + h * 128, EV_PITCH, pr + 1024 + h * 128, EV_PITCH, CUMS + row0 * 16 + 8 + h,
                                    (const bf16_t*)(R + R_SINR) + ((size_t)(b * 4 + h) * 32 + c) * 16384, pr + 1536 + h * 128, EV_PITCH, nullptr, 0.f,
                                    MIX + row0 * DM + h * 128, DM, lds, tid, wave, lane);
        } else { const int v = u - 512, b = v >> 8, c = (v >> 3) & 31, hd = v & 7, g = hd >> 2; const size_t row0 = (size_t)b * SEQ + c * 128;
            e3_unit<64, 64, false>(CONV + row0 * 768 + 640 + g * 64, 768, CONV + row0 * 768 + 512 + g * 64, 768, XDT + row0 * 512 + hd * 64, 512, CUMS + row0 * 16 + hd,
                                   (const bf16_t*)(R + R_SINS) + ((size_t)(b * 8 + hd) * 32 + c) * 4096, PROJ + row0 * EV_PITCH + 2048 + hd * 64, EV_PITCH,
                                   CONV + row0 * 768 + hd * 64, a.in[I_SSMD][li * 8 + hd], YP + row0 * 512 + hd * 64, 512, lds, tid, wave, lane);
        }
    }
}
DI void e4_phase(const Args& a, int li, int gw, int NGW, int lane) {
    const bf16_t* YP = (const bf16_t*)(a.ws + WS_R + R_YP); bf16_t* MIX = (bf16_t*)(a.ws + WS_H); const float* nw = a.in[I_SSMNW] + (size_t)li * 512;
    const f32x4 w0 = *(const f32x4*)(nw + lane * 8), w1 = *(const f32x4*)(nw + lane * 8 + 4);
    for (int m = gw; m < MTOK; m += NGW) {
        const u32x4 v = *(const u32x4*)(YP + (size_t)m * 512 + lane * 8);
        float f[8] = {bflo(v.x), bfhi(v.x), bflo(v.y), bfhi(v.y), bflo(v.z), bfhi(v.z), bflo(v.w), bfhi(v.w)}; float s = 0.f;
#pragma unroll
        for (int e = 0; e < 8; ++e) s += f[e] * f[e];
        const float r = 1.0f / sqrtf(wave_sum(s) * (1.f / 512.f) + EPS);
        u32x4 o; o.x = pk2(f[0] * r * w0.x, f[1] * r * w0.y); o.y = pk2(f[2] * r * w0.z, f[3] * r * w0.w); o.z = pk2(f[4] * r * w1.x, f[5] * r * w1.y); o.w = pk2(f[6] * r * w1.z, f[7] * r * w1.w);
        *(u32x4*)(MIX + (size_t)m * DM + 512 + lane * 8) = o;
    }
}

template <int MT, int HD, class MaskF>
DI void flash_block(const bf16x8 (&qf)[MT][HD / 32], const bf16_t* Kb, int ldk, const bf16_t* Vt, int ldv,
                    f32x4 (&o)[MT][HD / 16], float (&mrow)[MT][4], float (&lrow)[MT][4], LAS bf16_t* pbuf, float c2, const MaskF& mk, int key0, int lr, int lq) {
    constexpr int PP = 72;
    f32x4 s[MT][4];
#pragma unroll
    for (int mt = 0; mt < MT; ++mt)
#pragma unroll
        for (int nt = 0; nt < 4; ++nt) s[mt][nt] = (f32x4){0.f, 0.f, 0.f, 0.f};
#pragma unroll
    for (int nt = 0; nt < 4; ++nt)
#pragma unroll
        for (int ks = 0; ks < HD / 32; ++ks) { const bf16x8 kf = *(const bf16x8*)(Kb + (size_t)(nt * 16 + lr) * ldk + ks * 32 + lq * 8);
#pragma unroll
            for (int mt = 0; mt < MT; ++mt) s[mt][nt] = mfma16(qf[mt][ks], kf, s[mt][nt]); }
#pragma unroll
    for (int mt = 0; mt < MT; ++mt) {
#pragma unroll
        for (int nt = 0; nt < 4; ++nt) { const bool ok = mk.ok(mt, key0 + nt * 16 + lr);
#pragma unroll
            for (int t = 0; t < 4; ++t) s[mt][nt][t] = ok ? s[mt][nt][t] * c2 : -INFINITY; }
#pragma unroll
        for (int t = 0; t < 4; ++t) {
            float mx = fmaxf(fmaxf(s[mt][0][t], s[mt][1][t]), fmaxf(s[mt][2][t], s[mt][3][t])); mx = grp16_max(mx);
            const float mnew = fmaxf(mrow[mt][t], mx), alpha = ex2(mrow[mt][t] - mnew); mrow[mt][t] = mnew;
            float ps = 0.f;
#pragma unroll
            for (int nt = 0; nt < 4; ++nt) { const float p = ex2(s[mt][nt][t] - mnew); s[mt][nt][t] = p; ps += p; }
            lrow[mt][t] = lrow[mt][t] * alpha + ps;
#pragma unroll
            for (int nt = 0; nt < HD / 16; ++nt) o[mt][nt][t] *= alpha;
        }
#pragma unroll
        for (int nt = 0; nt < 4; ++nt)
#pragma unroll
            for (int t = 0; t < 4; ++t) pbuf[(mt * 16 + 4 * lq + t) * PP + nt * 16 + lr] = f2bf(s[mt][nt][t]);
    }
    LDS_WAIT();
#pragma unroll
    for (int ks = 0; ks < 2; ++ks) { bf16x8 pf[MT];
#pragma unroll
        for (int mt = 0; mt < MT; ++mt) pf[mt] = *(const LAS bf16x8*)(pbuf + (mt * 16 + lr) * PP + ks * 32 + lq * 8);
#pragma unroll
        for (int nt = 0; nt < HD / 16; ++nt) { const bf16x8 vf = *(const bf16x8*)(Vt + (size_t)(nt * 16 + lr) * ldv + ks * 32 + lq * 8);
#pragma unroll
            for (int mt = 0; mt < MT; ++mt) o[mt][nt] = mfma16(pf[mt], vf, o[mt][nt]); } }
    LDS_WAIT();
}
struct NoMask { DI bool ok(int, int) const { return true; } };
struct WinMask { int W; int tpos[2]; DI bool ok(int mt, int key) const { return key <= tpos[mt] && tpos[mt] - key < W; } };
struct SelMask { unsigned long long sm[2]; int jb; int tpos[2]; DI bool ok(int mt, int key) const { return ((sm[mt] >> jb) & 1ull) != 0ull && key <= tpos[mt]; } };

struct CmpOrder {
    int G, c; const char* P; const char* W1;
    DI bool next(int i, pg8::Unit& u) const { const int L = i * G + c; if (L >= 16) return false; u.pm = L & 7; u.pn = L >> 3; const int b = u.pm >> 1, g = u.pm & 1;
        u.a = P + ((size_t)b * SEQ * OD_PITCH + 512 + u.pn * 128 + g * 64) * 2; u.b = W1 + (size_t)u.pn * 256 * 2048 * 2; return true; }
};
DI void o2_phase(const Args& a, int gw, int lane) {
    if (gw >= 128) return;
    unsigned char* R = a.ws + WS_R; const bf16_t* HIDC = (const bf16_t*)(R + R_HIDC); const bf16_t* W2T = (const bf16_t*)(a.ws + WS_W + W_C2);
    bf16_t* KC = (bf16_t*)(R + R_KC); bf16_t* VCT = (bf16_t*)(R + R_VCT);
    const int kv = gw >> 6, bg = (gw >> 3) & 7, n0 = (gw & 7) * 32, lr = lane & 15, lq = lane >> 4;
    const bf16_t* hid = HIDC + ((size_t)(kv * 8 + bg) * 256) * 256; const bf16_t* w2 = W2T + (size_t)kv * 64 * 256;
    if (kv == 0) {
        f32x4 acc[2][4];
#pragma unroll
        for (int mt = 0; mt < 2; ++mt)
#pragma unroll
            for (int nt = 0; nt < 4; ++nt) acc[mt][nt] = (f32x4){0.f, 0.f, 0.f, 0.f};
#pragma unroll
        for (int ks = 0; ks < 8; ++ks) { bf16x8 xf[2];
#pragma unroll
            for (int mt = 0; mt < 2; ++mt) xf[mt] = *(const bf16x8*)(hid + (size_t)(n0 + mt * 16 + lr) * 256 + ks * 32 + lq * 8);
#pragma unroll
            for (int nt = 0; nt < 4; ++nt) { const bf16x8 yf = *(const bf16x8*)(w2 + (size_t)(nt * 16 + lr) * 256 + ks * 32 + lq * 8);
#pragma unroll
                for (int mt = 0; mt < 2; ++mt) acc[mt][nt] = mfma16(xf[mt], yf, acc[mt][nt]); } }
#pragma unroll
        for (int mt = 0; mt < 2; ++mt)
#pragma unroll
            for (int nt = 0; nt < 4; ++nt)
#pragma unroll
                for (int t = 0; t < 4; ++t) KC[((size_t)bg * 256 + n0 + mt * 16 + 4 * lq + t) * 64 + nt * 16 + lr] = f2bf(acc[mt][nt][t]);
    } else {
        f32x4 acc[4][2];
#pragma unroll
        for (int mt = 0; mt < 4; ++mt)
#pragma unroll
            for (int nt = 0; nt < 2; ++nt) acc[mt][nt] = (f32x4){0.f, 0.f, 0.f, 0.f};
#pragma unroll
        for (int ks = 0; ks < 8; ++ks) { bf16x8 yf[2];
#pragma unroll
            for (int nt = 0; nt < 2; ++nt) yf[nt] = *(const bf16x8*)(hid + (size_t)(n0 + nt * 16 + lr) * 256 + ks * 32 + lq * 8);
#pragma unroll
            for (int mt = 0; mt < 4; ++mt) { const bf16x8 xf = *(const bf16x8*)(w2 + (size_t)(mt * 16 + lr) * 256 + ks * 32 + lq * 8);
#pragma unroll
                for (int nt = 0; nt < 2; ++nt) acc[mt][nt] = mfma16(xf, yf[nt], acc[mt][nt]); } }
#pragma unroll
        for (int mt = 0; mt < 4; ++mt)
#pragma unroll
            for (int nt = 0; nt < 2; ++nt)
#pragma unroll
                for (int t = 0; t < 4; ++t) VCT[((size_t)bg * 64 + mt * 16 + 4 * lq + t) * 256 + n0 + nt * 16 + lr] = f2bf(acc[mt][nt][t]);
    }
}

constexpr int O3_IMP = 102400, O3_SELM = 139264, O3_UNION = 139776;
constexpr int O3_OTP = 68, O3_PBUF = 0, O3_KV = 36864, O3_NST = 4;
struct WinMaskT { int W; int tpos[2]; DI void set_block(int) {} DI bool ok(int mt, int key) const { return key <= tpos[mt] && tpos[mt] - key < W; } };
struct SelMaskT { unsigned long long sm[2]; int jb; int tpos[2]; DI void set_block(int j) { jb = j; } DI bool ok(int mt, int key) const { return ((sm[mt] >> jb) & 1ull) != 0ull && key <= tpos[mt]; } };

template <class MaskF>
DI void flash_pass_lds(const bf16x8 (&qf)[2][2], const bf16_t* Kg, int ldk, const bf16_t* Vg, int ldv, unsigned long long use,
                       f32x4 (&o)[2][4], float (&mrow)[2], float (&lrow)[2], LAS unsigned char* lds, float c2, MaskF& mk, int tid, int wave, int lr, int lq) {
    constexpr int PP = 72;
    LAS bf16_t* pbuf = (LAS bf16_t*)(lds + O3_PBUF + wave * 4608);
    int R, C; pg8::stage_rc(tid * 16, R, C);
    const bf16_t* ksrc = Kg + (size_t)R * ldk + C; const bf16_t* vsrc = Vg + (size_t)R * ldv + C;
    const int koff = pg8::lds_byte(lr, lq * 8);
#pragma unroll
    for (int mt = 0; mt < 2; ++mt) { mrow[mt] = -1e30f; lrow[mt] = 0.f;
#pragma unroll
        for (int nt = 0; nt < 4; ++nt) o[mt][nt] = (f32x4){0.f, 0.f, 0.f, 0.f}; }
    __syncthreads();
    if (use == 0ull) return;
    unsigned long long rem_issue = use; int nissued = 0; const int total = __builtin_popcountll(use);
#define O3_ISSUE() do { const int j_ = __builtin_ctzll(rem_issue); rem_issue &= rem_issue - 1ull; const int b_ = (nissued & (O3_NST - 1)) * 16384; ++nissued; \
        __builtin_amdgcn_global_load_lds((const unsigned*)(ksrc + (size_t)j_ * 64 * ldk), (LAS unsigned*)(lds + O3_KV + b_ + wave * 1024), 16, 0, 0); \
        __builtin_amdgcn_global_load_lds((const unsigned*)(vsrc + j_ * 64), (LAS unsigned*)(lds + O3_KV + b_ + 8192 + wave * 1024), 16, 0, 0); } while (0)
#pragma unroll 1
    for (int k = 0; k < O3_NST - 1 && rem_issue; ++k) O3_ISSUE();
#pragma unroll 1
    for (int i = 0; i < total; ++i) {
        const int jb = __builtin_ctzll(use); use &= use - 1ull; const int buf = i & (O3_NST - 1);
        const int ahead = nissued - i - 1;
        if (ahead >= 2) asm volatile("s_waitcnt vmcnt(4)" ::: "memory"); else if (ahead == 1) asm volatile("s_waitcnt vmcnt(2)" ::: "memory"); else asm volatile("s_waitcnt vmcnt(0)" ::: "memory");
        asm volatile("s_waitcnt lgkmcnt(0)" ::: "memory"); __builtin_amdgcn_s_barrier(); asm volatile("" ::: "memory");
        if (rem_issue) O3_ISSUE();
        const LAS unsigned char* kb = lds + O3_KV + buf * 16384 + koff; const LAS unsigned char* vb = kb + 8192;
        mk.set_block(jb);
        const int key0 = jb * 64 + 4 * lq;
        f32x4 s[2][4];
#pragma unroll
        for (int mt = 0; mt < 2; ++mt)
#pragma unroll
            for (int nt = 0; nt < 4; ++nt) s[mt][nt] = (f32x4){0.f, 0.f, 0.f, 0.f};
#pragma unroll
        for (int nt = 0; nt < 4; ++nt)
#pragma unroll
            for (int ks = 0; ks < 2; ++ks) { const bf16x8 kf = *(const LAS bf16x8*)(kb + nt * 2048 + ks * 1024);
#pragma unroll
                for (int mt = 0; mt < 2; ++mt) s[mt][nt] = mfma16(kf, qf[mt][ks], s[mt][nt]); }
#pragma unroll
        for (int mt = 0; mt < 2; ++mt) {
            float mx = -INFINITY;
#pragma unroll
            for (int nt = 0; nt < 4; ++nt)
#pragma unroll
                for (int t = 0; t < 4; ++t) { const float v = mk.ok(mt, key0 + nt * 16 + t) ? s[mt][nt][t] : -INFINITY; s[mt][nt][t] = v; mx = fmaxf(mx, v); }
            mx = fmaxf(mx, __shfl_xor(mx, 16)); mx = fmaxf(mx, __shfl_xor(mx, 32));
            const float mnew = fmaxf(mrow[mt], mx * c2), alpha = ex2(mrow[mt] - mnew); mrow[mt] = mnew;
            float ps = 0.f;
#pragma unroll
            for (int nt = 0; nt < 4; ++nt) {
#pragma unroll
                for (int t = 0; t < 4; ++t) { const float p = ex2(__builtin_fmaf(s[mt][nt][t], c2, -mnew)); s[mt][nt][t] = p; ps += p; }
                u32x2 w; w.x = pk2(s[mt][nt][0], s[mt][nt][1]); w.y = pk2(s[mt][nt][2], s[mt][nt][3]);
                *(LAS u32x2*)(pbuf + (mt * 16 + lr) * PP + nt * 16 + 4 * lq) = w; }
            lrow[mt] = lrow[mt] * alpha + ps;
#pragma unroll
            for (int nt = 0; nt < 4; ++nt) o[mt][nt] *= alpha;
        }
        LDS_WAIT();
#pragma unroll
        for (int ks = 0; ks < 2; ++ks) { bf16x8 pf[2];
#pragma unroll
            for (int mt = 0; mt < 2; ++mt) pf[mt] = *(const LAS bf16x8*)(pbuf + (mt * 16 + lr) * PP + ks * 32 + lq * 8);
#pragma unroll
            for (int nt = 0; nt < 4; ++nt) { const bf16x8 vf = *(const LAS bf16x8*)(vb + nt * 2048 + ks * 1024);
#pragma unroll
                for (int mt = 0; mt < 2; ++mt) o[mt][nt] = mfma16(vf, pf[mt], o[mt][nt]); } }
        LDS_WAIT();
    }
#undef O3_ISSUE
#pragma unroll
    for (int mt = 0; mt < 2; ++mt) { lrow[mt] += __shfl_xor(lrow[mt], 16); lrow[mt] += __shfl_xor(lrow[mt], 32); }
}

DI void o3_unit(const Args& a, int li, int bg, int tile, LAS unsigned char* lds, int tid, int wave, int lane) {
    asm volatile("" : "+v"(lane), "+v"(tid));
    unsigned char* R = a.ws + WS_R; const bf16_t* PROJ = (const bf16_t*)(R + R_PROJ); const bf16_t* VTb = (const bf16_t*)(R + R_VT);
    const bf16_t* KC = (const bf16_t*)(R + R_KC); const bf16_t* VCT = (const bf16_t*)(R + R_VCT); bf16_t* MIX = (bf16_t*)(a.ws + WS_H);
    const int b = bg >> 1, g = bg & 1, t0 = tile * 64, lr = lane & 15, lq = lane >> 4; const size_t rowb = (size_t)b * SEQ;
    LAS float* IMP = (LAS float*)(lds + O3_IMP + wave * 2048);
    LAS unsigned long long* SELM = (LAS unsigned long long*)(lds + O3_SELM + wave * 64); LAS unsigned long long* UNI8 = (LAS unsigned long long*)(lds + O3_UNION);
    LAS bf16_t* pbuf = (LAS bf16_t*)(lds + O3_PBUF + wave * 4608);
    const float c2 = 0.125f * LOG2E;
    const int e = lr & 3; int qpos[2]; qpos[0] = t0 + 8 * wave + (lr >> 2); qpos[1] = qpos[0] + 4;
    const int koff = pg8::lds_byte(lr, lq * 8);
    __syncthreads();
    {
        int Rr, Cc; pg8::stage_rc(tid * 16, Rr, Cc);
#pragma unroll
        for (int c = 0; c < 4; ++c) {
            __builtin_amdgcn_global_load_lds((const unsigned*)(KC + ((size_t)bg * 256 + c * 64 + Rr) * 64 + Cc), (LAS unsigned*)(lds + O3_KV + c * 16384 + wave * 1024), 16, 0, 0);
            __builtin_amdgcn_global_load_lds((const unsigned*)(VCT + ((size_t)bg * 64 + Rr) * 256 + c * 64 + Cc), (LAS unsigned*)(lds + O3_KV + c * 16384 + 8192 + wave * 1024), 16, 0, 0); }
    }
    bf16x8 qf[2][2];
#pragma unroll
    for (int mt = 0; mt < 2; ++mt)
#pragma unroll
        for (int ks = 0; ks < 2; ++ks) qf[mt][ks] = *(const bf16x8*)(PROJ + (rowb + t0 + 8 * wave + 4 * mt + (lr >> 2)) * OD_PITCH + g * 256 + (lr & 3) * 64 + ks * 32 + lq * 8);
#define GATE(mt, br) sigmoid_f(bf2f(PROJ[(rowb + qpos[mt]) * OD_PITCH + 1664 + g * 12 + e * 3 + (br)]))
    VM_WAIT(); __syncthreads();
    f32x4 oacc[2][4];
#pragma unroll
    for (int mt = 0; mt < 2; ++mt) {
        f32x4 s[4][4];
#pragma unroll
        for (int c = 0; c < 4; ++c)
#pragma unroll
            for (int nt = 0; nt < 4; ++nt) { s[c][nt] = (f32x4){0.f, 0.f, 0.f, 0.f};
#pragma unroll
                for (int ks = 0; ks < 2; ++ks) { const bf16x8 kf = *(const LAS bf16x8*)(lds + O3_KV + c * 16384 + koff + nt * 2048 + ks * 1024); s[c][nt] = mfma16(kf, qf[mt][ks], s[c][nt]); } }
        float mx = -INFINITY;
#pragma unroll
        for (int c = 0; c < 4; ++c)
#pragma unroll
            for (int nt = 0; nt < 4; ++nt)
#pragma unroll
                for (int t = 0; t < 4; ++t) { const int n = c * 64 + nt * 16 + 4 * lq + t; const bool ok = (n < 255) && (16 * n + 31 <= qpos[mt]);
                    const float v = ok ? s[c][nt][t] : -INFINITY; s[c][nt][t] = v; mx = fmaxf(mx, v); }
        mx = fmaxf(mx, __shfl_xor(mx, 16)); mx = fmaxf(mx, __shfl_xor(mx, 32));
        const float mm = (mx == -INFINITY) ? 0.f : mx * c2; float sum = 0.f;
#pragma unroll
        for (int c = 0; c < 4; ++c)
#pragma unroll
            for (int nt = 0; nt < 4; ++nt)
#pragma unroll
                for (int t = 0; t < 4; ++t) { const float p = ex2(__builtin_fmaf(s[c][nt][t], c2, -mm)); s[c][nt][t] = p; sum += p; }
        sum += __shfl_xor(sum, 16); sum += __shfl_xor(sum, 32);
        const float inv = 1.0f / fmaxf(sum, 1e-30f);
#pragma unroll
        for (int c = 0; c < 4; ++c)
#pragma unroll
            for (int nt = 0; nt < 4; ++nt) s[c][nt] *= inv;
        const int srcl = (lane + 48) & 63;
#pragma unroll
        for (int c = 0; c < 4; ++c)
#pragma unroll
            for (int nt = 0; nt < 4; ++nt) {
                const float own = (s[c][nt][0] + s[c][nt][1]) + (s[c][nt][2] + s[c][nt][3]);
                const float a_ = __shfl(s[c][nt][3], srcl);
                float b_ = 0.f; if (c > 0 || nt > 0) b_ = __shfl(s[(nt > 0) ? c : c - (c > 0 ? 1 : 0)][(nt > 0) ? nt - 1 : 3][3], srcl);
                float v = own + (lq > 0 ? a_ : b_);
                v += __shfl_xor(v, 1); v += __shfl_xor(v, 2);
                if (e == 0) IMP[(4 * mt + (lr >> 2)) * 64 + c * 16 + nt * 4 + lq] = v; }
#pragma unroll
        for (int nt = 0; nt < 4; ++nt) oacc[mt][nt] = (f32x4){0.f, 0.f, 0.f, 0.f};
#pragma unroll
        for (int c = 0; c < 4; ++c) {
#pragma unroll
            for (int nt = 0; nt < 4; ++nt) { u32x2 w; w.x = pk2(s[c][nt][0], s[c][nt][1]); w.y = pk2(s[c][nt][2], s[c][nt][3]); *(LAS u32x2*)(pbuf + lr * 72 + nt * 16 + 4 * lq) = w; }
            LDS_WAIT();
#pragma unroll
            for (int ks = 0; ks < 2; ++ks) { const bf16x8 pf = *(const LAS bf16x8*)(pbuf + lr * 72 + ks * 32 + lq * 8);
#pragma unroll
                for (int nt = 0; nt < 4; ++nt) { const bf16x8 vf = *(const LAS bf16x8*)(lds + O3_KV + c * 16384 + 8192 + koff + nt * 2048 + ks * 1024); oacc[mt][nt] = mfma16(vf, pf, oacc[mt][nt]); } }
            LDS_WAIT();
        }
        const float g0 = GATE(mt, 0);
#pragma unroll
        for (int nt = 0; nt < 4; ++nt) oacc[mt][nt] *= g0;
    }
    LDS_WAIT();
    unsigned long long wunion = 0ull;
    {
        const int j = lane; const bool valid = j <= tile, forced = valid && (j == 0 || j == tile || j == tile - 1);
#pragma unroll
        for (int tk = 0; tk < 8; ++tk) { const float imp = IMP[tk * 64 + j]; IMP[tk * 64 + j] = forced ? 1e6f : (valid ? imp : -INFINITY); }
        LDS_WAIT();
#pragma unroll 1
        for (int tk = 0; tk < 8; ++tk) {
            const float sc = IMP[tk * 64 + j]; int rank = 0;
#pragma unroll
            for (int q4 = 0; q4 < 16; ++q4) { const f32x4 v = *(const LAS f32x4*)(IMP + tk * 64 + q4 * 4);
#pragma unroll
                for (int k = 0; k < 4; ++k) { const int jp = q4 * 4 + k; rank += ((v[k] > sc) || (v[k] == sc && jp < j)) ? 1 : 0; } }
            const unsigned long long m = __ballot(valid && rank < 16);
            wunion |= m; if (lane == 0) SELM[tk] = m;
        }
    }
    if (lane == 0) UNI8[wave] = wunion;
    LDS_WAIT();
    __syncthreads();
    unsigned long long use_sel = 0ull;
#pragma unroll
    for (int w = 0; w < 8; ++w) use_sel |= UNI8[w];
    { const unsigned lo32 = __builtin_amdgcn_readfirstlane((unsigned)use_sel), hi32 = __builtin_amdgcn_readfirstlane((unsigned)(use_sel >> 32)); use_sel = ((unsigned long long)hi32 << 32) | lo32; }
    f32x4 o[2][4]; float mrow[2], lrow[2];
    {
        SelMaskT mk; mk.sm[0] = SELM[lr >> 2]; mk.sm[1] = SELM[4 + (lr >> 2)]; mk.tpos[0] = qpos[0]; mk.tpos[1] = qpos[1]; mk.jb = 0;
        flash_pass_lds(qf, PROJ + rowb * OD_PITCH + 768 + g * 64, OD_PITCH, VTb + (size_t)(g * 64) * MTOK + rowb, MTOK, use_sel, o, mrow, lrow, lds, c2, mk, tid, wave, lr, lq);
#pragma unroll
        for (int mt = 0; mt < 2; ++mt) { const float f = GATE(mt, 1) / lrow[mt];
#pragma unroll
            for (int nt = 0; nt < 4; ++nt) oacc[mt][nt] += o[mt][nt] * f; }
    }
    {
        WinMaskT mk; mk.W = 512; mk.tpos[0] = qpos[0]; mk.tpos[1] = qpos[1];
        const int jlo = tile >= 8 ? tile - 8 : 0; const unsigned long long use = ((tile == 63) ? ~0ull : ((1ull << (tile + 1)) - 1ull)) & ~((1ull << jlo) - 1ull);
        flash_pass_lds(qf, PROJ + rowb * OD_PITCH + 896 + g * 64, OD_PITCH, VTb + (size_t)(128 + g * 64) * MTOK + rowb, MTOK, use, o, mrow, lrow, lds, c2, mk, tid, wave, lr, lq);
#pragma unroll
        for (int mt = 0; mt < 2; ++mt) { const float f = GATE(mt, 2) / lrow[mt];
#pragma unroll
            for (int nt = 0; nt < 4; ++nt) { const f32x4 v = oacc[mt][nt] + o[mt][nt] * f;
                u32x2 w; w.x = pk2(v[0], v[1]); w.y = pk2(v[2], v[3]); *(u32x2*)(MIX + (rowb + qpos[mt]) * DM + g * 256 + e * 64 + nt * 16 + 4 * lq) = w; } }
    }
    {
#pragma unroll
        for (int mt = 0; mt < 2; ++mt)
#pragma unroll
            for (int ks = 0; ks < 2; ++ks) qf[mt][ks] = *(const bf16x8*)(PROJ + (rowb + t0 + 8 * wave + 4 * mt + (lr >> 2)) * OD_PITCH + 1152 + g * 256 + (lr & 3) * 64 + ks * 32 + lq * 8);
        WinMaskT mk; mk.W = 128; mk.tpos[0] = qpos[0]; mk.tpos[1] = qpos[1];
        const int jlo = tile >= 2 ? tile - 2 : 0; const unsigned long long use = ((tile == 63) ? ~0ull : ((1ull << (tile + 1)) - 1ull)) & ~((1ull << jlo) - 1ull);
        flash_pass_lds(qf, PROJ + rowb * OD_PITCH + 1024 + g * 64, OD_PITCH, VTb + (size_t)(256 + g * 64) * MTOK + rowb, MTOK, use, o, mrow, lrow, lds, c2, mk, tid, wave, lr, lq);
        const float sk = a.in[I_SINKS][li * 8 + g * 4 + e] * LOG2E;
#pragma unroll
        for (int mt = 0; mt < 2; ++mt) { const float f = 1.0f / (lrow[mt] + ex2(sk - mrow[mt]));
#pragma unroll
            for (int nt = 0; nt < 4; ++nt) { const f32x4 v = o[mt][nt] * f;
                u32x2 w; w.x = pk2(v[0], v[1]); w.y = pk2(v[2], v[3]); *(u32x2*)(MIX + (rowb + qpos[mt]) * DM + 512 + g * 256 + e * 64 + nt * 16 + 4 * lq) = w; } }
    }
#undef GATE
}
DI void o3_phase(const Args& a, int li, LAS unsigned char* lds, int tid, int wave, int lane, int bid, int G) {
    for (int p = bid; p < 256; p += G) { const int bg = p >> 5, tl = p & 31;
        o3_unit(a, li, bg, 63 - tl, lds, tid, wave, lane);
        o3_unit(a, li, bg, tl, lds, tid, wave, lane); }
}

constexpr int XA_PBUF = 0, XA_PP = 40, XA_KV = 10240, XA_STAGE = 32768, XA_NST = 4;
DI void xattn_phase(const Args& a, LAS unsigned char* lds, int tid, int wave, int lane, int bid, int G) {
    const bf16_t* Q = (const bf16_t*)(a.ws + WS_R + R_Q); bf16_t* O = (bf16_t*)(a.ws + WS_H); const bf16_t* KX = (const bf16_t*)(a.ws + WS_KX); const bf16_t* VTX = (const bf16_t*)(a.ws + WS_VTX);
    const float c2 = 0.0625f * LOG2E;
    for (int u = bid; u < 512; u += G) {
        asm volatile("" : "+v"(lane), "+v"(tid));
        const int lr = lane & 15, lq = lane >> 4; LAS bf16_t* pbuf = (LAS bf16_t*)(lds + XA_PBUF + wave * 1280);
        const int b = u >> 7, hd = (u >> 5) & 3, qt = u & 31;
        const size_t row0 = (size_t)b * SEQ + qt * 128 + wave * 16;
        const bf16_t* ksrc[2]; const bf16_t* vsrc[2];
#pragma unroll
        for (int i = 0; i < 2; ++i) { const int bb = tid * 16 + i * 8192, blk = bb >> 10, sb = bb & 1023, sw = sb ^ (((sb >> 9) & 1) << 5);
            ksrc[i] = KX + ((size_t)b * MEMLEN + (blk & 1) * 16 + (sw >> 6)) * DM + hd * 256 + (blk >> 1) * 32 + ((sw & 63) >> 1);
            vsrc[i] = VTX + ((size_t)hd * 256 + blk * 16 + (sw >> 6)) * DM + b * MEMLEN + ((sw & 63) >> 1); }
        const int koff = pg8::lds_byte(lr, lq * 8);
        __syncthreads();
#define XA_ISSUE(j_) do { const int st_ = XA_KV + ((j_) & (XA_NST - 1)) * XA_STAGE + wave * 1024; \
        __builtin_amdgcn_global_load_lds((const unsigned*)(ksrc[0] + (size_t)(j_) * 32 * DM), (LAS unsigned*)(lds + st_), 16, 0, 0); \
        __builtin_amdgcn_global_load_lds((const unsigned*)(ksrc[1] + (size_t)(j_) * 32 * DM), (LAS unsigned*)(lds + st_ + 8192), 16, 0, 0); \
        __builtin_amdgcn_global_load_lds((const unsigned*)(vsrc[0] + (j_) * 32), (LAS unsigned*)(lds + st_ + 16384), 16, 0, 0); \
        __builtin_amdgcn_global_load_lds((const unsigned*)(vsrc[1] + (j_) * 32), (LAS unsigned*)(lds + st_ + 24576), 16, 0, 0); } while (0)
        bf16x8 qf[8];
#pragma unroll
        for (int ks = 0; ks < 8; ++ks) qf[ks] = *(const bf16x8*)(Q + (row0 + lr) * DM + hd * 256 + ks * 32 + lq * 8);
        asm volatile("" ::: "memory");
        XA_ISSUE(0); XA_ISSUE(1); XA_ISSUE(2);
        f32x4 o[16]; float mrow = -1e30f, lsum = 0.f;
#pragma unroll
        for (int nt = 0; nt < 16; ++nt) o[nt] = (f32x4){0.f, 0.f, 0.f, 0.f};
#pragma unroll 1
        for (int j = 0; j < 8; ++j) {
            if (j <= 5) asm volatile("s_waitcnt vmcnt(8)" ::: "memory"); else if (j == 6) asm volatile("s_waitcnt vmcnt(4)" ::: "memory"); else asm volatile("s_waitcnt vmcnt(0)" ::: "memory");
            asm volatile("s_waitcnt lgkmcnt(0)" ::: "memory"); __builtin_amdgcn_s_barrier(); asm volatile("" ::: "memory");
            if (j + 3 < 8) XA_ISSUE(j + 3);
            const LAS unsigned char* st = lds + XA_KV + (j & (XA_NST - 1)) * XA_STAGE + koff;
            f32x4 s[2];
#pragma unroll
            for (int nt = 0; nt < 2; ++nt) { s[nt] = (f32x4){0.f, 0.f, 0.f, 0.f};
#pragma unroll
                for (int ks = 0; ks < 8; ++ks) { const bf16x8 kf = *(const LAS bf16x8*)(st + (ks * 2 + nt) * 1024); s[nt] = mfma16(kf, qf[ks], s[nt]); } }
            float mx = fmaxf(fmaxf(fmaxf(s[0][0], s[0][1]), fmaxf(s[0][2], s[0][3])), fmaxf(fmaxf(s[1][0], s[1][1]), fmaxf(s[1][2], s[1][3])));
            mx = fmaxf(mx, __shfl_xor(mx, 16)); mx = fmaxf(mx, __shfl_xor(mx, 32));
            const float mnew = fmaxf(mrow, mx * c2), alpha = ex2(mrow - mnew); mrow = mnew;
            float ps = 0.f;
#pragma unroll
            for (int nt = 0; nt < 2; ++nt) {
#pragma unroll
                for (int t = 0; t < 4; ++t) { const float p = ex2(__builtin_fmaf(s[nt][t], c2, -mnew)); s[nt][t] = p; ps += p; }
                u32x2 w; w.x = pk2(s[nt][0], s[nt][1]); w.y = pk2(s[nt][2], s[nt][3]); *(LAS u32x2*)(pbuf + lr * XA_PP + nt * 16 + 4 * lq) = w; }
            lsum = lsum * alpha + ps;
#pragma unroll
            for (int nt = 0; nt < 16; ++nt) o[nt] *= alpha;
            LDS_WAIT();
            const bf16x8 pf = *(const LAS bf16x8*)(pbuf + lr * XA_PP + lq * 8);
#pragma unroll
            for (int nt = 0; nt < 16; ++nt) { const bf16x8 vf = *(const LAS bf16x8*)(st + 16384 + nt * 1024); o[nt] = mfma16(vf, pf, o[nt]); }
            LDS_WAIT();
        }
#undef XA_ISSUE
        lsum += __shfl_xor(lsum, 16); lsum += __shfl_xor(lsum, 32);
        const float f = 1.0f / lsum;
#pragma unroll
        for (int nt = 0; nt < 16; ++nt) { const f32x4 v = o[nt] * f; u32x2 w; w.x = pk2(v[0], v[1]); w.y = pk2(v[2], v[3]);
            *(u32x2*)(O + (row0 + lr) * DM + hd * 256 + nt * 16 + 4 * lq) = w; }
    }
}

#ifndef MK_MODE
#define MK_MODE 1
#endif
constexpr int PH_PER_LAYER = 20, PH_FINAL = DEPTH * PH_PER_LAYER, PH_TOTAL = PH_FINAL + 1;
extern __shared__ __attribute__((aligned(16))) unsigned char lds_raw[];

#define PHASE_SETUP \
    asm volatile("" : "+s"(kp_)); \
    LAS unsigned char* lds = (LAS unsigned char*)lds_raw; \
    int tid = threadIdx.x, bid = blockIdx.x, G = gridDim.x; asm volatile("" : "+v"(tid)); asm volatile("" : "+s"(bid), "+s"(G)); \
    const int lane = tid & 63, wave = __builtin_amdgcn_readfirstlane(tid >> 6); const int gw = bid * 8 + wave, NGW = G * 8; (void)bid; \
    Args a; _Pragma("unroll") for (int i_ = 0; i_ < 25; ++i_) a.in[i_] = kp_->in[i_]; a.out = kp_->out; a.ws = kp_->ws; a.ph_lo = 0; a.ph_hi = 0; \
    unsigned char* ws = a.ws; float* X = (float*)(ws + WS_X); bf16_t* H = (bf16_t*)(ws + WS_H); unsigned char* R = ws + WS_R; unsigned char* W = ws + WS_W; \
    (void)lds; (void)tid; (void)lane; (void)wave; (void)G; (void)gw; (void)NGW; (void)X; (void)H; (void)R; (void)W;
#define UNI(x) __builtin_amdgcn_readfirstlane(x)

DI void P_prologue(KP kp_, int layer) { layer = UNI(layer); PHASE_SETUP layer_prologue(kp_, a, layer, lds, tid, wave, lane, gw, NGW); __syncthreads(); }
DI void P_norm(KP kp_, int layer, int which) { layer = UNI(layer); which = UNI(which); PHASE_SETUP
    norm_phase((layer == 0 && which == 0) ? a.in[I_X] : X, a.in[I_NORMW] + ((size_t)layer * 4 + which) * DM, H, gw, NGW, lane); }
DI void P_final(KP kp_) { PHASE_SETUP final_norm_phase(X, a.in[I_FNORMW], a.out, gw, NGW, lane); }
DI void P_gemm_bf16(KP kp_, int which) { which = UNI(which); PHASE_SETUP
    const bf16_t* A = H; const bf16_t* Bt = (const bf16_t*)(W + W_IN); bf16_t* O = (bf16_t*)(R + R_PROJ); int M = MTOK, N = EV_PITCH, ldc = EV_PITCH, rot = 0;
    if (which == 0) { A = (const bf16_t*)(ws + WS_MEMN); Bt = (const bf16_t*)(W + W_XKV); O = (bf16_t*)(ws + WS_KX); M = NB * MEMLEN; N = DM; ldc = DM; }
    else if (which == 1) { A = (const bf16_t*)(W + W_XKV) + (size_t)DM * DM; Bt = (const bf16_t*)(ws + WS_MEMN); O = (bf16_t*)(ws + WS_VTX); M = DM; N = NB * MEMLEN; ldc = DM; rot = 16; }
    else if (which == 3) { N = OD_PITCH; ldc = OD_PITCH; }
    else if (which == 4) { A = (const bf16_t*)(W + W_IN) + (size_t)OD_PITCH * DM; Bt = H; O = (bf16_t*)(R + R_VT); M = 512; N = MTOK; ldc = MTOK; rot = 64; }
    else if (which == 5) { Bt = (const bf16_t*)(W + W_XQ); O = (bf16_t*)(R + R_Q); N = DM; ldc = DM; }
    pg8::Gemm g{A, Bt, DM, DM, 128, 128, DM}; pg8::StaticOrder S; S.init(g, M, N, G, (bid + G - rot) % G);
    pg8::EpiBf16<0> E{O, ldc, nullptr, 0}; pg8::gemm_phase(lds, g, S, E, tid); }
DI void P_gemm_swiglu(KP kp_, int half) { half = UNI(half); PHASE_SETUP
    pg8::Gemm g{H, (const bf16_t*)(W + W_GU) + (size_t)half * 2 * FF * DM, DM, DM, 128, 128, DM}; pg8::StaticOrder S; S.init(g, MTOK, 2 * FF, G, bid);
    pg8::EpiSwiGLU E{(bf16_t*)(R + R_HID), FF}; pg8::gemm_phase(lds, g, S, E, tid); }
DI void P_gemm_resid(KP kp_, int which, int first) { which = UNI(which); first = UNI(first); PHASE_SETUP
    const bf16_t* A = (const bf16_t*)(R + R_HID); const bf16_t* Bt = (const bf16_t*)(W + W_D) + (size_t)which * DM * FF; int K = FF; float sc = 0.5f;
    if (which == 2) { A = H; Bt = (const bf16_t*)(W + W_OUT); K = DM; sc = 1.0f; }
    else if (which == 3) { A = H; Bt = (const bf16_t*)(W + W_XO); K = DM; sc = 1.0f; }
    pg8::Gemm g{A, Bt, K, K, 128, 128, K}; pg8::StaticOrder S; S.init(g, MTOK, DM, G, bid);
    pg8::EpiResid E{first ? a.in[I_X] : X, X, sc}; pg8::gemm_phase(lds, g, S, E, tid); }
DI void P_gemm_cmp(KP kp_) { PHASE_SETUP
    pg8::Gemm g{nullptr, nullptr, 16 * OD_PITCH, 2048, OD_PITCH * 2, 128, 2048};
    CmpOrder S{G, bid, (const char*)(R + R_PROJ), (const char*)(W + W_C1)};
    pg8::EpiBf16<2> E{(bf16_t*)(R + R_HIDC), 256, (const float*)(ws + WS_BIAS1), 1}; pg8::gemm_phase(lds, g, S, E, tid); }
DI void P_e0(KP kp_, int li) { li = UNI(li); PHASE_SETUP for (int u = bid; u < 256; u += G) e0_unit(a, li, u, lds, tid, wave, lane); }
DI void P_e1(KP kp_) { PHASE_SETUP e1_phase(a, lds, tid, wave, lane, bid, G); }
DI void P_e2(KP kp_) { PHASE_SETUP e2_phase(a, tid, bid, G); }
DI void P_e3(KP kp_, int li) { li = UNI(li); PHASE_SETUP e3_phase(a, li, lds, tid, wave, lane, bid, G); }
DI void P_e4(KP kp_, int li) { li = UNI(li); PHASE_SETUP e4_phase(a, li, gw, NGW, lane); }
DI void P_o2(KP kp_) { PHASE_SETUP o2_phase(a, gw, lane); }
DI void P_o3(KP kp_, int li) { li = UNI(li); PHASE_SETUP o3_phase(a, li, lds, tid, wave, lane, bid, G); }
DI void P_xattn(KP kp_) { PHASE_SETUP xattn_phase(a, lds, tid, wave, lane, bid, G); }

DI void grid_bar(KP kp_) {
    asm volatile("" : "+s"(kp_));
    XcdBarrier b; b.bar = (unsigned*)(kp_->ws + WS_CTL) + 4096 + kp_->li * XCD_BAR_WORDS; b.x = xb_xcc_id(); b.st = (volatile LAS unsigned*)((LAS unsigned char*)lds_raw + LDSCTL_OFF) + 8;
    xcd_barrier(b);
}
__global__ void __launch_bounds__(512, 2) fwd_kernel(KArgs ka) {
    KP kp = (KP)__builtin_amdgcn_kernarg_segment_ptr();
    {
        LAS unsigned char* lds = (LAS unsigned char*)lds_raw;
        volatile LAS unsigned* MISC = (volatile LAS unsigned*)(lds + LDSCTL_OFF);
        for (int u = threadIdx.x; u < 128; u += 512) MISC[u] = 0u;
        __syncthreads();
        if (ka.ph_hi - ka.ph_lo > 1) (void)xcd_barrier_post((unsigned*)(ka.ws + WS_CTL) + 4096 + ka.li * XCD_BAR_WORDS, MISC + 8);
    }
#define DUP(bit, call) call; if (DUP_MASK & (1 << (bit))) { call; }
#define PH(id, ...) { KP k_ = kp; asm volatile("" : "+s"(k_)); const int lo_ = k_->ph_lo, hi_ = k_->ph_hi; if (lo_ <= (id) && (id) < hi_) { __VA_ARGS__; if ((id) + 1 < hi_) grid_bar(kp); } }
    for (int layer = 0; layer < DEPTH; ++layer) {
        const int base = layer * PH_PER_LAYER, li = layer >> 1; const bool odd = (layer & 1) != 0;
        PH(base + 0, DUP(9, P_prologue(kp, layer)))
        PH(base + 1, DUP(2, P_gemm_bf16(kp, 0)); DUP(2, P_gemm_bf16(kp, 1)))
        PH(base + 2, DUP(0, P_norm(kp, layer, 0)))
        PH(base + 3, DUP(1, P_gemm_swiglu(kp, 0)))
        PH(base + 4, P_gemm_resid(kp, 0, layer == 0 ? 1 : 0))
        PH(base + 5, DUP(0, P_norm(kp, layer, 1)))
        if (!odd) {
            PH(base + 6, DUP(2, P_gemm_bf16(kp, 2)))
            PH(base + 7, P_e0(kp, li))
            PH(base + 8, DUP(3, P_e1(kp)))
            PH(base + 9, DUP(4, P_e2(kp)))
            PH(base + 10, DUP(5, P_e3(kp, li)))
            PH(base + 11, DUP(6, P_e4(kp, li)))
        } else {
            PH(base + 6, DUP(2, P_gemm_bf16(kp, 3)); DUP(2, P_gemm_bf16(kp, 4)))
            PH(base + 7, DUP(7, P_gemm_cmp(kp)))
            PH(base + 8, DUP(7, P_o2(kp)))
            PH(base + 9, DUP(8, P_o3(kp, li)))
        }
        PH(base + 12, P_gemm_resid(kp, 2, 0))
        PH(base + 13, DUP(0, P_norm(kp, layer, 2)))
        PH(base + 14, DUP(2, P_gemm_bf16(kp, 5)))
        PH(base + 15, DUP(11, P_xattn(kp)))
        PH(base + 16, P_gemm_resid(kp, 3, 0))
        PH(base + 17, DUP(0, P_norm(kp, layer, 3)))
        PH(base + 18, DUP(1, P_gemm_swiglu(kp, 1)))
        PH(base + 19, P_gemm_resid(kp, 1, 0))
    }
    PH(PH_FINAL, DUP(10, P_final(kp)))
#undef PH
}

extern "C" void kernel_launch(void* const* d_in, const int* in_sizes, int n_in, void* d_out, int out_size, void* d_ws, size_t ws_size, hipStream_t stream) {
    static int grid = 0;
    if (grid == 0) {
        if (n_in != 25 || out_size != MTOK * DM || ws_size < WS_END) { fprintf(stderr, "kernel_launch: unexpected problem (n_in %d, out %d, ws %zu < %zu)\n", n_in, out_size, ws_size, (size_t)WS_END); grid = -1; return; }
        int dev = 0, cus = 0, per_cu = 0;
        if (hipGetDevice(&dev) != hipSuccess || hipDeviceGetAttribute(&cus, hipDeviceAttributeMultiprocessorCount, dev) != hipSuccess) { grid = -1; return; }
        if (hipFuncSetAttribute((const void*)fwd_kernel, hipFuncAttributeMaxDynamicSharedMemorySize, LDS_BYTES) != hipSuccess) { fprintf(stderr, "kernel_launch: hipFuncSetAttribute failed\n"); grid = -1; return; }
        if (hipOccupancyMaxActiveBlocksPerMultiprocessor(&per_cu, (const void*)fwd_kernel, 512, LDS_BYTES) != hipSuccess || per_cu < 1) fprintf(stderr, "kernel_launch: occupancy query says %d\n", per_cu);
        (void)hipGetLastError();
        grid = cus;
    }
    if (grid < 0) return;
    (void)hipMemsetAsync((char*)d_ws + WS_CTL, 0, CTL_ZERO_BYTES, stream);
    KArgs a{};
    for (int i = 0; i < 25; ++i) a.in[i] = (const float*)d_in[i];
    a.out = (float*)d_out; a.ws = (unsigned char*)d_ws; a.pad = 0;
#if MK_MODE == 1
    a.ph_lo = 0; a.ph_hi = PH_TOTAL; a.li = 0;
    hipLaunchKernelGGL(fwd_kernel, dim3(grid), dim3(512), LDS_BYTES, stream, a);
#else
    for (int p = 0; p < PH_TOTAL; ++p) { const int l = p % PH_PER_LAYER; if (p < PH_FINAL && (((p / PH_PER_LAYER) & 1) != 0) && (l == 10 || l == 11)) continue;
        a.ph_lo = p; a.ph_hi = p + 1; a.li = 0;
        hipLaunchKernelGGL(fwd_kernel, dim3(grid), dim3(512), LDS_BYTES, stream, a); }
#endif
}
```

```cpp
#include <hip/hip_runtime.h>
#include <cstdio>
#include <cstdint>

#define DI __device__ __forceinline__
#define LAS __attribute__((address_space(3)))
#define GAS __attribute__((address_space(1)))
typedef unsigned short bf16_t;
typedef short bf16x8 __attribute__((ext_vector_type(8)));
typedef float f32x4 __attribute__((ext_vector_type(4)));
typedef float f32x2 __attribute__((ext_vector_type(2)));
typedef unsigned u32x4 __attribute__((ext_vector_type(4)));
typedef unsigned u32x2 __attribute__((ext_vector_type(2)));
typedef __bf16 bf16x2_t __attribute__((ext_vector_type(2)));

#ifndef DUP_MASK
#define DUP_MASK 0
#endif
constexpr int DM = 1024, NB = 4, SEQ = 4096, MTOK = NB * SEQ, DEPTH = 4, FF = 2816, MEMLEN = 256;
constexpr int EV_IN = 3336, EV_PITCH = 3584;
constexpr int OD_IN = 2072, OD_PITCH = 1792;
constexpr float EPS = 1e-6f;
constexpr float LOG2E = 1.4426950408889634f;

constexpr size_t MiB = 1u << 20;
constexpr size_t WS_CTL = 0, CTL_ZERO_BYTES = 1 * MiB;
constexpr size_t WS_COS = 1 * MiB, WS_SIN = 2 * MiB;
constexpr size_t WS_MEMN = 3 * MiB;
constexpr size_t WS_KX = 5 * MiB, WS_VTX = 7 * MiB;
constexpr size_t WS_BIAS1 = 9 * MiB;
constexpr size_t WS_W = 10 * MiB;
constexpr size_t W_GU = 0, W_D = 22 * MiB, W_XQ = 33 * MiB, W_XKV = 35 * MiB, W_XO = 39 * MiB, W_IN = 41 * MiB, W_OUT = 48 * MiB, W_C1 = 50 * MiB, W_C2 = 52 * MiB;
constexpr size_t WS_X = 64 * MiB;
constexpr size_t WS_H = 128 * MiB;
constexpr size_t WS_R = 160 * MiB;
constexpr size_t R_HID = 0;
constexpr size_t R_Q = 0;
constexpr size_t R_PROJ = 0;
constexpr size_t R_CONV = 112 * MiB, R_XDT = 136 * MiB, R_STR = 152 * MiB, R_STS = 184 * MiB, R_SINR = 200 * MiB, R_SINS = 216 * MiB, R_YP = 224 * MiB, R_CUMS = 240 * MiB;
constexpr size_t R_VT = 56 * MiB, R_HIDC = 72 * MiB, R_KC = 74 * MiB, R_VCT = 75 * MiB;
constexpr size_t WS_W2 = 402 * MiB;
constexpr size_t WS_END = 455 * MiB;

constexpr int LDS_BYTES = 147456;
constexpr int LDSCTL_OFF = 147456 - 512;

DI unsigned pk2(float lo, float hi) { f32x2 v = {lo, hi}; bf16x2_t b = __builtin_convertvector(v, bf16x2_t); return __builtin_bit_cast(unsigned, b); }
DI bf16_t f2bf(float f) { return (bf16_t)(pk2(f, 0.f) & 0xffffu); }
DI float bf2f(unsigned h) { return __uint_as_float((h & 0xffffu) << 16); }
DI float bflo(unsigned w) { return __uint_as_float(w << 16); }
DI float bfhi(unsigned w) { return __uint_as_float(w & 0xffff0000u); }
DI float silu_f(float x) { return x * __builtin_amdgcn_rcpf(1.f + __builtin_amdgcn_exp2f(-LOG2E * x)); }
DI float sigmoid_f(float x) { return __builtin_amdgcn_rcpf(1.f + __builtin_amdgcn_exp2f(-LOG2E * x)); }
DI float ex2(float x) { return __builtin_amdgcn_exp2f(x); }
DI f32x4 mfma16(bf16x8 a, bf16x8 b, f32x4 c) { return __builtin_amdgcn_mfma_f32_16x16x32_bf16(a, b, c, 0, 0, 0); }
DI float wave_sum(float v) {
#pragma unroll
    for (int o = 1; o < 64; o <<= 1) v += __shfl_xor(v, o);
    return v;
}
DI float grp16_sum(float v) { v += __shfl_xor(v, 1); v += __shfl_xor(v, 2); v += __shfl_xor(v, 4); v += __shfl_xor(v, 8); return v; }
DI float grp16_max(float v) { v = fmaxf(v, __shfl_xor(v, 1)); v = fmaxf(v, __shfl_xor(v, 2)); v = fmaxf(v, __shfl_xor(v, 4)); v = fmaxf(v, __shfl_xor(v, 8)); return v; }
#define LDS_WAIT() asm volatile("s_waitcnt lgkmcnt(0)" ::: "memory")
#define VM_WAIT() asm volatile("s_waitcnt vmcnt(0)" ::: "memory")

#define XB_TMO      128
#define XB_XCNT(j)  (256  + 64 * (j))
#define XB_XSUB(j)  (1280 + 64 * (j))
#define XB_XGEN(j)  (2304 + 64 * (j))
#define XB_TOP      3328
#define XB_TOPGEN   3392
#define XCD_BAR_WORDS 3456
#define XB_SPIN_CAP (1u << 18)
DI unsigned xb_ld(unsigned* p)              { return __hip_atomic_load(p, __ATOMIC_RELAXED, __HIP_MEMORY_SCOPE_AGENT); }
DI unsigned xb_add(unsigned* p, unsigned v) { return __hip_atomic_fetch_add(p, v, __ATOMIC_RELAXED, __HIP_MEMORY_SCOPE_AGENT); }
DI unsigned xb_xcc_id() { return (unsigned)__builtin_amdgcn_s_getreg((3 << 11) | 20) & 0xFu; }
#define XB_SPIN(cond, bar) do { unsigned _sp = 0; while (cond) { __builtin_amdgcn_s_sleep(1); \
    if ((++_sp & 255u) == 0u) { if (xb_ld(&(bar)[XB_TMO])) break; if (_sp > XB_SPIN_CAP) { atomicAdd(&(bar)[XB_TMO], 1u); break; } } } } while (0)
struct XcdBarrier { unsigned* bar; unsigned x; volatile LAS unsigned* st; };
DI XcdBarrier xcd_barrier_post(unsigned* bar, volatile LAS unsigned* st) {
    XcdBarrier b; b.bar = bar; b.x = xb_xcc_id(); b.st = st;
    if (threadIdx.x == 0) (void)xb_add(&bar[XB_XCNT(b.x)], 1u);
    return b;
}
DI void xcd_barrier_complete(unsigned* bar, unsigned x, unsigned& nloc, unsigned& nx) {
    const unsigned G = gridDim.x * gridDim.y * gridDim.z;
    unsigned sum, cnt, mine, sp = 0u;
    for (;;) {
        sum = 0u; cnt = 0u; mine = 0u;
#pragma unroll
        for (unsigned j = 0; j < 16; ++j) { const unsigned c = xb_ld(&bar[XB_XCNT(j)]); sum += c; cnt += (c > 0u) ? 1u : 0u; mine = (j == x) ? c : mine; }
        if (sum == G) break;
        __builtin_amdgcn_s_sleep(1);
        if ((++sp & 255u) == 0u) { if (xb_ld(&bar[XB_TMO])) break; if (sp > XB_SPIN_CAP) { atomicAdd(&bar[XB_TMO], 1u); break; } }
    }
    nloc = mine > 0u ? mine : 1u; nx = cnt > 0u ? cnt : 1u;
}
DI void xcd_barrier(const XcdBarrier& b) {
    asm volatile("s_waitcnt vmcnt(0)" ::: "memory");
    __syncthreads();
    if (threadIdx.x == 0) {
        unsigned* bar = b.bar;
        __builtin_amdgcn_s_waitcnt(0);
        unsigned nloc = b.st[0], nx = b.st[1];
        if (nloc == 0u) { xcd_barrier_complete(bar, b.x, nloc, nx); b.st[0] = nloc; b.st[1] = nx; }
        const unsigned old = xb_add(&bar[XB_XSUB(b.x)], 1u);
        const unsigned gen = old / nloc;
        if (old + 1u == (gen + 1u) * nloc) {
            __builtin_amdgcn_fence(__ATOMIC_RELEASE, "agent");
            asm volatile("s_waitcnt vmcnt(0)" ::: "memory");
            const unsigned og = xb_add(&bar[XB_TOP], 1u);
            const unsigned tg = og / nx;
            if (og + 1u == (tg + 1u) * nx) xb_add(&bar[XB_TOPGEN], 1u);
            else XB_SPIN(xb_ld(&bar[XB_TOPGEN]) == tg, bar);
            __builtin_amdgcn_fence(__ATOMIC_ACQUIRE, "agent");
            xb_add(&bar[XB_XGEN(b.x)], 1u);
            asm volatile("s_waitcnt vmcnt(0)" ::: "memory");
        } else {
            XB_SPIN(xb_ld(&bar[XB_XGEN(b.x)]) == gen, bar);
            __builtin_amdgcn_fence(__ATOMIC_ACQUIRE, "agent");
            asm volatile("s_waitcnt vmcnt(0)" ::: "memory");
        }
    }
    __syncthreads();
}

namespace pg8 {
constexpr int BM = 256, BK = 64, HALF = 128, HTB = HALF * BK * 2, STAGE_BYTES = 8 * HTB, NXCD = 8, WGM = 8;
__host__ __device__ __forceinline__ int lds_byte(int r, int c) { const int st = (r >> 4) * 2 + (c >> 5), rr = r & 15, cc = c & 31, ob = rr * 64 + cc * 2; return st * 1024 + (ob ^ (((ob >> 9) & 1) << 5)); }
__host__ __device__ __forceinline__ void stage_rc(int b, int& R, int& C) { const int st = b / 1024, sb = b % 1024, swz = sb ^ (((sb >> 9) & 1) << 5); R = (st >> 1) * 16 + swz / 64; C = (st & 1) * 32 + (swz % 64) / 2; }
__host__ __device__ __forceinline__ int perm32(int rho) { const int n = rho >> 4, i = rho & 15; return 8 * (i >> 2) + 4 * n + (i & 3); }

struct Unit { int pm, pn; const char* a; const char* b; };
struct Gemm { const bf16_t* A; const bf16_t* Bt; int lda, ldb, kstepA, kstepB, K; };

struct StaticOrder {
    int nM, nN, nwg, G, c; const char* A; const char* B; size_t tA, tB;
    DI void init(const Gemm& g, int M, int N, int G_, int c_) { nM = M / BM; nN = N / BM; nwg = nM * nN; G = G_; c = c_; A = (const char*)g.A; B = (const char*)g.Bt; tA = (size_t)BM * g.lda * 2; tB = (size_t)BM * g.ldb * 2; }
    DI bool next(int i, Unit& u) const {
        const int L = i * G + c; if (L >= nwg) return false;
        int wgid = L; { const int q = nwg / NXCD, r = nwg % NXCD, xcd = wgid % NXCD, off = wgid / NXCD; wgid = (xcd < r ? xcd * (q + 1) : r * (q + 1) + (xcd - r) * q) + off; }
        const int nig = WGM * nN, gid = wgid / nig, fm = gid * WGM, gsz = (nM - fm) < WGM ? (nM - fm) : WGM;
        u.pm = fm + ((wgid % nig) % gsz); u.pn = (wgid % nig) / gsz; u.a = A + (size_t)u.pm * tA; u.b = B + (size_t)u.pn * tB; return true;
    }
};

DI unsigned cvt_pk_bf16(float lo, float hi) { return pk2(lo, hi); }

template <int ACT> struct EpiBf16 {
    static constexpr bool PERM = true;
    bf16_t* O; int ldc; const float* bias; int cmp_mode;
    DI void operator()(const f32x4 (&acc)[2][2][4][2], const Unit& u, int wr, int wc, int fr, int fq) const {
        const int rt = cmp_mode ? (u.pn * 8 + u.pm) : u.pm, ct = cmp_mode ? 0 : u.pn;
        const int row0 = rt * BM + wr * 64 + fr; const int col0 = ct * BM + wc * 32 + 8 * fq;
        f32x4 bv[2][2];
#pragma unroll
        for (int bj = 0; bj < 2; ++bj)
#pragma unroll
            for (int n = 0; n < 2; ++n) bv[bj][n] = bias ? *(const f32x4*)(bias + u.pn * BM + (wc * 32 + 8 * fq) + bj * HALF + 4 * n) : (f32x4){0.f, 0.f, 0.f, 0.f};
#pragma unroll
        for (int ai = 0; ai < 2; ++ai)
#pragma unroll
            for (int m = 0; m < 4; ++m) { bf16_t* rowp = O + (size_t)(row0 + ai * HALF + m * 16) * ldc + col0;
#pragma unroll
                for (int bj = 0; bj < 2; ++bj) { f32x4 v0 = acc[ai][bj][m][0] + bv[bj][0], v1 = acc[ai][bj][m][1] + bv[bj][1];
                    if (ACT == 2) { v0 = (f32x4){silu_f(v0[0]), silu_f(v0[1]), silu_f(v0[2]), silu_f(v0[3])}; v1 = (f32x4){silu_f(v1[0]), silu_f(v1[1]), silu_f(v1[2]), silu_f(v1[3])}; }
                    u32x4 w; w.x = cvt_pk_bf16(v0[0], v0[1]); w.y = cvt_pk_bf16(v0[2], v0[3]); w.z = cvt_pk_bf16(v1[0], v1[1]); w.w = cvt_pk_bf16(v1[2], v1[3]);
                    *(u32x4*)(rowp + bj * HALF) = w; } }
    }
};
struct EpiSwiGLU {
    static constexpr bool PERM = true;
    bf16_t* O; int ldc;
    DI void operator()(const f32x4 (&acc)[2][2][4][2], const Unit& u, int wr, int wc, int fr, int fq) const {
        const int row0 = u.pm * BM + wr * 64 + fr; const int col0 = u.pn * HALF + wc * 32 + 8 * fq;
#pragma unroll
        for (int ai = 0; ai < 2; ++ai)
#pragma unroll
            for (int m = 0; m < 4; ++m) { bf16_t* rowp = O + (size_t)(row0 + ai * HALF + m * 16) * ldc + col0;
                const f32x4 g0 = acc[ai][0][m][0], g1 = acc[ai][0][m][1], u0 = acc[ai][1][m][0], u1 = acc[ai][1][m][1];
                u32x4 w; w.x = cvt_pk_bf16(silu_f(g0[0]) * u0[0], silu_f(g0[1]) * u0[1]); w.y = cvt_pk_bf16(silu_f(g0[2]) * u0[2], silu_f(g0[3]) * u0[3]);
                w.z = cvt_pk_bf16(silu_f(g1[0]) * u1[0], silu_f(g1[1]) * u1[1]); w.w = cvt_pk_bf16(silu_f(g1[2]) * u1[2], silu_f(g1[3]) * u1[3]);
                *(u32x4*)rowp = w; }
    }
};
struct EpiResid {
    static constexpr bool PERM = false;
    const float* base; float* out; float scale;
    DI void operator()(const f32x4 (&acc)[2][2][4][2], const Unit& u, int wr, int wc, int fr, int fq) const {
        const int col0 = u.pn * BM + wc * 32 + 4 * fq;
#pragma unroll
        for (int ai = 0; ai < 2; ++ai)
#pragma unroll
            for (int m = 0; m < 4; ++m) { const size_t off = (size_t)(u.pm * BM + ai * HALF + wr * 64 + m * 16 + fr) * DM + col0;
#pragma unroll
                for (int bj = 0; bj < 2; ++bj)
#pragma unroll
                    for (int n = 0; n < 2; ++n) { const f32x4 bs = *(const f32x4*)(base + off + bj * HALF + n * 16); *(f32x4*)(out + off + bj * HALF + n * 16) = bs + acc[ai][bj][m][n] * scale; } }
    }
};

template <class Epi, class Sched>
DI void gemm_phase(LAS unsigned char* lds, const Gemm g, const Sched& S, const Epi& E, const int tid) {
    const int wid = __builtin_amdgcn_readfirstlane(tid >> 6), lane = tid & 63, wr = wid >> 2, wc = wid & 3, fr = lane & 15, fq = lane >> 4;
    const int K = g.K, nt = K / BK;
    unsigned voffA[2], voffB[2];
#pragma unroll
    for (int i = 0; i < 2; ++i) { int R, C; stage_rc(tid * 16 + i * 8192, R, C); const int Rb = Epi::PERM ? ((R & ~31) + perm32(R & 31)) : R;
        voffA[i] = (unsigned)(R * g.lda + C) * 2u; voffB[i] = (unsigned)(Rb * g.ldb + C) * 2u; }
    const size_t kA = (size_t)g.kstepA, kB = (size_t)g.kstepB;
    const size_t hA = (size_t)HALF * g.lda * 2, hB = (size_t)HALF * g.ldb * 2;
    const unsigned ldsw = (unsigned)wid * 1024u;
    const int aoff = lds_byte(wr * 64 + fr, fq * 8), boff = lds_byte(wc * 32 + fr, fq * 8);
#define PG8_SA(b, h) (((b) * 2 + (h)) * HTB)
#define PG8_SB(b, h) ((4 + (b) * 2 + (h)) * HTB)
#define PG8_STAGE(bufoff, gbase, voff) do { _Pragma("unroll") for (int _i = 0; _i < 2; ++_i) \
        __builtin_amdgcn_global_load_lds((const unsigned*)((const char*)(gbase) + (voff)[_i]), (LAS unsigned*)(lds + (bufoff) + ldsw + _i * 8192), 16, 0, 0); } while (0)
#define PG8_LDA(dst, b, h) do { _Pragma("unroll") for (int m = 0; m < 4; ++m) _Pragma("unroll") for (int k = 0; k < 2; ++k) dst[m][k] = *(const LAS bf16x8*)(lds + PG8_SA(b, h) + aoff + m * 2048 + k * 1024); } while (0)
#define PG8_LDB(dst, b, h) do { _Pragma("unroll") for (int n = 0; n < 2; ++n) _Pragma("unroll") for (int k = 0; k < 2; ++k) dst[n][k] = *(const LAS bf16x8*)(lds + PG8_SB(b, h) + boff + n * 2048 + k * 1024); } while (0)
#define PG8_MMA(ai, bj, At, Bt) do { __builtin_amdgcn_s_setprio(1); _Pragma("unroll") for (int m = 0; m < 4; ++m) _Pragma("unroll") for (int n = 0; n < 2; ++n) _Pragma("unroll") for (int k = 0; k < 2; ++k) \
        acc[ai][bj][m][n] = __builtin_amdgcn_mfma_f32_16x16x32_bf16(Bt[n][k], At[m][k], acc[ai][bj][m][n], 0, 0, 0); __builtin_amdgcn_s_setprio(0); } while (0)
#define PG8_WAIT_V(n) asm volatile("s_waitcnt vmcnt(" #n ")" ::: "memory")
#define PG8_WAIT_L(n) asm volatile("s_waitcnt lgkmcnt(" #n ")" ::: "memory")
#define PG8_BAR __builtin_amdgcn_s_barrier()
#define PG8_SCHED __builtin_amdgcn_sched_barrier(0)
    Unit cur, nxt; int ui = 0;
    if (!S.next(0, cur)) return;
    f32x4 acc[2][2][4][2];
#pragma unroll
    for (int a = 0; a < 2; ++a)
#pragma unroll
        for (int b = 0; b < 2; ++b)
#pragma unroll
            for (int m = 0; m < 4; ++m)
#pragma unroll
                for (int n = 0; n < 2; ++n) acc[a][b][m][n] = (f32x4){0.f, 0.f, 0.f, 0.f};
    bf16x8 At[4][2], B0[2][2], B1[2][2];
    const char* cA = cur.a; const char* cB = cur.b;
    PG8_STAGE(PG8_SB(0, 0), cB, voffB); PG8_STAGE(PG8_SB(0, 1), cB + hB, voffB); PG8_STAGE(PG8_SA(0, 0), cA, voffA); PG8_STAGE(PG8_SA(0, 1), cA + hA, voffA);
    if (wr == 1) PG8_BAR;
    PG8_WAIT_V(2); PG8_BAR;
    PG8_STAGE(PG8_SB(1, 0), cB + kB, voffB); PG8_STAGE(PG8_SA(1, 0), cA + kA, voffA); PG8_STAGE(PG8_SB(1, 1), cB + hB + kB, voffB);
    PG8_WAIT_V(6); PG8_BAR;
    for (;;) {
        const bool has_next = S.next(ui + 1, nxt);
        const char* nA = has_next ? nxt.a : cA; const char* nB = has_next ? nxt.b : cB;
        for (int t = 0; t < nt; t += 2) {
            const bool last = (t == nt - 2);
            const char* a1 = cA + (size_t)(t + 1) * kA;
            const char* a2 = last ? nA : cA + (size_t)(t + 2) * kA; const char* b2 = last ? nB : cB + (size_t)(t + 2) * kB;
            const char* a3 = a2 + kA; const char* b3 = b2 + kB;
            PG8_LDB(B0, 0, 0); PG8_LDB(B1, 0, 1); PG8_SCHED; PG8_LDA(At, 0, 0); PG8_STAGE(PG8_SA(1, 1), a1 + hA, voffA);
            PG8_WAIT_V(8); PG8_WAIT_L(0); PG8_BAR; PG8_MMA(0, 0, At, B0); PG8_MMA(0, 1, At, B1); PG8_BAR; PG8_SCHED;
            PG8_LDA(At, 0, 1); PG8_STAGE(PG8_SB(0, 0), b2, voffB); PG8_STAGE(PG8_SB(0, 1), b2 + hB, voffB); PG8_STAGE(PG8_SA(0, 0), a2, voffA);
            PG8_WAIT_V(8); PG8_WAIT_L(0); PG8_BAR; PG8_MMA(1, 0, At, B0); PG8_MMA(1, 1, At, B1); PG8_BAR; PG8_SCHED;
            PG8_LDB(B0, 1, 0); PG8_LDB(B1, 1, 1); PG8_SCHED; PG8_LDA(At, 1, 0); PG8_STAGE(PG8_SA(0, 1), a2 + hA, voffA);
            PG8_WAIT_V(8); PG8_WAIT_L(0); PG8_BAR; PG8_MMA(0, 0, At, B0); PG8_MMA(0, 1, At, B1); PG8_BAR; PG8_SCHED;
            PG8_LDA(At, 1, 1); PG8_STAGE(PG8_SB(1, 0), b3, voffB); PG8_STAGE(PG8_SB(1, 1), b3 + hB, voffB); PG8_STAGE(PG8_SA(1, 0), a3, voffA);
            PG8_WAIT_V(8); PG8_WAIT_L(0); PG8_BAR; PG8_MMA(1, 0, At, B0); PG8_MMA(1, 1, At, B1); PG8_BAR; PG8_SCHED;
        }
        if (wr == 0) PG8_BAR;
        E(acc, cur, wr, wc, fr, fq);
        if (!has_next) break;
#pragma unroll
        for (int a = 0; a < 2; ++a)
#pragma unroll
            for (int b = 0; b < 2; ++b)
#pragma unroll
                for (int m = 0; m < 4; ++m)
#pragma unroll
                    for (int n = 0; n < 2; ++n) acc[a][b][m][n] = (f32x4){0.f, 0.f, 0.f, 0.f};
        cur = nxt; cA = nA; cB = nB; ++ui;
        if (wr == 1) PG8_BAR;
    }
    PG8_WAIT_V(0);
    PG8_BAR;
#undef PG8_SA
#undef PG8_SB
#undef PG8_STAGE
#undef PG8_LDA
#undef PG8_LDB
#undef PG8_MMA
#undef PG8_WAIT_V
#undef PG8_WAIT_L
#undef PG8_BAR
#undef PG8_SCHED
}
}

struct Args { const float* in[25]; float* out; unsigned char* ws; int ph_lo, ph_hi; };
struct KArgs { const float* in[25]; float* out; unsigned char* ws; int ph_lo, ph_hi, li, pad; };
typedef const KArgs __attribute__((address_space(4)))* KP;
enum { I_X = 0, I_MEM, I_NORMW, I_FNORMW, I_MNORMW, I_WG, I_WU, I_WD, I_XWQ, I_XWKV, I_XWO, I_EWIN, I_EWOUT, I_CONVW, I_CONVB, I_DTB, I_ALOG, I_SSMD, I_SSMNW, I_OWIN, I_OWOUT, I_CPE, I_CW1, I_CW2, I_SINKS };


__device__ const float INVF[64] = {1.000000000e+00f, 8.639885187e-01f, 7.464760542e-01f, 6.449466944e-01f, 5.572264791e-01f, 4.814372659e-01f, 4.159561992e-01f, 3.593813777e-01f, 3.105013072e-01f, 2.682695687e-01f, 2.317818254e-01f, 2.002568096e-01f, 1.730195731e-01f, 1.494869143e-01f, 1.291549653e-01f, 1.115884036e-01f, 9.641107917e-02f, 8.329805732e-02f, 7.196855545e-02f, 6.218000501e-02f, 5.372281000e-02f, 4.641588405e-02f, 4.010278732e-02f, 3.464834765e-02f, 2.993576974e-02f, 2.586415969e-02f, 2.234633639e-02f, 1.930697635e-02f, 1.668100618e-02f, 1.441219542e-02f, 1.245197095e-02f, 1.075835899e-02f, 9.295095690e-03f, 8.030855097e-03f, 6.938566454e-03f, 5.994840525e-03f, 5.179473199e-03f, 4.475005437e-03f, 3.866353072e-03f, 3.340484342e-03f, 2.886139555e-03f, 2.493591513e-03f, 2.154434333e-03f, 1.861406374e-03f, 1.608233666e-03f, 1.389495214e-03f, 1.200507861e-03f, 1.037224894e-03f, 8.961504791e-04f, 7.742635789e-04f, 6.689548027e-04f, 5.779692437e-04f, 4.993587499e-04f, 4.314401885e-04f, 3.727593285e-04f, 3.220597573e-04f, 2.782559313e-04f, 2.404098923e-04f, 2.077113895e-04f, 1.794602285e-04f, 1.550515735e-04f, 1.339627634e-04f, 1.157422957e-04f, 9.999999747e-05f};
DI void sincos_acc(float x, float& s, float& c) {
    const float kf = __builtin_rintf(x * 0.636619772367581343f); const int k = (int)kf;
    float r = __builtin_fmaf(-kf, 1.57079637050628662109375f, x); r = __builtin_fmaf(-kf, -4.37113900018624283e-8f, r);
    const float r2 = r * r;
    const float sp = r + r * r2 * (-1.0f / 6.0f + r2 * (1.0f / 120.0f + r2 * (-1.0f / 5040.0f + r2 * (1.0f / 362880.0f))));
    const float cp = 1.0f + r2 * (-0.5f + r2 * (1.0f / 24.0f + r2 * (-1.0f / 720.0f + r2 * (1.0f / 40320.0f + r2 * (-1.0f / 3628800.0f)))));
    const int q = k & 3;
    s = (q == 0) ? sp : (q == 1) ? cp : (q == 2) ? -sp : -cp;
    c = (q == 0) ? cp : (q == 1) ? -sp : (q == 2) ? -cp : sp;
}

#define JNO (1 << 20)
constexpr int NJ_EVEN = 11, NJ_ODD = 25;
__device__ const int JT_EVEN[NJ_EVEN][12] = {
    {I_WG, 2 * DM * FF, 0, 0, FF, DM, 0, FF, (int)W_GU, 128, 256, 0}, {I_WU, 2 * DM * FF, 0, 0, FF, DM, 0, FF, (int)W_GU, 128, 256, 128}, {I_WD, 2 * DM * FF, 0, 0, DM, FF, 0, DM, (int)W_D, JNO, 0, 0},
    {I_WG, 2 * DM * FF, 0, DM * FF, FF, DM, 0, FF, (int)(W_GU + 4 * FF * DM), 128, 256, 0}, {I_WU, 2 * DM * FF, 0, DM * FF, FF, DM, 0, FF, (int)(W_GU + 4 * FF * DM), 128, 256, 128}, {I_WD, 2 * DM * FF, 0, DM * FF, DM, FF, 0, DM, (int)(W_D + 2 * DM * FF), JNO, 0, 0},
    {I_XWQ, DM * DM, 0, 0, DM, DM, 0, DM, (int)W_XQ, JNO, 0, 0}, {I_XWKV, 2 * DM * DM, 0, 0, 2 * DM, DM, 0, 2 * DM, (int)W_XKV, JNO, 0, 0}, {I_XWO, DM * DM, 0, 0, DM, DM, 0, DM, (int)W_XO, JNO, 0, 0},
    {I_EWIN, 0, DM * EV_IN, 0, EV_IN, DM, 0, EV_IN, (int)W_IN, JNO, 0, 0}, {I_EWOUT, 0, DM * DM, 0, DM, DM, 0, DM, (int)W_OUT, JNO, 0, 0} };
__device__ const int JT_ODD[NJ_ODD][12] = {
    {I_WG, 2 * DM * FF, 0, 0, FF, DM, 0, FF, (int)W_GU, 128, 256, 0}, {I_WU, 2 * DM * FF, 0, 0, FF, DM, 0, FF, (int)W_GU, 128, 256, 128}, {I_WD, 2 * DM * FF, 0, 0, DM, FF, 0, DM, (int)W_D, JNO, 0, 0},
    {I_WG, 2 * DM * FF, 0, DM * FF, FF, DM, 0, FF, (int)(W_GU + 4 * FF * DM), 128, 256, 0}, {I_WU, 2 * DM * FF, 0, DM * FF, FF, DM, 0, FF, (int)(W_GU + 4 * FF * DM), 128, 256, 128}, {I_WD, 2 * DM * FF, 0, DM * FF, DM, FF, 0, DM, (int)(W_D + 2 * DM * FF), JNO, 0, 0},
    {I_XWQ, DM * DM, 0, 0, DM, DM, 0, DM, (int)W_XQ, JNO, 0, 0}, {I_XWKV, 2 * DM * DM, 0, 0, 2 * DM, DM, 0, 2 * DM, (int)W_XKV, JNO, 0, 0}, {I_XWO, DM * DM, 0, 0, DM, DM, 0, DM, (int)W_XO, JNO, 0, 0},
    {I_OWIN, 0, DM * OD_IN, 0, OD_IN, DM, 0, 512, (int)W_IN, JNO, 0, 0}, {I_OWIN, 0, DM * OD_IN, 0, OD_IN, DM, 512, 128, (int)W_IN, JNO, 0, 512}, {I_OWIN, 0, DM * OD_IN, 0, OD_IN, DM, 640, 128, (int)W_IN, JNO, 0, 640},
    {I_OWIN, 0, DM * OD_IN, 0, OD_IN, DM, 768, 128, (int)W_IN, JNO, 0, 768}, {I_OWIN, 0, DM * OD_IN, 0, OD_IN, DM, 1024, 128, (int)W_IN, JNO, 0, 896}, {I_OWIN, 0, DM * OD_IN, 0, OD_IN, DM, 1816, 128, (int)W_IN, JNO, 0, 1024},
    {I_OWIN, 0, DM * OD_IN, 0, OD_IN, DM, 1304, 512, (int)W_IN, JNO, 0, 1152}, {I_OWIN, 0, DM * OD_IN, 0, OD_IN, DM, 1280, 24, (int)W_IN, JNO, 0, 1664},
    {I_OWIN, 0, DM * OD_IN, 0, OD_IN, DM, 896, 128, (int)(W_IN + 2 * OD_PITCH * DM), JNO, 0, 0}, {I_OWIN, 0, DM * OD_IN, 0, OD_IN, DM, 1152, 128, (int)(W_IN + 2 * OD_PITCH * DM), JNO, 0, 128}, {I_OWIN, 0, DM * OD_IN, 0, OD_IN, DM, 1944, 128, (int)(W_IN + 2 * OD_PITCH * DM), JNO, 0, 256},
    {I_OWOUT, 0, DM * DM, 0, DM, DM, 0, DM, (int)W_OUT, JNO, 0, 0},
    {I_CW1, 0, 2 * 2048 * 256, 0, 256, 2048, 0, 256, (int)W_C1, JNO, 0, 0}, {I_CW1, 0, 2 * 2048 * 256, 2048 * 256, 256, 2048, 0, 256, (int)(W_C1 + 2 * 256 * 2048), JNO, 0, 0},
    {I_CW2, 0, 2 * 256 * 64, 0, 64, 256, 0, 64, (int)W_C2, JNO, 0, 0}, {I_CW2, 0, 2 * 256 * 64, 256 * 64, 64, 256, 0, 64, (int)(W_C2 + 2 * 64 * 256), JNO, 0, 0} };

DI void transpose_item(const float* src, bf16_t* dst, int ldw, int K, int c0, int ncols, int G, int GS, int off, int nblk, int item, LAS float* scr, int lane) {
    const int kb = item / nblk, nb = item % nblk, k0 = 64 * kb, n0 = 32 * nb;
    const int cl = n0 + (lane & 31); const bool okc = cl < ncols;
    float tv[32];
#pragma unroll
    for (int i = 0; i < 32; ++i) { const int kk = 2 * i + (lane >> 5); tv[i] = okc ? src[(size_t)(k0 + kk) * ldw + c0 + cl] : 0.f; }
#pragma unroll
    for (int i = 0; i < 32; ++i) { const int kk = 2 * i + (lane >> 5); scr[kk * 33 + (lane & 31)] = tv[i]; }
    LDS_WAIT(); asm volatile("" ::: "memory");
    const int c = lane & 7;
#pragma unroll
    for (int j = 0; j < 4; ++j) { const int n = (lane >> 3) + 8 * j; const LAS float* s = scr + (8 * c) * 33 + n;
        u32x4 o; o.x = pk2(s[0 * 33], s[1 * 33]); o.y = pk2(s[2 * 33], s[3 * 33]); o.z = pk2(s[4 * 33], s[5 * 33]); o.w = pk2(s[6 * 33], s[7 * 33]);
        const int cc = n0 + n; const int drow = (cc / G) * GS + off + (cc % G);
        *(u32x4*)(dst + (size_t)drow * K + k0 + 8 * c) = o; }
    LDS_WAIT(); asm volatile("" ::: "memory");
}
constexpr int TAIL_ITEMS = 4232, TAIL_SLOTS = 3;
DI void convert_items(KP kp, const Args& a, int layer, int it_lo, int it_hi, int wi, int nworkers, LAS unsigned char* lds, int tid, int wave, int lane) {
    LAS int* item0 = (LAS int*)(lds + 8 * 8448);
    unsigned char* ws = a.ws; unsigned char* W = ws + ((layer & 1) ? WS_W2 : WS_W); const int li = layer >> 1; const bool odd = (layer & 1) != 0;
    const int nj = odd ? NJ_ODD : NJ_EVEN; const int (*JT)[12] = odd ? JT_ODD : JT_EVEN;
    __syncthreads();
    if (tid == 0) { int items = 0; for (int j = 0; j < nj; ++j) { item0[j] = items; items += ((JT[j][7] + 31) / 32) * (JT[j][5] / 64); } item0[nj] = items; }
    __syncthreads();
    const int nitems = item0[nj] < it_hi ? item0[nj] : it_hi;
    LAS float* scr = (LAS float*)(lds + wave * 8448);
    for (int it = it_lo + wi; it < nitems; it += nworkers) {
        int j = 0;
        while (j + 1 < nj && item0[j + 1] <= it) ++j;
        j = __builtin_amdgcn_readfirstlane(j);
        const int* J = JT[j];
        const float* src = kp->in[J[0]] + ((size_t)layer * J[1] + (size_t)li * J[2] + J[3]);
        transpose_item(src, (bf16_t*)(W + J[8]), J[4], J[5], J[6], J[7], J[9], J[10], J[11], (J[7] + 31) / 32, it - item0[j], scr, lane);
    }
    __syncthreads();
}
DI void cmp_bias1(const Args& a, int layer, int wi, int nworkers, int lane) {
    const int li = layer >> 1; float* bias1 = (float*)(a.ws + WS_BIAS1);
    for (int o = wi; o < 512; o += nworkers) { const int kv = o >> 8, col = o & 255;
        const float* pe = a.in[I_CPE] + (size_t)(li * 2 + kv) * 2048; const float* w1 = a.in[I_CW1] + (size_t)(li * 2 + kv) * 2048 * 256 + col;
        float s = 0.f;
        for (int k = lane; k < 2048; k += 64) s += pe[k] * w1[(size_t)k * 256];
        s = wave_sum(s); if (lane == 0) bias1[o] = s; }
}
DI void layer_prologue(KP kp, const Args& a, int layer, LAS unsigned char* lds, int tid, int wave, int lane, int gw, int NGW) {
    unsigned char* ws = a.ws; const int li = layer >> 1; const bool odd = (layer & 1) != 0;
    convert_items(kp, a, layer, (layer > 0 && NGW == 2048) ? TAIL_SLOTS * TAIL_ITEMS : 0, 1 << 30, gw, NGW, lds, tid, wave, lane);
    if (odd && !(layer > 0 && NGW == 2048)) cmp_bias1(a, layer, gw, NGW, lane);
    if (layer == 0) {
        float* ct = (float*)(ws + WS_COS); float* st = (float*)(ws + WS_SIN);
        const int gt = gw * 64 + lane, NT = NGW * 64;
        for (int e = gt; e < SEQ * 64; e += NT) { const int pos = e >> 6, i = e & 63;
            const float ang = (float)pos * INVF[i];
            float sv, cv; sincos_acc(ang, sv, cv); ct[e] = cv; st[e] = sv; }
        const float* mem = a.in[I_MEM]; const float* mw = a.in[I_MNORMW]; bf16_t* memn = (bf16_t*)(ws + WS_MEMN);
        for (int m = gw; m < NB * MEMLEN; m += NGW) {
            const f32x4* xr = (const f32x4*)(mem + (size_t)m * DM) + lane; f32x4 v[4]; float s = 0.f;
#pragma unroll
            for (int j = 0; j < 4; ++j) { v[j] = xr[64 * j]; s += (v[j].x * v[j].x + v[j].y * v[j].y) + (v[j].z * v[j].z + v[j].w * v[j].w); }
            const float r = 1.0f / sqrtf(wave_sum(s) * (1.f / DM) + EPS);
#pragma unroll
            for (int j = 0; j < 4; ++j) { const f32x4 w = ((const f32x4*)mw)[lane + 64 * j];
                u32x2 o; o.x = pk2(v[j].x * r * w.x, v[j].y * r * w.y); o.y = pk2(v[j].z * r * w.z, v[j].w * r * w.w);
                *(u32x2*)(memn + (size_t)m * DM + 4 * (lane + 64 * j)) = o; }
        }
    }
}

DI void prologue_tail(KP kp, const Args& a, int layer_next, int slot, int b0, int bid, int G, LAS unsigned char* lds, int tid, int wave, int lane) {
    if (G != 256 || layer_next >= DEPTH || bid < b0) return;
    convert_items(kp, a, layer_next, slot * TAIL_ITEMS, (slot + 1) * TAIL_ITEMS, (bid - b0) * 8 + wave, (256 - b0) * 8, lds, tid, wave, lane);
    if (slot == 2 && (layer_next & 1)) cmp_bias1(a, layer_next, (bid - b0) * 8 + wave, (256 - b0) * 8, lane);
}

DI void norm_phase(const float* x, const float* w, bf16_t* h, int gw, int NGW, int lane) {
    f32x4 wv[4];
#pragma unroll
    for (int j = 0; j < 4; ++j) wv[j] = ((const f32x4*)w)[lane + 64 * j];
    for (int m = gw; m < MTOK; m += NGW) {
        const f32x4* xr = (const f32x4*)(x + (size_t)m * DM) + lane; f32x4 v[4]; float s = 0.f;
#pragma unroll
        for (int j = 0; j < 4; ++j) { v[j] = xr[64 * j]; s += (v[j].x * v[j].x + v[j].y * v[j].y) + (v[j].z * v[j].z + v[j].w * v[j].w); }
        const float r = 1.0f / sqrtf(wave_sum(s) * (1.f / DM) + EPS);
#pragma unroll
        for (int j = 0; j < 4; ++j) { u32x2 o; o.x = pk2(v[j].x * r * wv[j].x, v[j].y * r * wv[j].y); o.y = pk2(v[j].z * r * wv[j].z, v[j].w * r * wv[j].w);
            *(u32x2*)(h + (size_t)m * DM + 4 * (lane + 64 * j)) = o; }
    }
}
DI void final_norm_phase(const float* x, const float* w, float* out, int gw, int NGW, int lane) {
    f32x4 wv[4];
#pragma unroll
    for (int j = 0; j < 4; ++j) wv[j] = ((const f32x4*)w)[lane + 64 * j];
    for (int m = gw; m < MTOK; m += NGW) {
        const f32x4* xr = (const f32x4*)(x + (size_t)m * DM) + lane; f32x4 v[4]; float s = 0.f;
#pragma unroll
        for (int j = 0; j < 4; ++j) { v[j] = xr[64 * j]; s += (v[j].x * v[j].x + v[j].y * v[j].y) + (v[j].z * v[j].z + v[j].w * v[j].w); }
        const float r = 1.0f / sqrtf(wave_sum(s) * (1.f / DM) + EPS);
#pragma unroll
        for (int j = 0; j < 4; ++j) ((f32x4*)(out + (size_t)m * DM))[lane + 64 * j] = v[j] * r * wv[j];
    }
}

constexpr int TP = 136;

DI void e0_unit(const Args& a, int li, int unit, LAS unsigned char* lds, int tid, int wave, int lane) {
    unsigned char* R = a.ws + WS_R;
    bf16_t* PROJ = (bf16_t*)(R + R_PROJ); bf16_t* CONV = (bf16_t*)(R + R_CONV); bf16_t* XDT = (bf16_t*)(R + R_XDT); float* CUMS = (float*)(R + R_CUMS);
    const float* COS = (const float*)(a.ws + WS_COS); const float* SIN = (const float*)(a.ws + WS_SIN);
    const int half = unit & 1, c = (unit >> 1) & 31, b = unit >> 6;
    const int crow0 = b * SEQ + c * 128;
    LAS float* dts = (LAS float*)lds;
    LAS float* das = dts + 1024;
    LAS float* cus = das + 1024;
    __syncthreads();
#pragma unroll
    for (int k = 0; k < 2; ++k) { const int idx = tid + 512 * k, l = idx >> 3, hd = idx & 7;
        const float raw = bf2f(PROJ[(size_t)(crow0 + l) * EV_PITCH + 3328 + hd]) + a.in[I_DTB][li * 8 + hd];
        const float dt = raw > 20.f ? raw : log1pf(expf(raw));
        const float av = -expf(a.in[I_ALOG][li * 8 + hd]);
        dts[l * 8 + hd] = dt; das[l * 8 + hd] = dt * av; }
    __syncthreads();
    {
        const float v0 = das[(2 * lane) * 8 + wave], v1 = das[(2 * lane + 1) * 8 + wave]; float s = v0 + v1;
#pragma unroll
        for (int o = 1; o < 64; o <<= 1) { const float t = __shfl_up(s, o); if (lane >= o) s += t; }
        cus[(2 * lane) * 8 + wave] = s - v1; cus[(2 * lane + 1) * 8 + wave] = s; }
    __syncthreads();
    for (int idx = tid; idx < 64 * 16; idx += 512) { const int rl = idx >> 4, k = idx & 15, l = half * 64 + rl; float v = 0.f;
        if (k < 8) v = cus[l * 8 + k]; else if (k < 12) v = (float)(l + 1) * log1pf(-exp2f(-5.0f - (float)(k - 8)));
        CUMS[(size_t)(crow0 + l) * 16 + k] = v; }
    const int r0 = crow0 + half * 64, pos0 = c * 128 + half * 64;
    for (int it = tid; it < 64 * 128; it += 512) { const int rl = it >> 7, ch = it & 127, col = ch * 8, i0 = (col & 127) >> 1;
        const f32x4 cs = *(const f32x4*)(COS + (size_t)(pos0 + rl) * 64 + i0), sn = *(const f32x4*)(SIN + (size_t)(pos0 + rl) * 64 + i0);
        u32x4* p = (u32x4*)(PROJ + (size_t)(r0 + rl) * EV_PITCH + col); const u32x4 v = *p; const float sc = col >= 512 ? 0.08838834764831845f : 1.0f; u32x4 o;
#pragma unroll
        for (int e = 0; e < 4; ++e) { const float t1 = bflo(v[e]), t2 = bfhi(v[e]); o[e] = pk2((t1 * cs[e] - t2 * sn[e]) * sc, (t1 * sn[e] + t2 * cs[e]) * sc); }
        *p = o; }
    const float* cw = a.in[I_CONVW] + (size_t)li * 4 * 768; const float* cb = a.in[I_CONVB] + (size_t)li * 768;
    for (int it = tid; it < 64 * 96; it += 512) { const int rl = it / 96, ch = (it % 96) * 8; const int pos = pos0 + rl;
        float acc[8];
        { const f32x4 b0 = *(const f32x4*)(cb + ch), b1 = *(const f32x4*)(cb + ch + 4); acc[0] = b0.x; acc[1] = b0.y; acc[2] = b0.z; acc[3] = b0.w; acc[4] = b1.x; acc[5] = b1.y; acc[6] = b1.z; acc[7] = b1.w; }
#pragma unroll
        for (int i = 0; i < 4; ++i) { const int ps = pos - 3 + i; if (ps >= 0) {
            const u32x4 v = *(const u32x4*)(PROJ + (size_t)(b * SEQ + ps) * EV_PITCH + 2560 + ch);
            const f32x4 w0 = *(const f32x4*)(cw + i * 768 + ch), w1 = *(const f32x4*)(cw + i * 768 + ch + 4);
            acc[0] += w0.x * bflo(v.x); acc[1] += w0.y * bfhi(v.x); acc[2] += w0.z * bflo(v.y); acc[3] += w0.w * bfhi(v.y);
            acc[4] += w1.x * bflo(v.z); acc[5] += w1.y * bfhi(v.z); acc[6] += w1.z * bflo(v.w); acc[7] += w1.w * bfhi(v.w); } }
#pragma unroll
        for (int e = 0; e < 8; ++e) acc[e] = silu_f(acc[e]);
        u32x4 o; o.x = pk2(acc[0], acc[1]); o.y = pk2(acc[2], acc[3]); o.z = pk2(acc[4], acc[5]); o.w = pk2(acc[6], acc[7]);
        *(u32x4*)(CONV + (size_t)(r0 + rl) * 768 + ch) = o;
        if (ch < 512) { const float dt = dts[(half * 64 + rl) * 8 + (ch >> 6)];
            u32x4 x; x.x = pk2(acc[0] * dt, acc[1] * dt); x.y = pk2(acc[2] * dt, acc[3] * dt); x.z = pk2(acc[4] * dt, acc[5] * dt); x.w = pk2(acc[6] * dt, acc[7] * dt);
            *(u32x4*)(XDT + (size_t)(r0 + rl) * 512 + ch) = x; } }
}

template <int NCOL, bool WEIGHT>
DI void stage_T(const bf16_t* src, int ld, LAS bf16_t* dstT, const float* cum, int tid) {
    constexpr int CPR = NCOL / 8;
    float cl = 0.f; if (WEIGHT) cl = cum[127 * 16];
    for (int it = tid; it < 128 * CPR; it += 512) { const int j = it / CPR, ch = it % CPR;
        const u32x4 v = *(const u32x4*)(src + (size_t)j * ld + ch * 8);
        float w = 1.f; if (WEIGHT) w = ex2((cl - cum[j * 16]) * LOG2E);
#pragma unroll
        for (int e = 0; e < 4; ++e) { float lo = bflo(v[e]), hi = bfhi(v[e]); if (WEIGHT) { lo *= w; hi *= w; }
            dstT[(ch * 8 + 2 * e) * TP + j] = f2bf(lo); dstT[(ch * 8 + 2 * e + 1) * TP + j] = f2bf(hi); } }
}
template <int NCOL>
DI void stage_N(const bf16_t* src, int ld, LAS bf16_t* dst, int tid) {
    constexpr int CPR = NCOL / 8;
    for (int it = tid; it < 128 * CPR; it += 512) { const int j = it / CPR, ch = it % CPR;
        *(LAS u32x4*)(dst + j * (NCOL + 8) + ch * 8) = *(const u32x4*)(src + (size_t)j * ld + ch * 8); }
}

template <int DK, int DV>
DI void e1_unit(const bf16_t* Kp, int ldk, const bf16_t* Vp, int ldv, const float* cum, float* st, LAS unsigned char* lds, int tid, int wave, int lane) {
    LAS bf16_t* KT = (LAS bf16_t*)lds; LAS bf16_t* VT = KT + DK * TP;
    __syncthreads();
    stage_T<DK, false>(Kp, ldk, KT, cum, tid);
    stage_T<DV, true>(Vp, ldv, VT, cum, tid);
    __syncthreads();
    constexpr int NTILES = DK / 16, TPW = (DV / 16) * NTILES / 8;
    const int lr = lane & 15, lq = lane >> 4; const int mt = (wave * TPW) / NTILES, nt0 = (wave * TPW) % NTILES;
    f32x4 acc[TPW];
#pragma unroll
    for (int i = 0; i < TPW; ++i) acc[i] = (f32x4){0.f, 0.f, 0.f, 0.f};
#pragma unroll
    for (int ks = 0; ks < 4; ++ks) { const bf16x8 xf = *(const LAS bf16x8*)(VT + (mt * 16 + lr) * TP + ks * 32 + lq * 8);
#pragma unroll
        for (int i = 0; i < TPW; ++i) { const bf16x8 yf = *(const LAS bf16x8*)(KT + ((nt0 + i) * 16 + lr) * TP + ks * 32 + lq * 8); acc[i] = mfma16(xf, yf, acc[i]); } }
#pragma unroll
    for (int i = 0; i < TPW; ++i)
#pragma unroll
        for (int t = 0; t < 4; ++t) st[(size_t)(mt * 16 + 4 * lq + t) * DK + (nt0 + i) * 16 + lr] = acc[i][t];
}

template <int DK, int DV, bool RET>
DI void e3_unit(const bf16_t* Qp, int ldq, const bf16_t* Kp, int ldk, const bf16_t* Vp, int ldv, const float* cum, const bf16_t* Sin,
                const bf16_t* gz, int ldgz, const bf16_t* xs, float dskip, bf16_t* outp, int ldo, LAS unsigned char* lds, int tid, int wave, int lane) {
    constexpr int QP = DK + 8;
    LAS bf16_t* Qs = (LAS bf16_t*)lds; LAS bf16_t* Ks = Qs + 128 * QP; LAS bf16_t* VT = Ks + 128 * QP; LAS bf16_t* P = VT + DV * TP; LAS float* cumL = (LAS float*)(P + 128 * TP);
    __syncthreads();
    stage_N<DK>(Qp, ldq, Qs, tid); stage_N<DK>(Kp, ldk, Ks, tid); stage_T<DV, false>(Vp, ldv, VT, cum, tid);
    if (tid < 128) cumL[tid] = cum[tid * 16];
    __syncthreads();
    const int lr = lane & 15, lq = lane >> 4, i0 = wave * 16;
    bf16x8 qf[DK / 32];
#pragma unroll
    for (int ks = 0; ks < DK / 32; ++ks) qf[ks] = *(const LAS bf16x8*)(Qs + (i0 + lr) * QP + ks * 32 + lq * 8);
    float ci[4];
#pragma unroll
    for (int t = 0; t < 4; ++t) ci[t] = cumL[i0 + 4 * lq + t];
#pragma unroll
    for (int nt = 0; nt < 8; ++nt) {
        f32x4 s = (f32x4){0.f, 0.f, 0.f, 0.f};
        if (nt <= wave) {
#pragma unroll
            for (int ks = 0; ks < DK / 32; ++ks) { const bf16x8 kf = *(const LAS bf16x8*)(Ks + (nt * 16 + lr) * QP + ks * 32 + lq * 8); s = mfma16(qf[ks], kf, s); }
        }
        const int j = nt * 16 + lr; const float cj = cumL[j];
#pragma unroll
        for (int t = 0; t < 4; ++t) { const int i = i0 + 4 * lq + t; const float p = (i >= j) ? s[t] * ex2((ci[t] - cj) * LOG2E) : 0.f; P[i * TP + j] = f2bf(p); }
    }
    f32x4 o[DV / 16];
#pragma unroll
    for (int nt = 0; nt < DV / 16; ++nt) { o[nt] = (f32x4){0.f, 0.f, 0.f, 0.f};
#pragma unroll
        for (int ks = 0; ks < DK / 32; ++ks) { const bf16x8 sf = *(const bf16x8*)(Sin + (size_t)(nt * 16 + lr) * DK + ks * 32 + lq * 8); o[nt] = mfma16(qf[ks], sf, o[nt]); }
#pragma unroll
        for (int t = 0; t < 4; ++t) o[nt][t] *= ex2(ci[t] * LOG2E); }
    LDS_WAIT();
#pragma unroll
    for (int ks = 0; ks < 4; ++ks) { const bf16x8 pf = *(const LAS bf16x8*)(P + (i0 + lr) * TP + ks * 32 + lq * 8);
#pragma unroll
        for (int nt = 0; nt < DV / 16; ++nt) { const bf16x8 vf = *(const LAS bf16x8*)(VT + (nt * 16 + lr) * TP + ks * 32 + lq * 8); o[nt] = mfma16(pf, vf, o[nt]); } }
    if (RET) {
        float rs[4];
#pragma unroll
        for (int t = 0; t < 4; ++t) { float ss = 0.f;
#pragma unroll
            for (int nt = 0; nt < DV / 16; ++nt) ss += o[nt][t] * o[nt][t];
            ss = grp16_sum(ss); rs[t] = 1.0f / sqrtf(ss * (1.0f / DV) + EPS); }
#pragma unroll
        for (int nt = 0; nt < DV / 16; ++nt)
#pragma unroll
            for (int t = 0; t < 4; ++t) { const int i = i0 + 4 * lq + t; const float g = bf2f(gz[(size_t)i * ldgz + nt * 16 + lr]);
                outp[(size_t)i * ldo + nt * 16 + lr] = f2bf(o[nt][t] * rs[t] * silu_f(g)); }
    } else {
#pragma unroll
        for (int nt = 0; nt < DV / 16; ++nt)
#pragma unroll
            for (int t = 0; t < 4; ++t) { const int i = i0 + 4 * lq + t; const float z = bf2f(gz[(size_t)i * ldgz + nt * 16 + lr]); const float xv = bf2f(xs[(size_t)i * 768 + nt * 16 + lr]);
                outp[(size_t)i * ldo + nt * 16 + lr] = f2bf((o[nt][t] + dskip * xv) * silu_f(z)); }
    }
}

DI void e1_phase(const Args& a, LAS unsigned char* lds, int tid, int wave, int lane, int bid, int G) {
    unsigned char* R = a.ws + WS_R; const bf16_t* PROJ = (const bf16_t*)(R + R_PROJ); const bf16_t* CONV = (const bf16_t*)(R + R_CONV); const bf16_t* XDT = (const bf16_t*)(R + R_XDT); const float* CUMS = (const float*)(R + R_CUMS);
    for (int u = bid; u < 1536; u += G) {
        if (u < 512) { const int b = u >> 7, c = (u >> 2) & 31, h = u & 3; const size_t row0 = (size_t)b * SEQ + c * 128;
            e1_unit<128, 128>(PROJ + row0 * EV_PITCH + 512 + h * 128, EV_PITCH, PROJ + row0 * EV_PITCH + 1024 + h * 128, EV_PITCH, CUMS + row0 * 16 + 8 + h,
                              (float*)(R + R_STR) + ((size_t)(b * 4 + h) * 32 + c) * 16384, lds, tid, wave, lane);
        } else { const int v = u - 512, b = v >> 8, c = (v >> 3) & 31, hd = v & 7, g = hd >> 2; const size_t row0 = (size_t)b * SEQ + c * 128;
            e1_unit<64, 64>(CONV + row0 * 768 + 512 + g * 64, 768, XDT + row0 * 512 + hd * 64, 512, CUMS + row0 * 16 + hd,
                            (float*)(R + R_STS) + ((size_t)(b * 8 + hd) * 32 + c) * 4096, lds, tid, wave, lane);
        }
    }
}
DI void e2_phase(const Args& a, int tid, int bid, int G) {
    unsigned char* R = a.ws + WS_R; const float* CUMS = (const float*)(R + R_CUMS);
    const float* STR = (const float*)(R + R_STR); const float* STS = (const float*)(R + R_STS); bf16_t* SINR = (bf16_t*)(R + R_SINR); bf16_t* SINS = (bf16_t*)(R + R_SINS);
    for (int idx = bid * 512 + tid; idx < 262144 + 131072; idx += G * 512) {
        if (idx < 262144) { const int bh = idx >> 14, el = idx & 16383, b = bh >> 2, h = bh & 3; float run = 0.f;
            for (int c = 0; c < 32; ++c) { const size_t o = ((size_t)bh * 32 + c) * 16384 + el; SINR[o] = f2bf(run);
                const float dec = expf(CUMS[((size_t)b * SEQ + c * 128 + 127) * 16 + 8 + h]); run = dec * run + STR[o]; }
        } else { const int e = idx - 262144, bh = e >> 12, el = e & 4095, b = bh >> 3, hd = bh & 7; float run = 0.f;
            for (int c = 0; c < 32; ++c) { const size_t o = ((size_t)bh * 32 + c) * 4096 + el; SINS[o] = f2bf(run);
                const float dec = expf(CUMS[((size_t)b * SEQ + c * 128 + 127) * 16 + hd]); run = dec * run + STS[o]; }
        }
    }
}
DI void e3_phase(const Args& a, int li, LAS unsigned char* lds, int tid, int wave, int lane, int bid, int G) {
    unsigned char* R = a.ws + WS_R; const bf16_t* PROJ = (const bf16_t*)(R + R_PROJ); const bf16_t* CONV = (const bf16_t*)(R + R_CONV); const bf16_t* XDT = (const bf16_t*)(R + R_XDT); const float* CUMS = (const float*)(R + R_CUMS);
    bf16_t* MIX = (bf16_t*)(a.ws + WS_H); bf16_t* YP = (bf16_t*)(R + R_YP);
    for (int u = bid; u < 1536; u += G) {
        if (u < 512) { const int b = u >> 7, c = (u >> 2) & 31, h = u & 3; const size_t row0 = (size_t)b * SEQ + c * 128; const bf16_t* pr = PROJ + row0 * EV_PITCH;
            e3_unit<128, 128, true>(pr + h * 128, EV_PITCH, pr + 512 + h * 128, EV_PITCH, pr + 1024 + h * 128, EV_PITCH, CUMS + row0 * 16 + 8 + h,
                                    (const bf16_t*)(R + R_SINR) + ((size_t)(b * 4 + h) * 32 + c) * 16384, pr + 1536 + h * 128, EV_PITCH, nullptr, 0.f,
                                    MIX + row0 * DM + h * 128, DM, lds, tid, wave, lane);
        } else { const int v = u - 512, b = v >> 8, c = (v >> 3) & 31, hd = v & 7, g = hd >> 2; const size_t row0 = (size_t)b * SEQ + c * 128;
            e3_unit<64, 64, false>(CONV + row0 * 768 + 640 + g * 64, 768, CONV + row0 * 768 + 512 + g * 64, 768, XDT + row0 * 512 + hd * 64, 512, CUMS + row0 * 16 + hd,
                                   (const bf16_t*)(R + R_SINS) + ((size_t)(b * 8 + hd) * 32 + c) * 4096, PROJ + row0 * EV_PITCH + 2048 + hd * 64, EV_PITCH,
                                   CONV + row0 * 768 + hd * 64, a.in[I_SSMD][li * 8 + hd], YP + row0 * 512 + hd * 64, 512, lds, tid, wave, lane);
        }
    }
}
DI void e4_phase(const Args& a, int li, int gw, int NGW, int lane) {
    const bf16_t* YP = (const bf16_t*)(a.ws + WS_R + R_YP); bf16_t* MIX = (bf16_t*)(a.ws + WS_H); const float* nw = a.in[I_SSMNW] + (size_t)li * 512;
    const f32x4 w0 = *(const f32x4*)(nw + lane * 8), w1 = *(const f32x4*)(nw + lane * 8 + 4);
    for (int m = gw; m < MTOK; m += NGW) {
        const u32x4 v = *(const u32x4*)(YP + (size_t)m * 512 + lane * 8);
        float f[8] = {bflo(v.x), bfhi(v.x), bflo(v.y), bfhi(v.y), bflo(v.z), bfhi(v.z), bflo(v.w), bfhi(v.w)}; float s = 0.f;
#pragma unroll
        for (int e = 0; e < 8; ++e) s += f[e] * f[e];
        const float r = 1.0f / sqrtf(wave_sum(s) * (1.f / 512.f) + EPS);
        u32x4 o; o.x = pk2(f[0] * r * w0.x, f[1] * r * w0.y); o.y = pk2(f[2] * r * w0.z, f[3] * r * w0.w); o.z = pk2(f[4] * r * w1.x, f[5] * r * w1.y); o.w = pk2(f[6] * r * w1.z, f[7] * r * w1.w);
        *(u32x4*)(MIX + (size_t)m * DM + 512 + lane * 8) = o;
    }
}

template <int MT, int HD, class MaskF>
DI void flash_block(const bf16x8 (&qf)[MT][HD / 32], const bf16_t* Kb, int ldk, const bf16_t* Vt, int ldv,
                    f32x4 (&o)[MT][HD / 16], float (&mrow)[MT][4], float (&lrow)[MT][4], LAS bf16_t* pbuf, float c2, const MaskF& mk, int key0, int lr, int lq) {
    constexpr int PP = 72;
    f32x4 s[MT][4];
#pragma unroll
    for (int mt = 0; mt < MT; ++mt)
#pragma unroll
        for (int nt = 0; nt < 4; ++nt) s[mt][nt] = (f32x4){0.f, 0.f, 0.f, 0.f};
#pragma unroll
    for (int nt = 0; nt < 4; ++nt)
#pragma unroll
        for (int ks = 0; ks < HD / 32; ++ks) { const bf16x8 kf = *(const bf16x8*)(Kb + (size_t)(nt * 16 + lr) * ldk + ks * 32 + lq * 8);
#pragma unroll
            for (int mt = 0; mt < MT; ++mt) s[mt][nt] = mfma16(qf[mt][ks], kf, s[mt][nt]); }
#pragma unroll
    for (int mt = 0; mt < MT; ++mt) {
#pragma unroll
        for (int nt = 0; nt < 4; ++nt) { const bool ok = mk.ok(mt, key0 + nt * 16 + lr);
#pragma unroll
            for (int t = 0; t < 4; ++t) s[mt][nt][t] = ok ? s[mt][nt][t] * c2 : -INFINITY; }
#pragma unroll
        for (int t = 0; t < 4; ++t) {
            float mx = fmaxf(fmaxf(s[mt][0][t], s[mt][1][t]), fmaxf(s[mt][2][t], s[mt][3][t])); mx = grp16_max(mx);
            const float mnew = fmaxf(mrow[mt][t], mx), alpha = ex2(mrow[mt][t] - mnew); mrow[mt][t] = mnew;
            float ps = 0.f;
#pragma unroll
            for (int nt = 0; nt < 4; ++nt) { const float p = ex2(s[mt][nt][t] - mnew); s[mt][nt][t] = p; ps += p; }
            lrow[mt][t] = lrow[mt][t] * alpha + ps;
#pragma unroll
            for (int nt = 0; nt < HD / 16; ++nt) o[mt][nt][t] *= alpha;
        }
#pragma unroll
        for (int nt = 0; nt < 4; ++nt)
#pragma unroll
            for (int t = 0; t < 4; ++t) pbuf[(mt * 16 + 4 * lq + t) * PP + nt * 16 + lr] = f2bf(s[mt][nt][t]);
    }
    LDS_WAIT();
#pragma unroll
    for (int ks = 0; ks < 2; ++ks) { bf16x8 pf[MT];
#pragma unroll
        for (int mt = 0; mt < MT; ++mt) pf[mt] = *(const LAS bf16x8*)(pbuf + (mt * 16 + lr) * PP + ks * 32 + lq * 8);
#pragma unroll
        for (int nt = 0; nt < HD / 16; ++nt) { const bf16x8 vf = *(const bf16x8*)(Vt + (size_t)(nt * 16 + lr) * ldv + ks * 32 + lq * 8);
#pragma unroll
            for (int mt = 0; mt < MT; ++mt) o[mt][nt] = mfma16(pf[mt], vf, o[mt][nt]); } }
    LDS_WAIT();
}
struct NoMask { DI bool ok(int, int) const { return true; } };
struct WinMask { int W; int tpos[2]; DI bool ok(int mt, int key) const { return key <= tpos[mt] && tpos[mt] - key < W; } };
struct SelMask { unsigned long long sm[2]; int jb; int tpos[2]; DI bool ok(int mt, int key) const { return ((sm[mt] >> jb) & 1ull) != 0ull && key <= tpos[mt]; } };

struct CmpOrder {
    int G, c; const char* P; const char* W1;
    DI bool next(int i, pg8::Unit& u) const { const int L = i * G + c; if (L >= 16) return false; u.pm = L & 7; u.pn = L >> 3; const int b = u.pm >> 1, g = u.pm & 1;
        u.a = P + ((size_t)b * SEQ * OD_PITCH + 512 + u.pn * 128 + g * 64) * 2; u.b = W1 + (size_t)u.pn * 256 * 2048 * 2; return true; }
};
DI void o2_phase(const Args& a, const unsigned char* W, int gw, int lane) {
    if (gw >= 128) return;
    unsigned char* R = a.ws + WS_R; const bf16_t* HIDC = (const bf16_t*)(R + R_HIDC); const bf16_t* W2T = (const bf16_t*)(W + W_C2);
    bf16_t* KC = (bf16_t*)(R + R_KC); bf16_t* VCT = (bf16_t*)(R + R_VCT);
    const int kv = gw >> 6, bg = (gw >> 3) & 7, n0 = (gw & 7) * 32, lr = lane & 15, lq = lane >> 4;
    const bf16_t* hid = HIDC + ((size_t)(kv * 8 + bg) * 256) * 256; const bf16_t* w2 = W2T + (size_t)kv * 64 * 256;
    if (kv == 0) {
        f32x4 acc[2][4];
#pragma unroll
        for (int mt = 0; mt < 2; ++mt)
#pragma unroll
            for (int nt = 0; nt < 4; ++nt) acc[mt][nt] = (f32x4){0.f, 0.f, 0.f, 0.f};
#pragma unroll
        for (int ks = 0; ks < 8; ++ks) { bf16x8 xf[2];
#pragma unroll
            for (int mt = 0; mt < 2; ++mt) xf[mt] = *(const bf16x8*)(hid + (size_t)(n0 + mt * 16 + lr) * 256 + ks * 32 + lq * 8);
#pragma unroll
            for (int nt = 0; nt < 4; ++nt) { const bf16x8 yf = *(const bf16x8*)(w2 + (size_t)(nt * 16 + lr) * 256 + ks * 32 + lq * 8);
#pragma unroll
                for (int mt = 0; mt < 2; ++mt) acc[mt][nt] = mfma16(xf[mt], yf, acc[mt][nt]); } }
#pragma unroll
        for (int mt = 0; mt < 2; ++mt)
#pragma unroll
            for (int nt = 0; nt < 4; ++nt)
#pragma unroll
                for (int t = 0; t < 4; ++t) KC[((size_t)bg * 256 + n0 + mt * 16 + 4 * lq + t) * 64 + nt * 16 + lr] = f2bf(acc[mt][nt][t]);
    } else {
        f32x4 acc[4][2];
#pragma unroll
        for (int mt = 0; mt < 4; ++mt)
#pragma unroll
            for (int nt = 0; nt < 2; ++nt) acc[mt][nt] = (f32x4){0.f, 0.f, 0.f, 0.f};
#pragma unroll
        for (int ks = 0; ks < 8; ++ks) { bf16x8 yf[2];
#pragma unroll
            for (int nt = 0; nt < 2; ++nt) yf[nt] = *(const bf16x8*)(hid + (size_t)(n0 + nt * 16 + lr) * 256 + ks * 32 + lq * 8);
#pragma unroll
            for (int mt = 0; mt < 4; ++mt) { const bf16x8 xf = *(const bf16x8*)(w2 + (size_t)(mt * 16 + lr) * 256 + ks * 32 + lq * 8);
#pragma unroll
                for (int nt = 0; nt < 2; ++nt) acc[mt][nt] = mfma16(xf, yf[nt], acc[mt][nt]); } }
#pragma unroll
        for (int mt = 0; mt < 4; ++mt)
#pragma unroll
            for (int nt = 0; nt < 2; ++nt)
#pragma unroll
                for (int t = 0; t < 4; ++t) VCT[((size_t)bg * 64 + mt * 16 + 4 * lq + t) * 256 + n0 + nt * 16 + lr] = f2bf(acc[mt][nt][t]);
    }
}

constexpr int O3_IMP = 102400, O3_SELM = 139264, O3_UNION = 139776;
constexpr int O3_OTP = 68, O3_PBUF = 0, O3_KV = 36864, O3_NST = 4;
struct WinMaskT { int W; int tpos[2]; DI void set_block(int) {} DI bool ok(int mt, int key) const { return key <= tpos[mt] && tpos[mt] - key < W; } };
struct SelMaskT { unsigned long long sm[2]; int jb; int tpos[2]; DI void set_block(int j) { jb = j; } DI bool ok(int mt, int key) const { return ((sm[mt] >> jb) & 1ull) != 0ull && key <= tpos[mt]; } };

template <class MaskF>
DI void flash_pass_lds(const bf16x8 (&qf)[2][2], const bf16_t* Kg, int ldk, const bf16_t* Vg, int ldv, unsigned long long use,
                       f32x4 (&o)[2][4], float (&mrow)[2], float (&lrow)[2], LAS unsigned char* lds, float c2, MaskF& mk, int tid, int wave, int lr, int lq) {
    constexpr int PP = 72;
    LAS bf16_t* pbuf = (LAS bf16_t*)(lds + O3_PBUF + wave * 4608);
    int R, C; pg8::stage_rc(tid * 16, R, C);
    const bf16_t* ksrc = Kg + (size_t)R * ldk + C; const bf16_t* vsrc = Vg + (size_t)R * ldv + C;
    const int koff = pg8::lds_byte(lr, lq * 8);
#pragma unroll
    for (int mt = 0; mt < 2; ++mt) { mrow[mt] = -1e30f; lrow[mt] = 0.f;
#pragma unroll
        for (int nt = 0; nt < 4; ++nt) o[mt][nt] = (f32x4){0.f, 0.f, 0.f, 0.f}; }
    __syncthreads();
    if (use == 0ull) return;
    unsigned long long rem_issue = use; int nissued = 0; const int total = __builtin_popcountll(use);
#define O3_ISSUE() do { const int j_ = __builtin_ctzll(rem_issue); rem_issue &= rem_issue - 1ull; const int b_ = (nissued & (O3_NST - 1)) * 16384; ++nissued; \
        __builtin_amdgcn_global_load_lds((const unsigned*)(ksrc + (size_t)j_ * 64 * ldk), (LAS unsigned*)(lds + O3_KV + b_ + wave * 1024), 16, 0, 0); \
        __builtin_amdgcn_global_load_lds((const unsigned*)(vsrc + j_ * 64), (LAS unsigned*)(lds + O3_KV + b_ + 8192 + wave * 1024), 16, 0, 0); } while (0)
#pragma unroll 1
    for (int k = 0; k < O3_NST - 1 && rem_issue; ++k) O3_ISSUE();
#pragma unroll 1
    for (int i = 0; i < total; ++i) {
        const int jb = __builtin_ctzll(use); use &= use - 1ull; const int buf = i & (O3_NST - 1);
        const int ahead = nissued - i - 1;
        if (ahead >= 2) asm volatile("s_waitcnt vmcnt(4)" ::: "memory"); else if (ahead == 1) asm volatile("s_waitcnt vmcnt(2)" ::: "memory"); else asm volatile("s_waitcnt vmcnt(0)" ::: "memory");
        asm volatile("s_waitcnt lgkmcnt(0)" ::: "memory"); __builtin_amdgcn_s_barrier(); asm volatile("" ::: "memory");
        if (rem_issue) O3_ISSUE();
        const LAS unsigned char* kb = lds + O3_KV + buf * 16384 + koff; const LAS unsigned char* vb = kb + 8192;
        mk.set_block(jb);
        const int key0 = jb * 64 + 4 * lq;
        f32x4 s[2][4];
#pragma unroll
        for (int mt = 0; mt < 2; ++mt)
#pragma unroll
            for (int nt = 0; nt < 4; ++nt) s[mt][nt] = (f32x4){0.f, 0.f, 0.f, 0.f};
#pragma unroll
        for (int nt = 0; nt < 4; ++nt)
#pragma unroll
            for (int ks = 0; ks < 2; ++ks) { const bf16x8 kf = *(const LAS bf16x8*)(kb + nt * 2048 + ks * 1024);
#pragma unroll
                for (int mt = 0; mt < 2; ++mt) s[mt][nt] = mfma16(kf, qf[mt][ks], s[mt][nt]); }
#pragma unroll
        for (int mt = 0; mt < 2; ++mt) {
            float mx = -INFINITY;
#pragma unroll
            for (int nt = 0; nt < 4; ++nt)
#pragma unroll
                for (int t = 0; t < 4; ++t) { const float v = mk.ok(mt, key0 + nt * 16 + t) ? s[mt][nt][t] : -INFINITY; s[mt][nt][t] = v; mx = fmaxf(mx, v); }
            mx = fmaxf(mx, __shfl_xor(mx, 16)); mx = fmaxf(mx, __shfl_xor(mx, 32));
            const float mnew = fmaxf(mrow[mt], mx * c2), alpha = ex2(mrow[mt] - mnew); mrow[mt] = mnew;
            float ps = 0.f;
#pragma unroll
            for (int nt = 0; nt < 4; ++nt) {
#pragma unroll
                for (int t = 0; t < 4; ++t) { const float p = ex2(__builtin_fmaf(s[mt][nt][t], c2, -mnew)); s[mt][nt][t] = p; ps += p; }
                u32x2 w; w.x = pk2(s[mt][nt][0], s[mt][nt][1]); w.y = pk2(s[mt][nt][2], s[mt][nt][3]);
                *(LAS u32x2*)(pbuf + (mt * 16 + lr) * PP + nt * 16 + 4 * lq) = w; }
            lrow[mt] = lrow[mt] * alpha + ps;
#pragma unroll
            for (int nt = 0; nt < 4; ++nt) o[mt][nt] *= alpha;
        }
        LDS_WAIT();
#pragma unroll
        for (int ks = 0; ks < 2; ++ks) { bf16x8 pf[2];
#pragma unroll
            for (int mt = 0; mt < 2; ++mt) pf[mt] = *(const LAS bf16x8*)(pbuf + (mt * 16 + lr) * PP + ks * 32 + lq * 8);
#pragma unroll
            for (int nt = 0; nt < 4; ++nt) { const bf16x8 vf = *(const LAS bf16x8*)(vb + nt * 2048 + ks * 1024);
#pragma unroll
                for (int mt = 0; mt < 2; ++mt) o[mt][nt] = mfma16(vf, pf[mt], o[mt][nt]); } }
        LDS_WAIT();
    }
#undef O3_ISSUE
#pragma unroll
    for (int mt = 0; mt < 2; ++mt) { lrow[mt] += __shfl_xor(lrow[mt], 16); lrow[mt] += __shfl_xor(lrow[mt], 32); }
}

DI void o3_unit(const Args& a, int li, int bg, int tile, LAS unsigned char* lds, int tid, int wave, int lane) {
    asm volatile("" : "+v"(lane), "+v"(tid));
    unsigned char* R = a.ws + WS_R; const bf16_t* PROJ = (const bf16_t*)(R + R_PROJ); const bf16_t* VTb = (const bf16_t*)(R + R_VT);
    const bf16_t* KC = (const bf16_t*)(R + R_KC); const bf16_t* VCT = (const bf16_t*)(R + R_VCT); bf16_t* MIX = (bf16_t*)(a.ws + WS_H);
    const int b = bg >> 1, g = bg & 1, t0 = tile * 64, lr = lane & 15, lq = lane >> 4; const size_t rowb = (size_t)b * SEQ;
    LAS float* IMP = (LAS float*)(lds + O3_IMP + wave * 2048);
    LAS unsigned long long* SELM = (LAS unsigned long long*)(lds + O3_SELM + wave * 64); LAS unsigned long long* UNI8 = (LAS unsigned long long*)(lds + O3_UNION);
    LAS bf16_t* pbuf = (LAS bf16_t*)(lds + O3_PBUF + wave * 4608);
    const float c2 = 0.125f * LOG2E;
    const int e = lr & 3; int qpos[2]; qpos[0] = t0 + 8 * wave + (lr >> 2); qpos[1] = qpos[0] + 4;
    const int koff = pg8::lds_byte(lr, lq * 8);
    __syncthreads();
    {
        int Rr, Cc; pg8::stage_rc(tid * 16, Rr, Cc);
#pragma unroll
        for (int c = 0; c < 4; ++c) {
            __builtin_amdgcn_global_load_lds((const unsigned*)(KC + ((size_t)bg * 256 + c * 64 + Rr) * 64 + Cc), (LAS unsigned*)(lds + O3_KV + c * 16384 + wave * 1024), 16, 0, 0);
            __builtin_amdgcn_global_load_lds((const unsigned*)(VCT + ((size_t)bg * 64 + Rr) * 256 + c * 64 + Cc), (LAS unsigned*)(lds + O3_KV + c * 16384 + 8192 + wave * 1024), 16, 0, 0); }
    }
    bf16x8 qf[2][2];
#pragma unroll
    for (int mt = 0; mt < 2; ++mt)
#pragma unroll
        for (int ks = 0; ks < 2; ++ks) qf[mt][ks] = *(const bf16x8*)(PROJ + (rowb + t0 + 8 * wave + 4 * mt + (lr >> 2)) * OD_PITCH + g * 256 + (lr & 3) * 64 + ks * 32 + lq * 8);
#define GATE(mt, br) sigmoid_f(bf2f(PROJ[(rowb + qpos[mt]) * OD_PITCH + 1664 + g * 12 + e * 3 + (br)]))
    VM_WAIT(); __syncthreads();
    f32x4 oacc[2][4];
#pragma unroll
    for (int mt = 0; mt < 2; ++mt) {
        f32x4 s[4][4];
#pragma unroll
        for (int c = 0; c < 4; ++c)
#pragma unroll
            for (int nt = 0; nt < 4; ++nt) { s[c][nt] = (f32x4){0.f, 0.f, 0.f, 0.f};
#pragma unroll
                for (int ks = 0; ks < 2; ++ks) { const bf16x8 kf = *(const LAS bf16x8*)(lds + O3_KV + c * 16384 + koff + nt * 2048 + ks * 1024); s[c][nt] = mfma16(kf, qf[mt][ks], s[c][nt]); } }
        float mx = -INFINITY;
#pragma unroll
        for (int c = 0; c < 4; ++c)
#pragma unroll
            for (int nt = 0; nt < 4; ++nt)
#pragma unroll
                for (int t = 0; t < 4; ++t) { const int n = c * 64 + nt * 16 + 4 * lq + t; const bool ok = (n < 255) && (16 * n + 31 <= qpos[mt]);
                    const float v = ok ? s[c][nt][t] : -INFINITY; s[c][nt][t] = v; mx = fmaxf(mx, v); }
        mx = fmaxf(mx, __shfl_xor(mx, 16)); mx = fmaxf(mx, __shfl_xor(mx, 32));
        const float mm = (mx == -INFINITY) ? 0.f : mx * c2; float sum = 0.f;
#pragma unroll
        for (int c = 0; c < 4; ++c)
#pragma unroll
            for (int nt = 0; nt < 4; ++nt)
#pragma unroll
                for (int t = 0; t < 4; ++t) { const float p = ex2(__builtin_fmaf(s[c][nt][t], c2, -mm)); s[c][nt][t] = p; sum += p; }
        sum += __shfl_xor(sum, 16); sum += __shfl_xor(sum, 32);
        const float inv = 1.0f / fmaxf(sum, 1e-30f);
#pragma unroll
        for (int c = 0; c < 4; ++c)
#pragma unroll
            for (int nt = 0; nt < 4; ++nt) s[c][nt] *= inv;
        const int srcl = (lane + 48) & 63;
#pragma unroll
        for (int c = 0; c < 4; ++c)
#pragma unroll
            for (int nt = 0; nt < 4; ++nt) {
                const float own = (s[c][nt][0] + s[c][nt][1]) + (s[c][nt][2] + s[c][nt][3]);
                const float a_ = __shfl(s[c][nt][3], srcl);
                float b_ = 0.f; if (c > 0 || nt > 0) b_ = __shfl(s[(nt > 0) ? c : c - (c > 0 ? 1 : 0)][(nt > 0) ? nt - 1 : 3][3], srcl);
                float v = own + (lq > 0 ? a_ : b_);
                v += __shfl_xor(v, 1); v += __shfl_xor(v, 2);
                if (e == 0) IMP[(4 * mt + (lr >> 2)) * 64 + c * 16 + nt * 4 + lq] = v; }
#pragma unroll
        for (int nt = 0; nt < 4; ++nt) oacc[mt][nt] = (f32x4){0.f, 0.f, 0.f, 0.f};
#pragma unroll
        for (int c = 0; c < 4; ++c) {
#pragma unroll
            for (int nt = 0; nt < 4; ++nt) { u32x2 w; w.x = pk2(s[c][nt][0], s[c][nt][1]); w.y = pk2(s[c][nt][2], s[c][nt][3]); *(LAS u32x2*)(pbuf + lr * 72 + nt * 16 + 4 * lq) = w; }
            LDS_WAIT();
#pragma unroll
            for (int ks = 0; ks < 2; ++ks) { const bf16x8 pf = *(const LAS bf16x8*)(pbuf + lr * 72 + ks * 32 + lq * 8);
#pragma unroll
                for (int nt = 0; nt < 4; ++nt) { const bf16x8 vf = *(const LAS bf16x8*)(lds + O3_KV + c * 16384 + 8192 + koff + nt * 2048 + ks * 1024); oacc[mt][nt] = mfma16(vf, pf, oacc[mt][nt]); } }
            LDS_WAIT();
        }
        const float g0 = GATE(mt, 0);
#pragma unroll
        for (int nt = 0; nt < 4; ++nt) oacc[mt][nt] *= g0;
    }
    LDS_WAIT();
    unsigned long long wunion = 0ull;
    {
        const int j = lane; const bool valid = j <= tile, forced = valid && (j == 0 || j == tile || j == tile - 1);
#pragma unroll
        for (int tk = 0; tk < 8; ++tk) { const float imp = IMP[tk * 64 + j]; IMP[tk * 64 + j] = forced ? 1e6f : (valid ? imp : -INFINITY); }
        LDS_WAIT();
#pragma unroll 1
        for (int tk = 0; tk < 8; ++tk) {
            const float sc = IMP[tk * 64 + j]; int rank = 0;
#pragma unroll
            for (int q4 = 0; q4 < 16; ++q4) { const f32x4 v = *(const LAS f32x4*)(IMP + tk * 64 + q4 * 4);
#pragma unroll
                for (int k = 0; k < 4; ++k) { const int jp = q4 * 4 + k; rank += ((v[k] > sc) || (v[k] == sc && jp < j)) ? 1 : 0; } }
            const unsigned long long m = __ballot(valid && rank < 16);
            wunion |= m; if (lane == 0) SELM[tk] = m;
        }
    }
    if (lane == 0) UNI8[wave] = wunion;
    LDS_WAIT();
    __syncthreads();
    unsigned long long use_sel = 0ull;
#pragma unroll
    for (int w = 0; w < 8; ++w) use_sel |= UNI8[w];
    { const unsigned lo32 = __builtin_amdgcn_readfirstlane((unsigned)use_sel), hi32 = __builtin_amdgcn_readfirstlane((unsigned)(use_sel >> 32)); use_sel = ((unsigned long long)hi32 << 32) | lo32; }
    f32x4 o[2][4]; float mrow[2], lrow[2];
    {
        SelMaskT mk; mk.sm[0] = SELM[lr >> 2]; mk.sm[1] = SELM[4 + (lr >> 2)]; mk.tpos[0] = qpos[0]; mk.tpos[1] = qpos[1]; mk.jb = 0;
        flash_pass_lds(qf, PROJ + rowb * OD_PITCH + 768 + g * 64, OD_PITCH, VTb + (size_t)(g * 64) * MTOK + rowb, MTOK, use_sel, o, mrow, lrow, lds, c2, mk, tid, wave, lr, lq);
#pragma unroll
        for (int mt = 0; mt < 2; ++mt) { const float f = GATE(mt, 1) / lrow[mt];
#pragma unroll
            for (int nt = 0; nt < 4; ++nt) oacc[mt][nt] += o[mt][nt] * f; }
    }
    {
        WinMaskT mk; mk.W = 512; mk.tpos[0] = qpos[0]; mk.tpos[1] = qpos[1];
        const int jlo = tile >= 8 ? tile - 8 : 0; const unsigned long long use = ((tile == 63) ? ~0ull : ((1ull << (tile + 1)) - 1ull)) & ~((1ull << jlo) - 1ull);
        flash_pass_lds(qf, PROJ + rowb * OD_PITCH + 896 + g * 64, OD_PITCH, VTb + (size_t)(128 + g * 64) * MTOK + rowb, MTOK, use, o, mrow, lrow, lds, c2, mk, tid, wave, lr, lq);
#pragma unroll
        for (int mt = 0; mt < 2; ++mt) { const float f = GATE(mt, 2) / lrow[mt];
#pragma unroll
            for (int nt = 0; nt < 4; ++nt) { const f32x4 v = oacc[mt][nt] + o[mt][nt] * f;
                u32x2 w; w.x = pk2(v[0], v[1]); w.y = pk2(v[2], v[3]); *(u32x2*)(MIX + (rowb + qpos[mt]) * DM + g * 256 + e * 64 + nt * 16 + 4 * lq) = w; } }
    }
    {
#pragma unroll
        for (int mt = 0; mt < 2; ++mt)
#pragma unroll
            for (int ks = 0; ks < 2; ++ks) qf[mt][ks] = *(const bf16x8*)(PROJ + (rowb + t0 + 8 * wave + 4 * mt + (lr >> 2)) * OD_PITCH + 1152 + g * 256 + (lr & 3) * 64 + ks * 32 + lq * 8);
        WinMaskT mk; mk.W = 128; mk.tpos[0] = qpos[0]; mk.tpos[1] = qpos[1];
        const int jlo = tile >= 2 ? tile - 2 : 0; const unsigned long long use = ((tile == 63) ? ~0ull : ((1ull << (tile + 1)) - 1ull)) & ~((1ull << jlo) - 1ull);
        flash_pass_lds(qf, PROJ + rowb * OD_PITCH + 1024 + g * 64, OD_PITCH, VTb + (size_t)(256 + g * 64) * MTOK + rowb, MTOK, use, o, mrow, lrow, lds, c2, mk, tid, wave, lr, lq);
        const float sk = a.in[I_SINKS][li * 8 + g * 4 + e] * LOG2E;
#pragma unroll
        for (int mt = 0; mt < 2; ++mt) { const float f = 1.0f / (lrow[mt] + ex2(sk - mrow[mt]));
#pragma unroll
            for (int nt = 0; nt < 4; ++nt) { const f32x4 v = o[mt][nt] * f;
                u32x2 w; w.x = pk2(v[0], v[1]); w.y = pk2(v[2], v[3]); *(u32x2*)(MIX + (rowb + qpos[mt]) * DM + 512 + g * 256 + e * 64 + nt * 16 + 4 * lq) = w; } }
    }
#undef GATE
}
DI void o3_phase(const Args& a, int li, LAS unsigned char* lds, int tid, int wave, int lane, int bid, int G) {
    for (int p = bid; p < 256; p += G) { const int bg = p >> 5, tl = p & 31;
        o3_unit(a, li, bg, 63 - tl, lds, tid, wave, lane);
        o3_unit(a, li, bg, tl, lds, tid, wave, lane); }
}

constexpr int XA_PBUF = 0, XA_PP = 40, XA_KV = 10240, XA_STAGE = 32768, XA_NST = 4;
DI void xattn_phase(const Args& a, LAS unsigned char* lds, int tid, int wave, int lane, int bid, int G) {
    const bf16_t* Q = (const bf16_t*)(a.ws + WS_R + R_Q); bf16_t* O = (bf16_t*)(a.ws + WS_H); const bf16_t* KX = (const bf16_t*)(a.ws + WS_KX); const bf16_t* VTX = (const bf16_t*)(a.ws + WS_VTX);
    const float c2 = 0.0625f * LOG2E;
    for (int u = bid; u < 512; u += G) {
        asm volatile("" : "+v"(lane), "+v"(tid));
        const int lr = lane & 15, lq = lane >> 4; LAS bf16_t* pbuf = (LAS bf16_t*)(lds + XA_PBUF + wave * 1280);
        const int b = u >> 7, hd = (u >> 5) & 3, qt = u & 31;
        const size_t row0 = (size_t)b * SEQ + qt * 128 + wave * 16;
        const bf16_t* ksrc[2]; const bf16_t* vsrc[2];
#pragma unroll
        for (int i = 0; i < 2; ++i) { const int bb = tid * 16 + i * 8192, blk = bb >> 10, sb = bb & 1023, sw = sb ^ (((sb >> 9) & 1) << 5);
            ksrc[i] = KX + ((size_t)b * MEMLEN + (blk & 1) * 16 + (sw >> 6)) * DM + hd * 256 + (blk >> 1) * 32 + ((sw & 63) >> 1);
            vsrc[i] = VTX + ((size_t)hd * 256 + blk * 16 + (sw >> 6)) * DM + b * MEMLEN + ((sw & 63) >> 1); }
        const int koff = pg8::lds_byte(lr, lq * 8);
        __syncthreads();
#define XA_ISSUE(j_) do { const int st_ = XA_KV + ((j_) & (XA_NST - 1)) * XA_STAGE + wave * 1024; \
        __builtin_amdgcn_global_load_lds((const unsigned*)(ksrc[0] + (size_t)(j_) * 32 * DM), (LAS unsigned*)(lds + st_), 16, 0, 0); \
        __builtin_amdgcn_global_load_lds((const unsigned*)(ksrc[1] + (size_t)(j_) * 32 * DM), (LAS unsigned*)(lds + st_ + 8192), 16, 0, 0); \
        __builtin_amdgcn_global_load_lds((const unsigned*)(vsrc[0] + (j_) * 32), (LAS unsigned*)(lds + st_ + 16384), 16, 0, 0); \
        __builtin_amdgcn_global_load_lds((const unsigned*)(vsrc[1] + (j_) * 32), (LAS unsigned*)(lds + st_ + 24576), 16, 0, 0); } while (0)
        bf16x8 qf[8];
#pragma unroll
        for (int ks = 0; ks < 8; ++ks) qf[ks] = *(const bf16x8*)(Q + (row0 + lr) * DM + hd * 256 + ks * 32 + lq * 8);
        asm volatile("" ::: "memory");
        XA_ISSUE(0); XA_ISSUE(1); XA_ISSUE(2);
        f32x4 o[16]; float mrow = -1e30f, lsum = 0.f;
#pragma unroll
        for (int nt = 0; nt < 16; ++nt) o[nt] = (f32x4){0.f, 0.f, 0.f, 0.f};
#pragma unroll 1
        for (int j = 0; j < 8; ++j) {
            if (j <= 5) asm volatile("s_waitcnt vmcnt(8)" ::: "memory"); else if (j == 6) asm volatile("s_waitcnt vmcnt(4)" ::: "memory"); else asm volatile("s_waitcnt vmcnt(0)" ::: "memory");
            asm volatile("s_waitcnt lgkmcnt(0)" ::: "memory"); __builtin_amdgcn_s_barrier(); asm volatile("" ::: "memory");
            if (j + 3 < 8) XA_ISSUE(j + 3);
            const LAS unsigned char* st = lds + XA_KV + (j & (XA_NST - 1)) * XA_STAGE + koff;
            f32x4 s[2];
#pragma unroll
            for (int nt = 0; nt < 2; ++nt) { s[nt] = (f32x4){0.f, 0.f, 0.f, 0.f};
#pragma unroll
                for (int ks = 0; ks < 8; ++ks) { const bf16x8 kf = *(const LAS bf16x8*)(st + (ks * 2 + nt) * 1024); s[nt] = mfma16(kf, qf[ks], s[nt]); } }
            float mx = fmaxf(fmaxf(fmaxf(s[0][0], s[0][1]), fmaxf(s[0][2], s[0][3])), fmaxf(fmaxf(s[1][0], s[1][1]), fmaxf(s[1][2], s[1][3])));
            mx = fmaxf(mx, __shfl_xor(mx, 16)); mx = fmaxf(mx, __shfl_xor(mx, 32));
            const float mnew = fmaxf(mrow, mx * c2), alpha = ex2(mrow - mnew); mrow = mnew;
            float ps = 0.f;
#pragma unroll
            for (int nt = 0; nt < 2; ++nt) {
#pragma unroll
                for (int t = 0; t < 4; ++t) { const float p = ex2(__builtin_fmaf(s[nt][t], c2, -mnew)); s[nt][t] = p; ps += p; }
                u32x2 w; w.x = pk2(s[nt][0], s[nt][1]); w.y = pk2(s[nt][2], s[nt][3]); *(LAS u32x2*)(pbuf + lr * XA_PP + nt * 16 + 4 * lq) = w; }
            lsum = lsum * alpha + ps;
#pragma unroll
            for (int nt = 0; nt < 16; ++nt) o[nt] *= alpha;
            LDS_WAIT();
            const bf16x8 pf = *(const LAS bf16x8*)(pbuf + lr * XA_PP + lq * 8);
#pragma unroll
            for (int nt = 0; nt < 16; ++nt) { const bf16x8 vf = *(const LAS bf16x8*)(st + 16384 + nt * 1024); o[nt] = mfma16(vf, pf, o[nt]); }
            LDS_WAIT();
        }
#undef XA_ISSUE
        lsum += __shfl_xor(lsum, 16); lsum += __shfl_xor(lsum, 32);
        const float f = 1.0f / lsum;
#pragma unroll
        for (int nt = 0; nt < 16; ++nt) { const f32x4 v = o[nt] * f; u32x2 w; w.x = pk2(v[0], v[1]); w.y = pk2(v[2], v[3]);
            *(u32x2*)(O + (row0 + lr) * DM + hd * 256 + nt * 16 + 4 * lq) = w; }
    }
}

#ifndef MK_MODE
#define MK_MODE 1
#endif
constexpr int PH_PER_LAYER = 20, PH_FINAL = DEPTH * PH_PER_LAYER, PH_TOTAL = PH_FINAL + 1;
extern __shared__ __attribute__((aligned(16))) unsigned char lds_raw[];

#define PHASE_SETUP \
    asm volatile("" : "+s"(kp_)); \
    LAS unsigned char* lds = (LAS unsigned char*)lds_raw; \
    int tid = threadIdx.x, bid = blockIdx.x, G = gridDim.x; asm volatile("" : "+v"(tid)); asm volatile("" : "+s"(bid), "+s"(G)); \
    const int lane = tid & 63, wave = __builtin_amdgcn_readfirstlane(tid >> 6); const int gw = bid * 8 + wave, NGW = G * 8; (void)bid; \
    Args a; _Pragma("unroll") for (int i_ = 0; i_ < 25; ++i_) a.in[i_] = kp_->in[i_]; a.out = kp_->out; a.ws = kp_->ws; a.ph_lo = 0; a.ph_hi = 0; \
    unsigned char* ws = a.ws; float* X = (float*)(ws + WS_X); bf16_t* H = (bf16_t*)(ws + WS_H); unsigned char* R = ws + WS_R; unsigned char* W = ws + (wpar_ ? WS_W2 : WS_W); \
    (void)lds; (void)tid; (void)lane; (void)wave; (void)G; (void)gw; (void)NGW; (void)X; (void)H; (void)R; (void)W;
#define UNI(x) __builtin_amdgcn_readfirstlane(x)

DI void P_prologue(KP kp_, int layer) { layer = UNI(layer); const int wpar_ = layer & 1; PHASE_SETUP layer_prologue(kp_, a, layer, lds, tid, wave, lane, gw, NGW); __syncthreads(); }
DI void P_norm(KP kp_, int layer, int which) { layer = UNI(layer); which = UNI(which); const int wpar_ = layer & 1; PHASE_SETUP
    norm_phase((layer == 0 && which == 0) ? a.in[I_X] : X, a.in[I_NORMW] + ((size_t)layer * 4 + which) * DM, H, gw, NGW, lane); }
DI void P_norm0_kvx(KP kp_, int layer) { layer = UNI(layer); const int wpar_ = layer & 1; PHASE_SETUP
    const float* xin = (layer == 0) ? a.in[I_X] : X; const float* nw = a.in[I_NORMW] + (size_t)layer * 4 * DM;
    if (G >= 64) {
        if (bid < 32) {
            const bool vpart = bid >= 16;
            const bf16_t* A = vpart ? (const bf16_t*)(W + W_XKV) + (size_t)DM * DM : (const bf16_t*)(ws + WS_MEMN);
            const bf16_t* Bt = vpart ? (const bf16_t*)(ws + WS_MEMN) : (const bf16_t*)(W + W_XKV);
            pg8::Gemm g{A, Bt, DM, DM, 128, 128, DM}; pg8::StaticOrder S; S.init(g, vpart ? DM : NB * MEMLEN, vpart ? NB * MEMLEN : DM, 16, bid & 15);
            pg8::EpiBf16<0> E{vpart ? (bf16_t*)(ws + WS_VTX) : (bf16_t*)(ws + WS_KX), DM, nullptr, 0}; pg8::gemm_phase(lds, g, S, E, tid);
        } else norm_phase(xin, nw, H, (bid - 32) * 8 + wave, (G - 32) * 8, lane);
    } else {
        for (int which = 0; which < 2; ++which) {
            const bool vpart = which == 1;
            const bf16_t* A = vpart ? (const bf16_t*)(W + W_XKV) + (size_t)DM * DM : (const bf16_t*)(ws + WS_MEMN);
            const bf16_t* Bt = vpart ? (const bf16_t*)(ws + WS_MEMN) : (const bf16_t*)(W + W_XKV);
            pg8::Gemm g{A, Bt, DM, DM, 128, 128, DM}; pg8::StaticOrder S; S.init(g, vpart ? DM : NB * MEMLEN, vpart ? NB * MEMLEN : DM, G, bid);
            pg8::EpiBf16<0> E{vpart ? (bf16_t*)(ws + WS_VTX) : (bf16_t*)(ws + WS_KX), DM, nullptr, 0}; pg8::gemm_phase(lds, g, S, E, tid); }
        norm_phase(xin, nw, H, gw, NGW, lane);
    } }
DI void P_final(KP kp_) { const int wpar_ = 0; PHASE_SETUP final_norm_phase(X, a.in[I_FNORMW], a.out, gw, NGW, lane); }
DI void P_gemm_bf16(KP kp_, int which, int layer) { which = UNI(which); layer = UNI(layer); const int wpar_ = layer & 1; PHASE_SETUP
    const bf16_t* A = H; const bf16_t* Bt = (const bf16_t*)(W + W_IN); bf16_t* O = (bf16_t*)(R + R_PROJ); int M = MTOK, N = EV_PITCH, ldc = EV_PITCH, rot = 0;
    if (which == 0) { A = (const bf16_t*)(ws + WS_MEMN); Bt = (const bf16_t*)(W + W_XKV); O = (bf16_t*)(ws + WS_KX); M = NB * MEMLEN; N = DM; ldc = DM; }
    else if (which == 1) { A = (const bf16_t*)(W + W_XKV) + (size_t)DM * DM; Bt = (const bf16_t*)(ws + WS_MEMN); O = (bf16_t*)(ws + WS_VTX); M = DM; N = NB * MEMLEN; ldc = DM; rot = 16; }
    else if (which == 3) { N = OD_PITCH; ldc = OD_PITCH; }
    else if (which == 4) { A = (const bf16_t*)(W + W_IN) + (size_t)OD_PITCH * DM; Bt = H; O = (bf16_t*)(R + R_VT); M = 512; N = MTOK; ldc = MTOK; rot = 64; }
    else if (which == 5) { Bt = (const bf16_t*)(W + W_XQ); O = (bf16_t*)(R + R_Q); N = DM; ldc = DM; }
    pg8::Gemm g{A, Bt, DM, DM, 128, 128, DM}; pg8::StaticOrder S; S.init(g, M, N, G, (bid + G - rot) % G);
    pg8::EpiBf16<0> E{O, ldc, nullptr, 0}; pg8::gemm_phase(lds, g, S, E, tid);
    if (which == 2) prologue_tail(kp_, a, layer + 1, 1, 128, bid, G, lds, tid, wave, lane);
    if (which == 3) prologue_tail(kp_, a, layer + 1, 1, 192, bid, G, lds, tid, wave, lane); }
DI void P_gemm_swiglu(KP kp_, int half, int layer) { half = UNI(half); layer = UNI(layer); const int wpar_ = layer & 1; PHASE_SETUP
    pg8::Gemm g{H, (const bf16_t*)(W + W_GU) + (size_t)half * 2 * FF * DM, DM, DM, 128, 128, DM}; pg8::StaticOrder S; S.init(g, MTOK, 2 * FF, G, bid);
    pg8::EpiSwiGLU E{(bf16_t*)(R + R_HID), FF}; pg8::gemm_phase(lds, g, S, E, tid);
    prologue_tail(kp_, a, layer + 1, half ? 2 : 0, 128, bid, G, lds, tid, wave, lane); }
DI void P_gemm_resid(KP kp_, int which, int first, int layer) { which = UNI(which); first = UNI(first); layer = UNI(layer); const int wpar_ = layer & 1; PHASE_SETUP
    const bf16_t* A = (const bf16_t*)(R + R_HID); const bf16_t* Bt = (const bf16_t*)(W + W_D) + (size_t)which * DM * FF; int K = FF; float sc = 0.5f;
    if (which == 2) { A = H; Bt = (const bf16_t*)(W + W_OUT); K = DM; sc = 1.0f; }
    else if (which == 3) { A = H; Bt = (const bf16_t*)(W + W_XO); K = DM; sc = 1.0f; }
    pg8::Gemm g{A, Bt, K, K, 128, 128, K}; pg8::StaticOrder S; S.init(g, MTOK, DM, G, bid);
    pg8::EpiResid E{first ? a.in[I_X] : X, X, sc}; pg8::gemm_phase(lds, g, S, E, tid); }
DI void P_gemm_cmp(KP kp_, int layer) { layer = UNI(layer); const int wpar_ = layer & 1; PHASE_SETUP
    pg8::Gemm g{nullptr, nullptr, 16 * OD_PITCH, 2048, OD_PITCH * 2, 128, 2048};
    CmpOrder S{G, bid, (const char*)(R + R_PROJ), (const char*)(W + W_C1)};
    pg8::EpiBf16<2> E{(bf16_t*)(R + R_HIDC), 256, (const float*)(ws + WS_BIAS1), 1}; pg8::gemm_phase(lds, g, S, E, tid); }
DI void P_e0(KP kp_, int li) { li = UNI(li); const int wpar_ = 0; PHASE_SETUP for (int u = bid; u < 256; u += G) e0_unit(a, li, u, lds, tid, wave, lane); }
DI void P_e1(KP kp_) { const int wpar_ = 0; PHASE_SETUP e1_phase(a, lds, tid, wave, lane, bid, G); }
DI void P_e2(KP kp_) { const int wpar_ = 0; PHASE_SETUP e2_phase(a, tid, bid, G); }
DI void P_e3(KP kp_, int li) { li = UNI(li); const int wpar_ = 0; PHASE_SETUP e3_phase(a, li, lds, tid, wave, lane, bid, G); }
DI void P_e4(KP kp_, int li) { li = UNI(li); const int wpar_ = 0; PHASE_SETUP e4_phase(a, li, gw, NGW, lane); }
DI void P_o2(KP kp_, int layer) { layer = UNI(layer); const int wpar_ = layer & 1; PHASE_SETUP o2_phase(a, W, gw, lane); }
DI void P_o3(KP kp_, int li) { li = UNI(li); const int wpar_ = 0; PHASE_SETUP o3_phase(a, li, lds, tid, wave, lane, bid, G); }
DI void P_xattn(KP kp_) { const int wpar_ = 0; PHASE_SETUP xattn_phase(a, lds, tid, wave, lane, bid, G); }

DI void grid_bar(KP kp_) {
    asm volatile("" : "+s"(kp_));
    XcdBarrier b; b.bar = (unsigned*)(kp_->ws + WS_CTL) + 4096 + kp_->li * XCD_BAR_WORDS; b.x = xb_xcc_id(); b.st = (volatile LAS unsigned*)((LAS unsigned char*)lds_raw + LDSCTL_OFF) + 8;
    xcd_barrier(b);
}
__global__ void __launch_bounds__(512, 2) fwd_kernel(KArgs ka) {
    KP kp = (KP)__builtin_amdgcn_kernarg_segment_ptr();
    {
        LAS unsigned char* lds = (LAS unsigned char*)lds_raw;
        volatile LAS unsigned* MISC = (volatile LAS unsigned*)(lds + LDSCTL_OFF);
        for (int u = threadIdx.x; u < 128; u += 512) MISC[u] = 0u;
        __syncthreads();
        if (ka.ph_hi - ka.ph_lo > 1) (void)xcd_barrier_post((unsigned*)(ka.ws + WS_CTL) + 4096 + ka.li * XCD_BAR_WORDS, MISC + 8);
    }
#define DUP(bit, call) call; if (DUP_MASK & (1 << (bit))) { call; }
#define PH(id, ...) { KP k_ = kp; asm volatile("" : "+s"(k_)); const int lo_ = k_->ph_lo, hi_ = k_->ph_hi; if (lo_ <= (id) && (id) < hi_) { __VA_ARGS__; if ((id) + 1 < hi_) { grid_bar(kp); if (DUP_MASK & 32768) grid_bar(kp); } } }
    for (int layer = 0; layer < DEPTH; ++layer) {
        const int base = layer * PH_PER_LAYER, li = layer >> 1; const bool odd = (layer & 1) != 0;
        if (layer == 0 || gridDim.x != 256) { PH(base + 0, DUP(9, P_prologue(kp, layer))) }
        PH(base + 2, P_norm0_kvx(kp, layer))
        PH(base + 3, DUP(1, P_gemm_swiglu(kp, 0, layer)))
        PH(base + 4, P_gemm_resid(kp, 0, layer == 0 ? 1 : 0, layer))
        PH(base + 5, DUP(0, P_norm(kp, layer, 1)))
        if (!odd) {
            PH(base + 6, DUP(2, P_gemm_bf16(kp, 2, layer)))
            PH(base + 7, P_e0(kp, li))
            PH(base + 8, DUP(3, P_e1(kp)))
            PH(base + 9, DUP(4, P_e2(kp)))
            PH(base + 10, DUP(5, P_e3(kp, li)))
            PH(base + 11, DUP(6, P_e4(kp, li)))
        } else {
            PH(base + 6, DUP(2, P_gemm_bf16(kp, 3, layer)); DUP(2, P_gemm_bf16(kp, 4, layer)))
            PH(base + 7, DUP(7, P_gemm_cmp(kp, layer)))
            PH(base + 8, DUP(7, P_o2(kp, layer)))
            PH(base + 9, DUP(8, P_o3(kp, li)))
        }
        PH(base + 12, P_gemm_resid(kp, 2, 0, layer))
        PH(base + 13, DUP(0, P_norm(kp, layer, 2)))
        PH(base + 14, DUP(2, P_gemm_bf16(kp, 5, layer)))
        PH(base + 15, DUP(11, P_xattn(kp)))
        PH(base + 16, P_gemm_resid(kp, 3, 0, layer))
        PH(base + 17, DUP(0, P_norm(kp, layer, 3)))
        PH(base + 18, DUP(1, P_gemm_swiglu(kp, 1, layer)))
        PH(base + 19, P_gemm_resid(kp, 1, 0, layer))
    }
    PH(PH_FINAL, DUP(10, P_final(kp)))
#undef PH
}

extern "C" void kernel_launch(void* const* d_in, const int* in_sizes, int n_in, void* d_out, int out_size, void* d_ws, size_t ws_size, hipStream_t stream) {
    static int grid = 0;
    if (grid == 0) {
        if (n_in != 25 || out_size != MTOK * DM || ws_size < WS_END) { fprintf(stderr, "kernel_launch: unexpected problem (n_in %d, out %d, ws %zu < %zu)\n", n_in, out_size, ws_size, (size_t)WS_END); grid = -1; return; }
        int dev = 0, cus = 0, per_cu = 0;
        if (hipGetDevice(&dev) != hipSuccess || hipDeviceGetAttribute(&cus, hipDeviceAttributeMultiprocessorCount, dev) != hipSuccess) { grid = -1; return; }
        if (hipFuncSetAttribute((const void*)fwd_kernel, hipFuncAttributeMaxDynamicSharedMemorySize, LDS_BYTES) != hipSuccess) { fprintf(stderr, "kernel_launch: hipFuncSetAttribute failed\n"); grid = -1; return; }
        if (hipOccupancyMaxActiveBlocksPerMultiprocessor(&per_cu, (const void*)fwd_kernel, 512, LDS_BYTES) != hipSuccess || per_cu < 1) fprintf(stderr, "kernel_launch: occupancy query says %d\n", per_cu);
        (void)hipGetLastError();
        grid = cus;
    }
    if (grid < 0) return;
    (void)hipMemsetAsync((char*)d_ws + WS_CTL, 0, CTL_ZERO_BYTES, stream);
    KArgs a{};
    for (int i = 0; i < 25; ++i) a.in[i] = (const float*)d_in[i];
    a.out = (float*)d_out; a.ws = (unsigned char*)d_ws; a.pad = 0;
#if MK_MODE == 1
    a.ph_lo = 0; a.ph_hi = PH_TOTAL; a.li = 0;
    hipLaunchKernelGGL(fwd_kernel, dim3(grid), dim3(512), LDS_BYTES, stream, a);
#else
    for (int p = 0; p < PH_TOTAL; ++p) { const int l = p % PH_PER_LAYER; if (p < PH_FINAL && (((p / PH_PER_LAYER) & 1) != 0) && (l == 10 || l == 11)) continue;
        a.ph_lo = p; a.ph_hi = p + 1; a.li = 0;
        hipLaunchKernelGGL(fwd_kernel, dim3(grid), dim3(512), LDS_BYTES, stream, a); }
#endif
}
```

```cpp
#include <hip/hip_runtime.h>
#include <cstdio>
#include <cstdint>

#define DI __device__ __forceinline__
#define LAS __attribute__((address_space(3)))
#define GAS __attribute__((address_space(1)))
typedef unsigned short bf16_t;
typedef short bf16x8 __attribute__((ext_vector_type(8)));
typedef float f32x4 __attribute__((ext_vector_type(4)));
typedef float f32x2 __attribute__((ext_vector_type(2)));
typedef unsigned u32x4 __attribute__((ext_vector_type(4)));
typedef unsigned u32x2 __attribute__((ext_vector_type(2)));
typedef __bf16 bf16x2_t __attribute__((ext_vector_type(2)));

#ifndef DUP_MASK
#define DUP_MASK 0
#endif
constexpr int DM = 1024, NB = 4, SEQ = 4096, MTOK = NB * SEQ, DEPTH = 4, FF = 2816, MEMLEN = 256;
constexpr int EV_IN = 3336, EV_PITCH = 3584;
constexpr int OD_IN = 2072, OD_PITCH = 1792;
constexpr float EPS = 1e-6f;
constexpr float LOG2E = 1.4426950408889634f;

constexpr size_t MiB = 1u << 20;
constexpr size_t WS_CTL = 0, CTL_ZERO_BYTES = 1 * MiB;
constexpr size_t WS_COS = 1 * MiB, WS_SIN = 2 * MiB;
constexpr size_t WS_MEMN = 3 * MiB;
constexpr size_t WS_KX = 5 * MiB, WS_VTX = 7 * MiB;
constexpr size_t WS_BIAS1 = 9 * MiB;
constexpr size_t WS_W = 10 * MiB;
constexpr size_t W_GU = 0, W_D = 22 * MiB, W_XQ = 33 * MiB, W_XKV = 35 * MiB, W_XO = 39 * MiB, W_IN = 41 * MiB, W_OUT = 48 * MiB, W_C1 = 50 * MiB, W_C2 = 52 * MiB;
constexpr size_t WS_X = 64 * MiB;
constexpr size_t WS_H = 128 * MiB;
constexpr size_t WS_R = 160 * MiB;
constexpr size_t R_HID = 0;
constexpr size_t R_Q = 0;
constexpr size_t R_PROJ = 0;
constexpr size_t R_CONV = 112 * MiB, R_XDT = 136 * MiB, R_STR = 152 * MiB, R_STS = 184 * MiB, R_SINR = 200 * MiB, R_SINS = 216 * MiB, R_YP = 224 * MiB, R_CUMS = 240 * MiB;
constexpr size_t R_VT = 56 * MiB, R_HIDC = 72 * MiB, R_KC = 74 * MiB, R_VCT = 75 * MiB;
constexpr size_t WS_W2 = 402 * MiB;
constexpr size_t WS_END = 455 * MiB;

constexpr int LDS_BYTES = 147456;
constexpr int LDSCTL_OFF = 147456 - 512;

DI unsigned pk2(float lo, float hi) { f32x2 v = {lo, hi}; bf16x2_t b = __builtin_convertvector(v, bf16x2_t); return __builtin_bit_cast(unsigned, b); }
DI bf16_t f2bf(float f) { return (bf16_t)(pk2(f, 0.f) & 0xffffu); }
DI float bf2f(unsigned h) { return __uint_as_float((h & 0xffffu) << 16); }
DI float bflo(unsigned w) { return __uint_as_float(w << 16); }
DI float bfhi(unsigned w) { return __uint_as_float(w & 0xffff0000u); }
DI float silu_f(float x) { return x * __builtin_amdgcn_rcpf(1.f + __builtin_amdgcn_exp2f(-LOG2E * x)); }
DI float sigmoid_f(float x) { return __builtin_amdgcn_rcpf(1.f + __builtin_amdgcn_exp2f(-LOG2E * x)); }
DI float ex2(float x) { return __builtin_amdgcn_exp2f(x); }
DI f32x4 mfma16(bf16x8 a, bf16x8 b, f32x4 c) { return __builtin_amdgcn_mfma_f32_16x16x32_bf16(a, b, c, 0, 0, 0); }
DI float wave_sum(float v) {
#pragma unroll
    for (int o = 1; o < 64; o <<= 1) v += __shfl_xor(v, o);
    return v;
}
DI float grp16_sum(float v) { v += __shfl_xor(v, 1); v += __shfl_xor(v, 2); v += __shfl_xor(v, 4); v += __shfl_xor(v, 8); return v; }
DI float grp16_max(float v) { v = fmaxf(v, __shfl_xor(v, 1)); v = fmaxf(v, __shfl_xor(v, 2)); v = fmaxf(v, __shfl_xor(v, 4)); v = fmaxf(v, __shfl_xor(v, 8)); return v; }
#define LDS_WAIT() asm volatile("s_waitcnt lgkmcnt(0)" ::: "memory")
#define VM_WAIT() asm volatile("s_waitcnt vmcnt(0)" ::: "memory")

#define XB_TMO      128
#define XB_XCNT(j)  (256  + 64 * (j))
#define XB_XSUB(j)  (1280 + 64 * (j))
#define XB_XGEN(j)  (2304 + 64 * (j))
#define XB_TOP      3328
#define XB_TOPGEN   3392
#define XCD_BAR_WORDS 3456
#define XB_SPIN_CAP (1u << 18)
DI unsigned xb_ld(unsigned* p)              { return __hip_atomic_load(p, __ATOMIC_RELAXED, __HIP_MEMORY_SCOPE_AGENT); }
DI unsigned xb_add(unsigned* p, unsigned v) { return __hip_atomic_fetch_add(p, v, __ATOMIC_RELAXED, __HIP_MEMORY_SCOPE_AGENT); }
DI unsigned xb_xcc_id() { return (unsigned)__builtin_amdgcn_s_getreg((3 << 11) | 20) & 0xFu; }
#define XB_SPIN(cond, bar) do { unsigned _sp = 0; while (cond) { __builtin_amdgcn_s_sleep(1); \
    if ((++_sp & 255u) == 0u) { if (xb_ld(&(bar)[XB_TMO])) break; if (_sp > XB_SPIN_CAP) { atomicAdd(&(bar)[XB_TMO], 1u); break; } } } } while (0)
struct XcdBarrier { unsigned* bar; unsigned x; volatile LAS unsigned* st; };
DI XcdBarrier xcd_barrier_post(unsigned* bar, volatile LAS unsigned* st) {
    XcdBarrier b; b.bar = bar; b.x = xb_xcc_id(); b.st = st;
    if (threadIdx.x == 0) (void)xb_add(&bar[XB_XCNT(b.x)], 1u);
    return b;
}
DI void xcd_barrier_complete(unsigned* bar, unsigned x, unsigned& nloc, unsigned& nx) {
    const unsigned G = gridDim.x * gridDim.y * gridDim.z;
    unsigned sum, cnt, mine, sp = 0u;
    for (;;) {
        sum = 0u; cnt = 0u; mine = 0u;
#pragma unroll
        for (unsigned j = 0; j < 16; ++j) { const unsigned c = xb_ld(&bar[XB_XCNT(j)]); sum += c; cnt += (c > 0u) ? 1u : 0u; mine = (j == x) ? c : mine; }
        if (sum == G) break;
        __builtin_amdgcn_s_sleep(1);
        if ((++sp & 255u) == 0u) { if (xb_ld(&bar[XB_TMO])) break; if (sp > XB_SPIN_CAP) { atomicAdd(&bar[XB_TMO], 1u); break; } }
    }
    nloc = mine > 0u ? mine : 1u; nx = cnt > 0u ? cnt : 1u;
}
DI void xcd_barrier(const XcdBarrier& b) {
    asm volatile("s_waitcnt vmcnt(0)" ::: "memory");
    __syncthreads();
    if (threadIdx.x == 0) {
        unsigned* bar = b.bar;
        __builtin_amdgcn_s_waitcnt(0);
        unsigned nloc = b.st[0], nx = b.st[1];
        if (nloc == 0u) { xcd_barrier_complete(bar, b.x, nloc, nx); b.st[0] = nloc; b.st[1] = nx; }
        const unsigned old = xb_add(&bar[XB_XSUB(b.x)], 1u);
        const unsigned gen = old / nloc;
        if (old + 1u == (gen + 1u) * nloc) {
            __builtin_amdgcn_fence(__ATOMIC_RELEASE, "agent");
            asm volatile("s_waitcnt vmcnt(0)" ::: "memory");
            const unsigned og = xb_add(&bar[XB_TOP], 1u);
            const unsigned tg = og / nx;
            if (og + 1u == (tg + 1u) * nx) xb_add(&bar[XB_TOPGEN], 1u);
            else XB_SPIN(xb_ld(&bar[XB_TOPGEN]) == tg, bar);
            __builtin_amdgcn_fence(__ATOMIC_ACQUIRE, "agent");
            xb_add(&bar[XB_XGEN(b.x)], 1u);
            asm volatile("s_waitcnt vmcnt(0)" ::: "memory");
        } else {
            XB_SPIN(xb_ld(&bar[XB_XGEN(b.x)]) == gen, bar);
            __builtin_amdgcn_fence(__ATOMIC_ACQUIRE, "agent");
            asm volatile("s_waitcnt vmcnt(0)" ::: "memory");
        }
    }
    __syncthreads();
}

namespace pg8 {
constexpr int BM = 256, BK = 64, HALF = 128, HTB = HALF * BK * 2, STAGE_BYTES = 8 * HTB, NXCD = 8, WGM = 8;
__host__ __device__ __forceinline__ int lds_byte(int r, int c) { const int st = (r >> 4) * 2 + (c >> 5), rr = r & 15, cc = c & 31, ob = rr * 64 + cc * 2; return st * 1024 + (ob ^ (((ob >> 9) & 1) << 5)); }
__host__ __device__ __forceinline__ void stage_rc(int b, int& R, int& C) { const int st = b / 1024, sb = b % 1024, swz = sb ^ (((sb >> 9) & 1) << 5); R = (st >> 1) * 16 + swz / 64; C = (st & 1) * 32 + (swz % 64) / 2; }
__host__ __device__ __forceinline__ int perm32(int rho) { const int n = rho >> 4, i = rho & 15; return 8 * (i >> 2) + 4 * n + (i & 3); }

struct Unit { int pm, pn; const char* a; const char* b; };
struct Gemm { const bf16_t* A; const bf16_t* Bt; int lda, ldb, kstepA, kstepB, K; };

struct StaticOrder {
    int nM, nN, nwg, G, c; const char* A; const char* B; size_t tA, tB;
    DI void init(const Gemm& g, int M, int N, int G_, int c_) { nM = M / BM; nN = N / BM; nwg = nM * nN; G = G_; c = c_; A = (const char*)g.A; B = (const char*)g.Bt; tA = (size_t)BM * g.lda * 2; tB = (size_t)BM * g.ldb * 2; }
    DI bool next(int i, Unit& u) const {
        const int L = i * G + c; if (L >= nwg) return false;
        int wgid = L; { const int q = nwg / NXCD, r = nwg % NXCD, xcd = wgid % NXCD, off = wgid / NXCD; wgid = (xcd < r ? xcd * (q + 1) : r * (q + 1) + (xcd - r) * q) + off; }
        const int nig = WGM * nN, gid = wgid / nig, fm = gid * WGM, gsz = (nM - fm) < WGM ? (nM - fm) : WGM;
        u.pm = fm + ((wgid % nig) % gsz); u.pn = (wgid % nig) / gsz; u.a = A + (size_t)u.pm * tA; u.b = B + (size_t)u.pn * tB; return true;
    }
};

DI unsigned cvt_pk_bf16(float lo, float hi) { return pk2(lo, hi); }

template <int ACT> struct EpiBf16 {
    static constexpr bool PERM = true;
    bf16_t* O; int ldc; const float* bias; int cmp_mode;
    DI void operator()(const f32x4 (&acc)[2][2][4][2], const Unit& u, int wr, int wc, int fr, int fq) const {
        const int rt = cmp_mode ? (u.pn * 8 + u.pm) : u.pm, ct = cmp_mode ? 0 : u.pn;
        const int row0 = rt * BM + wr * 64 + fr; const int col0 = ct * BM + wc * 32 + 8 * fq;
        f32x4 bv[2][2];
#pragma unroll
        for (int bj = 0; bj < 2; ++bj)
#pragma unroll
            for (int n = 0; n < 2; ++n) bv[bj][n] = bias ? *(const f32x4*)(bias + u.pn * BM + (wc * 32 + 8 * fq) + bj * HALF + 4 * n) : (f32x4){0.f, 0.f, 0.f, 0.f};
#pragma unroll
        for (int ai = 0; ai < 2; ++ai)
#pragma unroll
            for (int m = 0; m < 4; ++m) { bf16_t* rowp = O + (size_t)(row0 + ai * HALF + m * 16) * ldc + col0;
#pragma unroll
                for (int bj = 0; bj < 2; ++bj) { f32x4 v0 = acc[ai][bj][m][0] + bv[bj][0], v1 = acc[ai][bj][m][1] + bv[bj][1];
                    if (ACT == 2) { v0 = (f32x4){silu_f(v0[0]), silu_f(v0[1]), silu_f(v0[2]), silu_f(v0[3])}; v1 = (f32x4){silu_f(v1[0]), silu_f(v1[1]), silu_f(v1[2]), silu_f(v1[3])}; }
                    u32x4 w; w.x = cvt_pk_bf16(v0[0], v0[1]); w.y = cvt_pk_bf16(v0[2], v0[3]); w.z = cvt_pk_bf16(v1[0], v1[1]); w.w = cvt_pk_bf16(v1[2], v1[3]);
                    *(u32x4*)(rowp + bj * HALF) = w; } }
    }
};
struct EpiSwiGLU {
    static constexpr bool PERM = true;
    bf16_t* O; int ldc;
    DI void operator()(const f32x4 (&acc)[2][2][4][2], const Unit& u, int wr, int wc, int fr, int fq) const {
        const int row0 = u.pm * BM + wr * 64 + fr; const int col0 = u.pn * HALF + wc * 32 + 8 * fq;
#pragma unroll
        for (int ai = 0; ai < 2; ++ai)
#pragma unroll
            for (int m = 0; m < 4; ++m) { bf16_t* rowp = O + (size_t)(row0 + ai * HALF + m * 16) * ldc + col0;
                const f32x4 g0 = acc[ai][0][m][0], g1 = acc[ai][0][m][1], u0 = acc[ai][1][m][0], u1 = acc[ai][1][m][1];
                u32x4 w; w.x = cvt_pk_bf16(silu_f(g0[0]) * u0[0], silu_f(g0[1]) * u0[1]); w.y = cvt_pk_bf16(silu_f(g0[2]) * u0[2], silu_f(g0[3]) * u0[3]);
                w.z = cvt_pk_bf16(silu_f(g1[0]) * u1[0], silu_f(g1[1]) * u1[1]); w.w = cvt_pk_bf16(silu_f(g1[2]) * u1[2], silu_f(g1[3]) * u1[3]);
                *(u32x4*)rowp = w; }
    }
};
struct EpiResid {
    static constexpr bool PERM = false;
    const float* base; float* out; float scale;
    DI void operator()(const f32x4 (&acc)[2][2][4][2], const Unit& u, int wr, int wc, int fr, int fq) const {
        const int col0 = u.pn * BM + wc * 32 + 4 * fq;
#pragma unroll
        for (int ai = 0; ai < 2; ++ai)
#pragma unroll
            for (int m = 0; m < 4; ++m) { const size_t off = (size_t)(u.pm * BM + ai * HALF + wr * 64 + m * 16 + fr) * DM + col0;
#pragma unroll
                for (int bj = 0; bj < 2; ++bj)
#pragma unroll
                    for (int n = 0; n < 2; ++n) { const f32x4 bs = *(const f32x4*)(base + off + bj * HALF + n * 16); *(f32x4*)(out + off + bj * HALF + n * 16) = bs + acc[ai][bj][m][n] * scale; } }
    }
};

template <class Epi, class Sched>
DI void gemm_phase(LAS unsigned char* lds, const Gemm g, const Sched& S, const Epi& E, const int tid) {
    const int wid = __builtin_amdgcn_readfirstlane(tid >> 6), lane = tid & 63, wr = wid >> 2, wc = wid & 3, fr = lane & 15, fq = lane >> 4;
    const int K = g.K, nt = K / BK;
    unsigned voffA[2], voffB[2];
#pragma unroll
    for (int i = 0; i < 2; ++i) { int R, C; stage_rc(tid * 16 + i * 8192, R, C); const int Rb = Epi::PERM ? ((R & ~31) + perm32(R & 31)) : R;
        voffA[i] = (unsigned)(R * g.lda + C) * 2u; voffB[i] = (unsigned)(Rb * g.ldb + C) * 2u; }
    const size_t kA = (size_t)g.kstepA, kB = (size_t)g.kstepB;
    const size_t hA = (size_t)HALF * g.lda * 2, hB = (size_t)HALF * g.ldb * 2;
    const unsigned ldsw = (unsigned)wid * 1024u;
    const int aoff = lds_byte(wr * 64 + fr, fq * 8), boff = lds_byte(wc * 32 + fr, fq * 8);
#define PG8_SA(b, h) (((b) * 2 + (h)) * HTB)
#define PG8_SB(b, h) ((4 + (b) * 2 + (h)) * HTB)
#define PG8_STAGE(bufoff, gbase, voff) do { _Pragma("unroll") for (int _i = 0; _i < 2; ++_i) \
        __builtin_amdgcn_global_load_lds((const unsigned*)((const char*)(gbase) + (voff)[_i]), (LAS unsigned*)(lds + (bufoff) + ldsw + _i * 8192), 16, 0, 0); } while (0)
#define PG8_LDA(dst, b, h) do { _Pragma("unroll") for (int m = 0; m < 4; ++m) _Pragma("unroll") for (int k = 0; k < 2; ++k) dst[m][k] = *(const LAS bf16x8*)(lds + PG8_SA(b, h) + aoff + m * 2048 + k * 1024); } while (0)
#define PG8_LDB(dst, b, h) do { _Pragma("unroll") for (int n = 0; n < 2; ++n) _Pragma("unroll") for (int k = 0; k < 2; ++k) dst[n][k] = *(const LAS bf16x8*)(lds + PG8_SB(b, h) + boff + n * 2048 + k * 1024); } while (0)
#define PG8_MMA(ai, bj, At, Bt) do { __builtin_amdgcn_s_setprio(1); _Pragma("unroll") for (int m = 0; m < 4; ++m) _Pragma("unroll") for (int n = 0; n < 2; ++n) _Pragma("unroll") for (int k = 0; k < 2; ++k) \
        acc[ai][bj][m][n] = __builtin_amdgcn_mfma_f32_16x16x32_bf16(Bt[n][k], At[m][k], acc[ai][bj][m][n], 0, 0, 0); __builtin_amdgcn_s_setprio(0); } while (0)
#define PG8_WAIT_V(n) asm volatile("s_waitcnt vmcnt(" #n ")" ::: "memory")
#define PG8_WAIT_L(n) asm volatile("s_waitcnt lgkmcnt(" #n ")" ::: "memory")
#define PG8_BAR __builtin_amdgcn_s_barrier()
#define PG8_SCHED __builtin_amdgcn_sched_barrier(0)
    Unit cur, nxt; int ui = 0;
    if (!S.next(0, cur)) return;
    f32x4 acc[2][2][4][2];
#pragma unroll
    for (int a = 0; a < 2; ++a)
#pragma unroll
        for (int b = 0; b < 2; ++b)
#pragma unroll
            for (int m = 0; m < 4; ++m)
#pragma unroll
                for (int n = 0; n < 2; ++n) acc[a][b][m][n] = (f32x4){0.f, 0.f, 0.f, 0.f};
    bf16x8 At[4][2], B0[2][2], B1[2][2];
    const char* cA = cur.a; const char* cB = cur.b;
    PG8_STAGE(PG8_SB(0, 0), cB, voffB); PG8_STAGE(PG8_SB(0, 1), cB + hB, voffB); PG8_STAGE(PG8_SA(0, 0), cA, voffA); PG8_STAGE(PG8_SA(0, 1), cA + hA, voffA);
    if (wr == 1) PG8_BAR;
    PG8_WAIT_V(2); PG8_BAR;
    PG8_STAGE(PG8_SB(1, 0), cB + kB, voffB); PG8_STAGE(PG8_SA(1, 0), cA + kA, voffA); PG8_STAGE(PG8_SB(1, 1), cB + hB + kB, voffB);
    PG8_WAIT_V(6); PG8_BAR;
    for (;;) {
        const bool has_next = S.next(ui + 1, nxt);
        const char* nA = has_next ? nxt.a : cA; const char* nB = has_next ? nxt.b : cB;
        for (int t = 0; t < nt; t += 2) {
            const bool last = (t == nt - 2);
            const char* a1 = cA + (size_t)(t + 1) * kA;
            const char* a2 = last ? nA : cA + (size_t)(t + 2) * kA; const char* b2 = last ? nB : cB + (size_t)(t + 2) * kB;
            const char* a3 = a2 + kA; const char* b3 = b2 + kB;
            PG8_LDB(B0, 0, 0); PG8_LDB(B1, 0, 1); PG8_SCHED; PG8_LDA(At, 0, 0); PG8_STAGE(PG8_SA(1, 1), a1 + hA, voffA);
            PG8_WAIT_V(8); PG8_WAIT_L(0); PG8_BAR; PG8_MMA(0, 0, At, B0); PG8_MMA(0, 1, At, B1); PG8_BAR; PG8_SCHED;
            PG8_LDA(At, 0, 1); PG8_STAGE(PG8_SB(0, 0), b2, voffB); PG8_STAGE(PG8_SB(0, 1), b2 + hB, voffB); PG8_STAGE(PG8_SA(0, 0), a2, voffA);
            PG8_WAIT_V(8); PG8_WAIT_L(0); PG8_BAR; PG8_MMA(1, 0, At, B0); PG8_MMA(1, 1, At, B1); PG8_BAR; PG8_SCHED;
            PG8_LDB(B0, 1, 0); PG8_LDB(B1, 1, 1); PG8_SCHED; PG8_LDA(At, 1, 0); PG8_STAGE(PG8_SA(0, 1), a2 + hA, voffA);
            PG8_WAIT_V(8); PG8_WAIT_L(0); PG8_BAR; PG8_MMA(0, 0, At, B0); PG8_MMA(0, 1, At, B1); PG8_BAR; PG8_SCHED;
            PG8_LDA(At, 1, 1); PG8_STAGE(PG8_SB(1, 0), b3, voffB); PG8_STAGE(PG8_SB(1, 1), b3 + hB, voffB); PG8_STAGE(PG8_SA(1, 0), a3, voffA);
            PG8_WAIT_V(8); PG8_WAIT_L(0); PG8_BAR; PG8_MMA(1, 0, At, B0); PG8_MMA(1, 1, At, B1); PG8_BAR; PG8_SCHED;
        }
        if (wr == 0) PG8_BAR;
        E(acc, cur, wr, wc, fr, fq);
        if (!has_next) break;
#pragma unroll
        for (int a = 0; a < 2; ++a)
#pragma unroll
            for (int b = 0; b < 2; ++b)
#pragma unroll
                for (int m = 0; m < 4; ++m)
#pragma unroll
                    for (int n = 0; n < 2; ++n) acc[a][b][m][n] = (f32x4){0.f, 0.f, 0.f, 0.f};
        cur = nxt; cA = nA; cB = nB; ++ui;
        if (wr == 1) PG8_BAR;
    }
    PG8_WAIT_V(0);
    PG8_BAR;
#undef PG8_SA
#undef PG8_SB
#undef PG8_STAGE
#undef PG8_LDA
#undef PG8_LDB
#undef PG8_MMA
#undef PG8_WAIT_V
#undef PG8_WAIT_L
#undef PG8_BAR
#undef PG8_SCHED
}
}

struct Args { const float* in[25]; float* out; unsigned char* ws; int ph_lo, ph_hi; };
struct KArgs { const float* in[25]; float* out; unsigned char* ws; int ph_lo, ph_hi, li, pad; };
typedef const KArgs __attribute__((address_space(4)))* KP;
enum { I_X = 0, I_MEM, I_NORMW, I_FNORMW, I_MNORMW, I_WG, I_WU, I_WD, I_XWQ, I_XWKV, I_XWO, I_EWIN, I_EWOUT, I_CONVW, I_CONVB, I_DTB, I_ALOG, I_SSMD, I_SSMNW, I_OWIN, I_OWOUT, I_CPE, I_CW1, I_CW2, I_SINKS };


__device__ const float INVF[64] = {1.000000000e+00f, 8.639885187e-01f, 7.464760542e-01f, 6.449466944e-01f, 5.572264791e-01f, 4.814372659e-01f, 4.159561992e-01f, 3.593813777e-01f, 3.105013072e-01f, 2.682695687e-01f, 2.317818254e-01f, 2.002568096e-01f, 1.730195731e-01f, 1.494869143e-01f, 1.291549653e-01f, 1.115884036e-01f, 9.641107917e-02f, 8.329805732e-02f, 7.196855545e-02f, 6.218000501e-02f, 5.372281000e-02f, 4.641588405e-02f, 4.010278732e-02f, 3.464834765e-02f, 2.993576974e-02f, 2.586415969e-02f, 2.234633639e-02f, 1.930697635e-02f, 1.668100618e-02f, 1.441219542e-02f, 1.245197095e-02f, 1.075835899e-02f, 9.295095690e-03f, 8.030855097e-03f, 6.938566454e-03f, 5.994840525e-03f, 5.179473199e-03f, 4.475005437e-03f, 3.866353072e-03f, 3.340484342e-03f, 2.886139555e-03f, 2.493591513e-03f, 2.154434333e-03f, 1.861406374e-03f, 1.608233666e-03f, 1.389495214e-03f, 1.200507861e-03f, 1.037224894e-03f, 8.961504791e-04f, 7.742635789e-04f, 6.689548027e-04f, 5.779692437e-04f, 4.993587499e-04f, 4.314401885e-04f, 3.727593285e-04f, 3.220597573e-04f, 2.782559313e-04f, 2.404098923e-04f, 2.077113895e-04f, 1.794602285e-04f, 1.550515735e-04f, 1.339627634e-04f, 1.157422957e-04f, 9.999999747e-05f};
DI void sincos_acc(float x, float& s, float& c) {
    const float kf = __builtin_rintf(x * 0.636619772367581343f); const int k = (int)kf;
    float r = __builtin_fmaf(-kf, 1.57079637050628662109375f, x); r = __builtin_fmaf(-kf, -4.37113900018624283e-8f, r);
    const float r2 = r * r;
    const float sp = r + r * r2 * (-1.0f / 6.0f + r2 * (1.0f / 120.0f + r2 * (-1.0f / 5040.0f + r2 * (1.0f / 362880.0f))));
    const float cp = 1.0f + r2 * (-0.5f + r2 * (1.0f / 24.0f + r2 * (-1.0f / 720.0f + r2 * (1.0f / 40320.0f + r2 * (-1.0f / 3628800.0f)))));
    const int q = k & 3;
    s = (q == 0) ? sp : (q == 1) ? cp : (q == 2) ? -sp : -cp;
    c = (q == 0) ? cp : (q == 1) ? -sp : (q == 2) ? -cp : sp;
}

#define JNO (1 << 20)
constexpr int NJ_EVEN = 11, NJ_ODD = 25;
__device__ const int JT_EVEN[NJ_EVEN][12] = {
    {I_WG, 2 * DM * FF, 0, 0, FF, DM, 0, FF, (int)W_GU, 128, 256, 0}, {I_WU, 2 * DM * FF, 0, 0, FF, DM, 0, FF, (int)W_GU, 128, 256, 128}, {I_WD, 2 * DM * FF, 0, 0, DM, FF, 0, DM, (int)W_D, JNO, 0, 0},
    {I_WG, 2 * DM * FF, 0, DM * FF, FF, DM, 0, FF, (int)(W_GU + 4 * FF * DM), 128, 256, 0}, {I_WU, 2 * DM * FF, 0, DM * FF, FF, DM, 0, FF, (int)(W_GU + 4 * FF * DM), 128, 256, 128}, {I_WD, 2 * DM * FF, 0, DM * FF, DM, FF, 0, DM, (int)(W_D + 2 * DM * FF), JNO, 0, 0},
    {I_XWQ, DM * DM, 0, 0, DM, DM, 0, DM, (int)W_XQ, JNO, 0, 0}, {I_XWKV, 2 * DM * DM, 0, 0, 2 * DM, DM, 0, 2 * DM, (int)W_XKV, JNO, 0, 0}, {I_XWO, DM * DM, 0, 0, DM, DM, 0, DM, (int)W_XO, JNO, 0, 0},
    {I_EWIN, 0, DM * EV_IN, 0, EV_IN, DM, 0, EV_IN, (int)W_IN, JNO, 0, 0}, {I_EWOUT, 0, DM * DM, 0, DM, DM, 0, DM, (int)W_OUT, JNO, 0, 0} };
__device__ const int JT_ODD[NJ_ODD][12] = {
    {I_WG, 2 * DM * FF, 0, 0, FF, DM, 0, FF, (int)W_GU, 128, 256, 0}, {I_WU, 2 * DM * FF, 0, 0, FF, DM, 0, FF, (int)W_GU, 128, 256, 128}, {I_WD, 2 * DM * FF, 0, 0, DM, FF, 0, DM, (int)W_D, JNO, 0, 0},
    {I_WG, 2 * DM * FF, 0, DM * FF, FF, DM, 0, FF, (int)(W_GU + 4 * FF * DM), 128, 256, 0}, {I_WU, 2 * DM * FF, 0, DM * FF, FF, DM, 0, FF, (int)(W_GU + 4 * FF * DM), 128, 256, 128}, {I_WD, 2 * DM * FF, 0, DM * FF, DM, FF, 0, DM, (int)(W_D + 2 * DM * FF), JNO, 0, 0},
    {I_XWQ, DM * DM, 0, 0, DM, DM, 0, DM, (int)W_XQ, JNO, 0, 0}, {I_XWKV, 2 * DM * DM, 0, 0, 2 * DM, DM, 0, 2 * DM, (int)W_XKV, JNO, 0, 0}, {I_XWO, DM * DM, 0, 0, DM, DM, 0, DM, (int)W_XO, JNO, 0, 0},
    {I_OWIN, 0, DM * OD_IN, 0, OD_IN, DM, 0, 512, (int)W_IN, JNO, 0, 0}, {I_OWIN, 0, DM * OD_IN, 0, OD_IN, DM, 512, 128, (int)W_IN, JNO, 0, 512}, {I_OWIN, 0, DM * OD_IN, 0, OD_IN, DM, 640, 128, (int)W_IN, JNO, 0, 640},
    {I_OWIN, 0, DM * OD_IN, 0, OD_IN, DM, 768, 128, (int)W_IN, JNO, 0, 768}, {I_OWIN, 0, DM * OD_IN, 0, OD_IN, DM, 1024, 128, (int)W_IN, JNO, 0, 896}, {I_OWIN, 0, DM * OD_IN, 0, OD_IN, DM, 1816, 128, (int)W_IN, JNO, 0, 1024},
    {I_OWIN, 0, DM * OD_IN, 0, OD_IN, DM, 1304, 512, (int)W_IN, JNO, 0, 1152}, {I_OWIN, 0, DM * OD_IN, 0, OD_IN, DM, 1280, 24, (int)W_IN, JNO, 0, 1664},
    {I_OWIN, 0, DM * OD_IN, 0, OD_IN, DM, 896, 128, (int)(W_IN + 2 * OD_PITCH * DM), JNO, 0, 0}, {I_OWIN, 0, DM * OD_IN, 0, OD_IN, DM, 1152, 128, (int)(W_IN + 2 * OD_PITCH * DM), JNO, 0, 128}, {I_OWIN, 0, DM * OD_IN, 0, OD_IN, DM, 1944, 128, (int)(W_IN + 2 * OD_PITCH * DM), JNO, 0, 256},
    {I_OWOUT, 0, DM * DM, 0, DM, DM, 0, DM, (int)W_OUT, JNO, 0, 0},
    {I_CW1, 0, 2 * 2048 * 256, 0, 256, 2048, 0, 256, (int)W_C1, JNO, 0, 0}, {I_CW1, 0, 2 * 2048 * 256, 2048 * 256, 256, 2048, 0, 256, (int)(W_C1 + 2 * 256 * 2048), JNO, 0, 0},
    {I_CW2, 0, 2 * 256 * 64, 0, 64, 256, 0, 64, (int)W_C2, JNO, 0, 0}, {I_CW2, 0, 2 * 256 * 64, 256 * 64, 64, 256, 0, 64, (int)(W_C2 + 2 * 64 * 256), JNO, 0, 0} };

DI void transpose_item(const float* src, bf16_t* dst, int ldw, int K, int c0, int ncols, int G, int GS, int off, int nblk, int item, LAS float* scr, int lane) {
    const int kb = item / nblk, nb = item % nblk, k0 = 64 * kb, n0 = 32 * nb;
    const int cl = n0 + (lane & 31); const bool okc = cl < ncols;
    float tv[32];
#pragma unroll
    for (int i = 0; i < 32; ++i) { const int kk = 2 * i + (lane >> 5); tv[i] = okc ? src[(size_t)(k0 + kk) * ldw + c0 + cl] : 0.f; }
#pragma unroll
    for (int i = 0; i < 32; ++i) { const int kk = 2 * i + (lane >> 5); scr[kk * 33 + (lane & 31)] = tv[i]; }
    LDS_WAIT(); asm volatile("" ::: "memory");
    const int c = lane & 7;
#pragma unroll
    for (int j = 0; j < 4; ++j) { const int n = (lane >> 3) + 8 * j; const LAS float* s = scr + (8 * c) * 33 + n;
        u32x4 o; o.x = pk2(s[0 * 33], s[1 * 33]); o.y = pk2(s[2 * 33], s[3 * 33]); o.z = pk2(s[4 * 33], s[5 * 33]); o.w = pk2(s[6 * 33], s[7 * 33]);
        const int cc = n0 + n; const int drow = (cc / G) * GS + off + (cc % G);
        *(u32x4*)(dst + (size_t)drow * K + k0 + 8 * c) = o; }
    LDS_WAIT(); asm volatile("" ::: "memory");
}
constexpr int TAIL_ITEMS = 4232, TAIL_SLOTS = 3;
DI void convert_items(KP kp, const Args& a, int layer, int it_lo, int it_hi, int wi, int nworkers, LAS unsigned char* lds, int tid, int wave, int lane) {
    LAS int* item0 = (LAS int*)(lds + 8 * 8448);
    unsigned char* ws = a.ws; unsigned char* W = ws + ((layer & 1) ? WS_W2 : WS_W); const int li = layer >> 1; const bool odd = (layer & 1) != 0;
    const int nj = odd ? NJ_ODD : NJ_EVEN; const int (*JT)[12] = odd ? JT_ODD : JT_EVEN;
    __syncthreads();
    if (tid == 0) { int items = 0; for (int j = 0; j < nj; ++j) { item0[j] = items; items += ((JT[j][7] + 31) / 32) * (JT[j][5] / 64); } item0[nj] = items; }
    __syncthreads();
    const int nitems = item0[nj] < it_hi ? item0[nj] : it_hi;
    LAS float* scr = (LAS float*)(lds + wave * 8448);
    for (int it = it_lo + wi; it < nitems; it += nworkers) {
        int j = 0;
        while (j + 1 < nj && item0[j + 1] <= it) ++j;
        j = __builtin_amdgcn_readfirstlane(j);
        const int* J = JT[j];
        const float* src = kp->in[J[0]] + ((size_t)layer * J[1] + (size_t)li * J[2] + J[3]);
        transpose_item(src, (bf16_t*)(W + J[8]), J[4], J[5], J[6], J[7], J[9], J[10], J[11], (J[7] + 31) / 32, it - item0[j], scr, lane);
    }
    __syncthreads();
}
DI void cmp_bias1(const Args& a, int layer, int wi, int nworkers, int lane) {
    const int li = layer >> 1; float* bias1 = (float*)(a.ws + WS_BIAS1);
    for (int o = wi; o < 512; o += nworkers) { const int kv = o >> 8, col = o & 255;
        const float* pe = a.in[I_CPE] + (size_t)(li * 2 + kv) * 2048; const float* w1 = a.in[I_CW1] + (size_t)(li * 2 + kv) * 2048 * 256 + col;
        float s = 0.f;
        for (int k = lane; k < 2048; k += 64) s += pe[k] * w1[(size_t)k * 256];
        s = wave_sum(s); if (lane == 0) bias1[o] = s; }
}
DI void layer_prologue(KP kp, const Args& a, int layer, LAS unsigned char* lds, int tid, int wave, int lane, int gw, int NGW) {
    unsigned char* ws = a.ws; const int li = layer >> 1; const bool odd = (layer & 1) != 0;
    convert_items(kp, a, layer, (layer > 0 && NGW == 2048) ? TAIL_SLOTS * TAIL_ITEMS : 0, 1 << 30, gw, NGW, lds, tid, wave, lane);
    if (odd && !(layer > 0 && NGW == 2048)) cmp_bias1(a, layer, gw, NGW, lane);
    if (layer == 0) {
        float* ct = (float*)(ws + WS_COS); float* st = (float*)(ws + WS_SIN);
        const int gt = gw * 64 + lane, NT = NGW * 64;
        for (int e = gt; e < SEQ * 64; e += NT) { const int pos = e >> 6, i = e & 63;
            const float ang = (float)pos * INVF[i];
            float sv, cv; sincos_acc(ang, sv, cv); ct[e] = cv; st[e] = sv; }
        const float* mem = a.in[I_MEM]; const float* mw = a.in[I_MNORMW]; bf16_t* memn = (bf16_t*)(ws + WS_MEMN);
        for (int m = gw; m < NB * MEMLEN; m += NGW) {
            const f32x4* xr = (const f32x4*)(mem + (size_t)m * DM) + lane; f32x4 v[4]; float s = 0.f;
#pragma unroll
            for (int j = 0; j < 4; ++j) { v[j] = xr[64 * j]; s += (v[j].x * v[j].x + v[j].y * v[j].y) + (v[j].z * v[j].z + v[j].w * v[j].w); }
            const float r = 1.0f / sqrtf(wave_sum(s) * (1.f / DM) + EPS);
#pragma unroll
            for (int j = 0; j < 4; ++j) { const f32x4 w = ((const f32x4*)mw)[lane + 64 * j];
                u32x2 o; o.x = pk2(v[j].x * r * w.x, v[j].y * r * w.y); o.y = pk2(v[j].z * r * w.z, v[j].w * r * w.w);
                *(u32x2*)(memn + (size_t)m * DM + 4 * (lane + 64 * j)) = o; }
        }
    }
}

DI void prologue_tail(KP kp, const Args& a, int layer_next, int slot, int b0, int bid, int G, LAS unsigned char* lds, int tid, int wave, int lane) {
    if (G != 256 || layer_next >= DEPTH || bid < b0) return;
    convert_items(kp, a, layer_next, slot * TAIL_ITEMS, (slot + 1) * TAIL_ITEMS, (bid - b0) * 8 + wave, (256 - b0) * 8, lds, tid, wave, lane);
    if (slot == 2 && (layer_next & 1)) cmp_bias1(a, layer_next, (bid - b0) * 8 + wave, (256 - b0) * 8, lane);
}

DI void norm_phase(const float* x, const float* w, bf16_t* h, int gw, int NGW, int lane) {
    f32x4 wv[4];
#pragma unroll
    for (int j = 0; j < 4; ++j) wv[j] = ((const f32x4*)w)[lane + 64 * j];
    for (int m = gw; m < MTOK; m += NGW) {
        const f32x4* xr = (const f32x4*)(x + (size_t)m * DM) + lane; f32x4 v[4]; float s = 0.f;
#pragma unroll
        for (int j = 0; j < 4; ++j) { v[j] = xr[64 * j]; s += (v[j].x * v[j].x + v[j].y * v[j].y) + (v[j].z * v[j].z + v[j].w * v[j].w); }
        const float r = 1.0f / sqrtf(wave_sum(s) * (1.f / DM) + EPS);
#pragma unroll
        for (int j = 0; j < 4; ++j) { u32x2 o; o.x = pk2(v[j].x * r * wv[j].x, v[j].y * r * wv[j].y); o.y = pk2(v[j].z * r * wv[j].z, v[j].w * r * wv[j].w);
            *(u32x2*)(h + (size_t)m * DM + 4 * (lane + 64 * j)) = o; }
    }
}
DI void final_norm_phase(const float* x, const float* w, float* out, int gw, int NGW, int lane) {
    f32x4 wv[4];
#pragma unroll
    for (int j = 0; j < 4; ++j) wv[j] = ((const f32x4*)w)[lane + 64 * j];
    for (int m = gw; m < MTOK; m += NGW) {
        const f32x4* xr = (const f32x4*)(x + (size_t)m * DM) + lane; f32x4 v[4]; float s = 0.f;
#pragma unroll
        for (int j = 0; j < 4; ++j) { v[j] = xr[64 * j]; s += (v[j].x * v[j].x + v[j].y * v[j].y) + (v[j].z * v[j].z + v[j].w * v[j].w); }
        const float r = 1.0f / sqrtf(wave_sum(s) * (1.f / DM) + EPS);
#pragma unroll
        for (int j = 0; j < 4; ++j) ((f32x4*)(out + (size_t)m * DM))[lane + 64 * j] = v[j] * r * wv[j];
    }
}

constexpr int TP = 136;

DI void e0_unit(const Args& a, int li, int unit, LAS unsigned char* lds, int tid, int wave, int lane) {
    unsigned char* R = a.ws + WS_R;
    bf16_t* PROJ = (bf16_t*)(R + R_PROJ); bf16_t* CONV = (bf16_t*)(R + R_CONV); bf16_t* XDT = (bf16_t*)(R + R_XDT); float* CUMS = (float*)(R + R_CUMS);
    const float* COS = (const float*)(a.ws + WS_COS); const float* SIN = (const float*)(a.ws + WS_SIN);
    const int half = unit & 1, c = (unit >> 1) & 31, b = unit >> 6;
    const int crow0 = b * SEQ + c * 128;
    LAS float* dts = (LAS float*)lds;
    LAS float* das = dts + 1024;
    LAS float* cus = das + 1024;
    __syncthreads();
#pragma unroll
    for (int k = 0; k < 2; ++k) { const int idx = tid + 512 * k, l = idx >> 3, hd = idx & 7;
        const float raw = bf2f(PROJ[(size_t)(crow0 + l) * EV_PITCH + 3328 + hd]) + a.in[I_DTB][li * 8 + hd];
        const float dt = raw > 20.f ? raw : log1pf(expf(raw));
        const float av = -expf(a.in[I_ALOG][li * 8 + hd]);
        dts[l * 8 + hd] = dt; das[l * 8 + hd] = dt * av; }
    __syncthreads();
    {
        const float v0 = das[(2 * lane) * 8 + wave], v1 = das[(2 * lane + 1) * 8 + wave]; float s = v0 + v1;
#pragma unroll
        for (int o = 1; o < 64; o <<= 1) { const float t = __shfl_up(s, o); if (lane >= o) s += t; }
        cus[(2 * lane) * 8 + wave] = s - v1; cus[(2 * lane + 1) * 8 + wave] = s; }
    __syncthreads();
    for (int idx = tid; idx < 64 * 16; idx += 512) { const int rl = idx >> 4, k = idx & 15, l = half * 64 + rl; float v = 0.f;
        if (k < 8) v = cus[l * 8 + k]; else if (k < 12) v = (float)(l + 1) * log1pf(-exp2f(-5.0f - (float)(k - 8)));
        CUMS[(size_t)(crow0 + l) * 16 + k] = v; }
    const int r0 = crow0 + half * 64, pos0 = c * 128 + half * 64;
    for (int it = tid; it < 64 * 128; it += 512) { const int rl = it >> 7, ch = it & 127, col = ch * 8, i0 = (col & 127) >> 1;
        const f32x4 cs = *(const f32x4*)(COS + (size_t)(pos0 + rl) * 64 + i0), sn = *(const f32x4*)(SIN + (size_t)(pos0 + rl) * 64 + i0);
        u32x4* p = (u32x4*)(PROJ + (size_t)(r0 + rl) * EV_PITCH + col); const u32x4 v = *p; const float sc = col >= 512 ? 0.08838834764831845f : 1.0f; u32x4 o;
#pragma unroll
        for (int e = 0; e < 4; ++e) { const float t1 = bflo(v[e]), t2 = bfhi(v[e]); o[e] = pk2((t1 * cs[e] - t2 * sn[e]) * sc, (t1 * sn[e] + t2 * cs[e]) * sc); }
        *p = o; }
    const float* cw = a.in[I_CONVW] + (size_t)li * 4 * 768; const float* cb = a.in[I_CONVB] + (size_t)li * 768;
    for (int it = tid; it < 64 * 96; it += 512) { const int rl = it / 96, ch = (it % 96) * 8; const int pos = pos0 + rl;
        float acc[8];
        { const f32x4 b0 = *(const f32x4*)(cb + ch), b1 = *(const f32x4*)(cb + ch + 4); acc[0] = b0.x; acc[1] = b0.y; acc[2] = b0.z; acc[3] = b0.w; acc[4] = b1.x; acc[5] = b1.y; acc[6] = b1.z; acc[7] = b1.w; }
#pragma unroll
        for (int i = 0; i < 4; ++i) { const int ps = pos - 3 + i; if (ps >= 0) {
            const u32x4 v = *(const u32x4*)(PROJ + (size_t)(b * SEQ + ps) * EV_PITCH + 2560 + ch);
            const f32x4 w0 = *(const f32x4*)(cw + i * 768 + ch), w1 = *(const f32x4*)(cw + i * 768 + ch + 4);
            acc[0] += w0.x * bflo(v.x); acc[1] += w0.y * bfhi(v.x); acc[2] += w0.z * bflo(v.y); acc[3] += w0.w * bfhi(v.y);
            acc[4] += w1.x * bflo(v.z); acc[5] += w1.y * bfhi(v.z); acc[6] += w1.z * bflo(v.w); acc[7] += w1.w * bfhi(v.w); } }
#pragma unroll
        for (int e = 0; e < 8; ++e) acc[e] = silu_f(acc[e]);
        u32x4 o; o.x = pk2(acc[0], acc[1]); o.y = pk2(acc[2], acc[3]); o.z = pk2(acc[4], acc[5]); o.w = pk2(acc[6], acc[7]);
        *(u32x4*)(CONV + (size_t)(r0 + rl) * 768 + ch) = o;
        if (ch < 512) { const float dt = dts[(half * 64 + rl) * 8 + (ch >> 6)];
            u32x4 x; x.x = pk2(acc[0] * dt, acc[1] * dt); x.y = pk2(acc[2] * dt, acc[3] * dt); x.z = pk2(acc[4] * dt, acc[5] * dt); x.w = pk2(acc[6] * dt, acc[7] * dt);
            *(u32x4*)(XDT + (size_t)(r0 + rl) * 512 + ch) = x; } }
}

template <int NCOL, bool WEIGHT>
DI void stage_T(const bf16_t* src, int ld, LAS bf16_t* dstT, const float* cum, int tid) {
    constexpr int CPR = NCOL / 8;
    float cl = 0.f; if (WEIGHT) cl = cum[127 * 16];
    for (int it = tid; it < 128 * CPR; it += 512) { const int j = it & 127, ch = it >> 7;
        const u32x4 v = *(const u32x4*)(src + (size_t)j * ld + ch * 8);
        float w = 1.f; if (WEIGHT) w = ex2((cl - cum[j * 16]) * LOG2E);
#pragma unroll
        for (int e = 0; e < 4; ++e) { float lo = bflo(v[e]), hi = bfhi(v[e]); if (WEIGHT) { lo *= w; hi *= w; }
            dstT[(ch * 8 + 2 * e) * TP + j] = f2bf(lo); dstT[(ch * 8 + 2 * e + 1) * TP + j] = f2bf(hi); } }
}
template <int NCOL>
DI void stage_N(const bf16_t* src, int ld, LAS bf16_t* dst, int tid) {
    constexpr int CPR = NCOL / 8;
    for (int it = tid; it < 128 * CPR; it += 512) { const int j = it / CPR, ch = it % CPR;
        *(LAS u32x4*)(dst + j * (NCOL + 8) + ch * 8) = *(const u32x4*)(src + (size_t)j * ld + ch * 8); }
}

template <int DK, int DV>
DI void e1_unit(const bf16_t* Kp, int ldk, const bf16_t* Vp, int ldv, const float* cum, float* st, LAS unsigned char* lds, int tid, int wave, int lane) {
    LAS bf16_t* KT = (LAS bf16_t*)lds; LAS bf16_t* VT = KT + DK * TP;
    __syncthreads();
    stage_T<DK, false>(Kp, ldk, KT, cum, tid);
    stage_T<DV, true>(Vp, ldv, VT, cum, tid);
    __syncthreads();
    constexpr int NTILES = DK / 16, TPW = (DV / 16) * NTILES / 8;
    const int lr = lane & 15, lq = lane >> 4; const int mt = (wave * TPW) / NTILES, nt0 = (wave * TPW) % NTILES;
    f32x4 acc[TPW];
#pragma unroll
    for (int i = 0; i < TPW; ++i) acc[i] = (f32x4){0.f, 0.f, 0.f, 0.f};
#pragma unroll
    for (int ks = 0; ks < 4; ++ks) { const bf16x8 xf = *(const LAS bf16x8*)(VT + (mt * 16 + lr) * TP + ks * 32 + lq * 8);
#pragma unroll
        for (int i = 0; i < TPW; ++i) { const bf16x8 yf = *(const LAS bf16x8*)(KT + ((nt0 + i) * 16 + lr) * TP + ks * 32 + lq * 8); acc[i] = mfma16(xf, yf, acc[i]); } }
#pragma unroll
    for (int i = 0; i < TPW; ++i)
#pragma unroll
        for (int t = 0; t < 4; ++t) st[(size_t)(mt * 16 + 4 * lq + t) * DK + (nt0 + i) * 16 + lr] = acc[i][t];
}

template <int DK, int DV, bool RET>
DI void e3_unit(const bf16_t* Qp, int ldq, const bf16_t* Kp, int ldk, const bf16_t* Vp, int ldv, const float* cum, const bf16_t* Sin,
                const bf16_t* gz, int ldgz, const bf16_t* xs, float dskip, bf16_t* outp, int ldo, LAS unsigned char* lds, int tid, int wave, int lane) {
    constexpr int QP = DK + 8;
    LAS bf16_t* Qs = (LAS bf16_t*)lds; LAS bf16_t* Ks = Qs + 128 * QP; LAS bf16_t* VT = Ks + 128 * QP; LAS bf16_t* P = VT + DV * TP; LAS float* cumL = (LAS float*)(P + 128 * TP);
    __syncthreads();
    stage_N<DK>(Qp, ldq, Qs, tid); stage_N<DK>(Kp, ldk, Ks, tid); stage_T<DV, false>(Vp, ldv, VT, cum, tid);
    if (tid < 128) cumL[tid] = cum[tid * 16];
    __syncthreads();
    const int lr = lane & 15, lq = lane >> 4, i0 = wave * 16;
    bf16x8 qf[DK / 32];
#pragma unroll
    for (int ks = 0; ks < DK / 32; ++ks) qf[ks] = *(const LAS bf16x8*)(Qs + (i0 + lr) * QP + ks * 32 + lq * 8);
    float ci[4];
#pragma unroll
    for (int t = 0; t < 4; ++t) ci[t] = cumL[i0 + 4 * lq + t];
#pragma unroll
    for (int nt = 0; nt < 8; ++nt) {
        f32x4 s = (f32x4){0.f, 0.f, 0.f, 0.f};
        if (nt <= wave) {
#pragma unroll
            for (int ks = 0; ks < DK / 32; ++ks) { const bf16x8 kf = *(const LAS bf16x8*)(Ks + (nt * 16 + lr) * QP + ks * 32 + lq * 8); s = mfma16(qf[ks], kf, s); }
        }
        const int j = nt * 16 + lr; const float cj = cumL[j];
#pragma unroll
        for (int t = 0; t < 4; ++t) { const int i = i0 + 4 * lq + t; const float p = (i >= j) ? s[t] * ex2((ci[t] - cj) * LOG2E) : 0.f; P[i * TP + j] = f2bf(p); }
    }
    f32x4 o[DV / 16];
#pragma unroll
    for (int nt = 0; nt < DV / 16; ++nt) { o[nt] = (f32x4){0.f, 0.f, 0.f, 0.f};
#pragma unroll
        for (int ks = 0; ks < DK / 32; ++ks) { const bf16x8 sf = *(const bf16x8*)(Sin + (size_t)(nt * 16 + lr) * DK + ks * 32 + lq * 8); o[nt] = mfma16(qf[ks], sf, o[nt]); }
#pragma unroll
        for (int t = 0; t < 4; ++t) o[nt][t] *= ex2(ci[t] * LOG2E); }
    LDS_WAIT();
#pragma unroll
    for (int ks = 0; ks < 4; ++ks) { const bf16x8 pf = *(const LAS bf16x8*)(P + (i0 + lr) * TP + ks * 32 + lq * 8);
#pragma unroll
        for (int nt = 0; nt < DV / 16; ++nt) { const bf16x8 vf = *(const LAS bf16x8*)(VT + (nt * 16 + lr) * TP + ks * 32 + lq * 8); o[nt] = mfma16(pf, vf, o[nt]); } }
    if (RET) {
        float rs[4];
#pragma unroll
        for (int t = 0; t < 4; ++t) { float ss = 0.f;
#pragma unroll
            for (int nt = 0; nt < DV / 16; ++nt) ss += o[nt][t] * o[nt][t];
            ss = grp16_sum(ss); rs[t] = 1.0f / sqrtf(ss * (1.0f / DV) + EPS); }
#pragma unroll
        for (int nt = 0; nt < DV / 16; ++nt)
#pragma unroll
            for (int t = 0; t < 4; ++t) { const int i = i0 + 4 * lq + t; const float g = bf2f(gz[(size_t)i * ldgz + nt * 16 + lr]);
                outp[(size_t)i * ldo + nt * 16 + lr] = f2bf(o[nt][t] * rs[t] * silu_f(g)); }
    } else {
#pragma unroll
        for (int nt = 0; nt < DV / 16; ++nt)
#pragma unroll
            for (int t = 0; t < 4; ++t) { const int i = i0 + 4 * lq + t; const float z = bf2f(gz[(size_t)i * ldgz + nt * 16 + lr]); const float xv = bf2f(xs[(size_t)i * 768 + nt * 16 + lr]);
                outp[(size_t)i * ldo + nt * 16 + lr] = f2bf((o[nt][t] + dskip * xv) * silu_f(z)); }
    }
}

DI void e1_phase(const Args& a, LAS unsigned char* lds, int tid, int wave, int lane, int bid, int G) {
    unsigned char* R = a.ws + WS_R; const bf16_t* PROJ = (const bf16_t*)(R + R_PROJ); const bf16_t* CONV = (const bf16_t*)(R + R_CONV); const bf16_t* XDT = (const bf16_t*)(R + R_XDT); const float* CUMS = (const float*)(R + R_CUMS);
    for (int u = bid; u < 1536; u += G) {
        if (u < 512) { const int b = u >> 7, c = (u >> 2) & 31, h = u & 3; const size_t row0 = (size_t)b * SEQ + c * 128;
            e1_unit<128, 128>(PROJ + row0 * EV_PITCH + 512 + h * 128, EV_PITCH, PROJ + row0 * EV_PITCH + 1024 + h * 128, EV_PITCH, CUMS + row0 * 16 + 8 + h,
                              (float*)(R + R_STR) + ((size_t)(b * 4 + h) * 32 + c) * 16384, lds, tid, wave, lane);
        } else { const int v = u - 512, b = v >> 8, c = (v >> 3) & 31, hd = v & 7, g = hd >> 2; const size_t row0 = (size_t)b * SEQ + c * 128;
            e1_unit<64, 64>(CONV + row0 * 768 + 512 + g * 64, 768, XDT + row0 * 512 + hd * 64, 512, CUMS + row0 * 16 + hd,
                            (float*)(R + R_STS) + ((size_t)(b * 8 + hd) * 32 + c) * 4096, lds, tid, wave, lane);
        }
    }
}
DI void e2_phase(const Args& a, int tid, int bid, int G) {
    unsigned char* R = a.ws + WS_R; const float* CUMS = (const float*)(R + R_CUMS);
    const float* STR = (const float*)(R + R_STR); const float* STS = (const float*)(R + R_STS); bf16_t* SINR = (bf16_t*)(R + R_SINR); bf16_t* SINS = (bf16_t*)(R + R_SINS);
    for (int idx = bid * 512 + tid; idx < 65536 + 32768; idx += G * 512) {
        const bool ret = idx < 65536; const int e = ret ? idx : idx - 65536;
        const int bh = ret ? (e >> 12) : (e >> 10), el = ret ? (e & 4095) * 4 : (e & 1023) * 4, b = ret ? (bh >> 2) : (bh >> 3), hc = ret ? 8 + (bh & 3) : (bh & 7);
        const int esz = ret ? 16384 : 4096; const float* ST = ret ? STR : STS; bf16_t* SIN = ret ? SINR : SINS;
        f32x4 run = (f32x4){0.f, 0.f, 0.f, 0.f};
#pragma unroll 4
        for (int c = 0; c < 32; ++c) { const size_t o = ((size_t)bh * 32 + c) * esz + el;
            u32x2 w; w.x = pk2(run[0], run[1]); w.y = pk2(run[2], run[3]); *(u32x2*)(SIN + o) = w;
            const float dec = expf(CUMS[((size_t)b * SEQ + c * 128 + 127) * 16 + hc]); run = run * dec + *(const f32x4*)(ST + o); }
    }
}
DI void e3_phase(const Args& a, int li, LAS unsigned char* lds, int tid, int wave, int lane, int bid, int G) {
    unsigned char* R = a.ws + WS_R; const bf16_t* PROJ = (const bf16_t*)(R + R_PROJ); const bf16_t* CONV = (const bf16_t*)(R + R_CONV); const bf16_t* XDT = (const bf16_t*)(R + R_XDT); const float* CUMS = (const float*)(R + R_CUMS);
    bf16_t* MIX = (bf16_t*)(a.ws + WS_H); bf16_t* YP = (bf16_t*)(R + R_YP);
    for (int u = bid; u < 1536; u += G) {
        if (u < 512) { const int b = u >> 7, c = (u >> 2) & 31, h = u & 3; const size_t row0 = (size_t)b * SEQ + c * 128; const bf16_t* pr = PROJ + row0 * EV_PITCH;
            e3_unit<128, 128, true>(pr + h * 128, EV_PITCH, pr + 512 + h * 128, EV_PITCH, pr + 1024 + h * 128, EV_PITCH, CUMS + row0 * 16 + 8 + h,
                                    (const bf16_t*)(R + R_SINR) + ((size_t)(b * 4 + h) * 32 + c) * 16384, pr + 1536 + h * 128, EV_PITCH, nullptr, 0.f,
                                    MIX + row0 * DM + h * 128, DM, lds, tid, wave, lane);
        } else { const int v = u - 512, b = v >> 8, c = (v >> 3) & 31, hd = v & 7, g = hd >> 2; const size_t row0 = (size_t)b * SEQ + c * 128;
            e3_unit<64, 64, false>(CONV + row0 * 768 + 640 + g * 64, 768, CONV + row0 * 768 + 512 + g * 64, 768, XDT + row0 * 512 + hd * 64, 512, CUMS + row0 * 16 + hd,
                                   (const bf16_t*)(R + R_SINS) + ((size_t)(b * 8 + hd) * 32 + c) * 4096, PROJ + row0 * EV_PITCH + 2048 + hd * 64, EV_PITCH,
                                   CONV + row0 * 768 + hd * 64, a.in[I_SSMD][li * 8 + hd], YP + row0 * 512 + hd * 64, 512, lds, tid, wave, lane);
        }
    }
}
DI void e4_phase(const Args& a, int li, int gw, int NGW, int lane) {
    const bf16_t* YP = (const bf16_t*)(a.ws + WS_R + R_YP); bf16_t* MIX = (bf16_t*)(a.ws + WS_H); const float* nw = a.in[I_SSMNW] + (size_t)li * 512;
    const f32x4 w0 = *(const f32x4*)(nw + lane * 8), w1 = *(const f32x4*)(nw + lane * 8 + 4);
    for (int m = gw; m < MTOK; m += NGW) {
        const u32x4 v = *(const u32x4*)(YP + (size_t)m * 512 + lane * 8);
        float f[8] = {bflo(v.x), bfhi(v.x), bflo(v.y), bfhi(v.y), bflo(v.z), bfhi(v.z), bflo(v.w), bfhi(v.w)}; float s = 0.f;
#pragma unroll
        for (int e = 0; e < 8; ++e) s += f[e] * f[e];
        const float r = 1.0f / sqrtf(wave_sum(s) * (1.f / 512.f) + EPS);
        u32x4 o; o.x = pk2(f[0] * r * w0.x, f[1] * r * w0.y); o.y = pk2(f[2] * r * w0.z, f[3] * r * w0.w); o.z = pk2(f[4] * r * w1.x, f[5] * r * w1.y); o.w = pk2(f[6] * r * w1.z, f[7] * r * w1.w);
        *(u32x4*)(MIX + (size_t)m * DM + 512 + lane * 8) = o;
    }
}

template <int MT, int HD, class MaskF>
DI void flash_block(const bf16x8 (&qf)[MT][HD / 32], const bf16_t* Kb, int ldk, const bf16_t* Vt, int ldv,
                    f32x4 (&o)[MT][HD / 16], float (&mrow)[MT][4], float (&lrow)[MT][4], LAS bf16_t* pbuf, float c2, const MaskF& mk, int key0, int lr, int lq) {
    constexpr int PP = 72;
    f32x4 s[MT][4];
#pragma unroll
    for (int mt = 0; mt < MT; ++mt)
#pragma unroll
        for (int nt = 0; nt < 4; ++nt) s[mt][nt] = (f32x4){0.f, 0.f, 0.f, 0.f};
#pragma unroll
    for (int nt = 0; nt < 4; ++nt)
#pragma unroll
        for (int ks = 0; ks < HD / 32; ++ks) { const bf16x8 kf = *(const bf16x8*)(Kb + (size_t)(nt * 16 + lr) * ldk + ks * 32 + lq * 8);
#pragma unroll
            for (int mt = 0; mt < MT; ++mt) s[mt][nt] = mfma16(qf[mt][ks], kf, s[mt][nt]); }
#pragma unroll
    for (int mt = 0; mt < MT; ++mt) {
#pragma unroll
        for (int nt = 0; nt < 4; ++nt) { const bool ok = mk.ok(mt, key0 + nt * 16 + lr);
#pragma unroll
            for (int t = 0; t < 4; ++t) s[mt][nt][t] = ok ? s[mt][nt][t] * c2 : -INFINITY; }
#pragma unroll
        for (int t = 0; t < 4; ++t) {
            float mx = fmaxf(fmaxf(s[mt][0][t], s[mt][1][t]), fmaxf(s[mt][2][t], s[mt][3][t])); mx = grp16_max(mx);
            const float mnew = fmaxf(mrow[mt][t], mx), alpha = ex2(mrow[mt][t] - mnew); mrow[mt][t] = mnew;
            float ps = 0.f;
#pragma unroll
            for (int nt = 0; nt < 4; ++nt) { const float p = ex2(s[mt][nt][t] - mnew); s[mt][nt][t] = p; ps += p; }
            lrow[mt][t] = lrow[mt][t] * alpha + ps;
#pragma unroll
            for (int nt = 0; nt < HD / 16; ++nt) o[mt][nt][t] *= alpha;
        }
#pragma unroll
        for (int nt = 0; nt < 4; ++nt)
#pragma unroll
            for (int t = 0; t < 4; ++t) pbuf[(mt * 16 + 4 * lq + t) * PP + nt * 16 + lr] = f2bf(s[mt][nt][t]);
    }
    LDS_WAIT();
#pragma unroll
    for (int ks = 0; ks < 2; ++ks) { bf16x8 pf[MT];
#pragma unroll
        for (int mt = 0; mt < MT; ++mt) pf[mt] = *(const LAS bf16x8*)(pbuf + (mt * 16 + lr) * PP + ks * 32 + lq * 8);
#pragma unroll
        for (int nt = 0; nt < HD / 16; ++nt) { const bf16x8 vf = *(const bf16x8*)(Vt + (size_t)(nt * 16 + lr) * ldv + ks * 32 + lq * 8);
#pragma unroll
            for (int mt = 0; mt < MT; ++mt) o[mt][nt] = mfma16(pf[mt], vf, o[mt][nt]); } }
    LDS_WAIT();
}
struct NoMask { DI bool ok(int, int) const { return true; } };
struct WinMask { int W; int tpos[2]; DI bool ok(int mt, int key) const { return key <= tpos[mt] && tpos[mt] - key < W; } };
struct SelMask { unsigned long long sm[2]; int jb; int tpos[2]; DI bool ok(int mt, int key) const { return ((sm[mt] >> jb) & 1ull) != 0ull && key <= tpos[mt]; } };

struct CmpOrder {
    int G, c; const char* P; const char* W1;
    DI bool next(int i, pg8::Unit& u) const { const int L = i * G + c; if (L >= 16) return false; u.pm = L & 7; u.pn = L >> 3; const int b = u.pm >> 1, g = u.pm & 1;
        u.a = P + ((size_t)b * SEQ * OD_PITCH + 512 + u.pn * 128 + g * 64) * 2; u.b = W1 + (size_t)u.pn * 256 * 2048 * 2; return true; }
};
DI void o2_phase(const Args& a, const unsigned char* W, int gw, int lane) {
    if (gw >= 128) return;
    unsigned char* R = a.ws + WS_R; const bf16_t* HIDC = (const bf16_t*)(R + R_HIDC); const bf16_t* W2T = (const bf16_t*)(W + W_C2);
    bf16_t* KC = (bf16_t*)(R + R_KC); bf16_t* VCT = (bf16_t*)(R + R_VCT);
    const int kv = gw >> 6, bg = (gw >> 3) & 7, n0 = (gw & 7) * 32, lr = lane & 15, lq = lane >> 4;
    const bf16_t* hid = HIDC + ((size_t)(kv * 8 + bg) * 256) * 256; const bf16_t* w2 = W2T + (size_t)kv * 64 * 256;
    if (kv == 0) {
        f32x4 acc[2][4];
#pragma unroll
        for (int mt = 0; mt < 2; ++mt)
#pragma unroll
            for (int nt = 0; nt < 4; ++nt) acc[mt][nt] = (f32x4){0.f, 0.f, 0.f, 0.f};
#pragma unroll
        for (int ks = 0; ks < 8; ++ks) { bf16x8 xf[2];
#pragma unroll
            for (int mt = 0; mt < 2; ++mt) xf[mt] = *(const bf16x8*)(hid + (size_t)(n0 + mt * 16 + lr) * 256 + ks * 32 + lq * 8);
#pragma unroll
            for (int nt = 0; nt < 4; ++nt) { const bf16x8 yf = *(const bf16x8*)(w2 + (size_t)(nt * 16 + lr) * 256 + ks * 32 + lq * 8);
#pragma unroll
                for (int mt = 0; mt < 2; ++mt) acc[mt][nt] = mfma16(xf[mt], yf, acc[mt][nt]); } }
#pragma unroll
        for (int mt = 0; mt < 2; ++mt)
#pragma unroll
            for (int nt = 0; nt < 4; ++nt)
#pragma unroll
                for (int t = 0; t < 4; ++t) KC[((size_t)bg * 256 + n0 + mt * 16 + 4 * lq + t) * 64 + nt * 16 + lr] = f2bf(acc[mt][nt][t]);
    } else {
        f32x4 acc[4][2];
#pragma unroll
        for (int mt = 0; mt < 4; ++mt)
#pragma unroll
            for (int nt = 0; nt < 2; ++nt) acc[mt][nt] = (f32x4){0.f, 0.f, 0.f, 0.f};
#pragma unroll
        for (int ks = 0; ks < 8; ++ks) { bf16x8 yf[2];
#pragma unroll
            for (int nt = 0; nt < 2; ++nt) yf[nt] = *(const bf16x8*)(hid + (size_t)(n0 + nt * 16 + lr) * 256 + ks * 32 + lq * 8);
#pragma unroll
            for (int mt = 0; mt < 4; ++mt) { const bf16x8 xf = *(const bf16x8*)(w2 + (size_t)(mt * 16 + lr) * 256 + ks * 32 + lq * 8);
#pragma unroll
                for (int nt = 0; nt < 2; ++nt) acc[mt][nt] = mfma16(xf, yf[nt], acc[mt][nt]); } }
#pragma unroll
        for (int mt = 0; mt < 4; ++mt)
#pragma unroll
            for (int nt = 0; nt < 2; ++nt)
#pragma unroll
                for (int t = 0; t < 4; ++t) VCT[((size_t)bg * 64 + mt * 16 + 4 * lq + t) * 256 + n0 + nt * 16 + lr] = f2bf(acc[mt][nt][t]);
    }
}

constexpr int O3_IMP = 102400, O3_GATES = 118784, O3_SELM = 139264, O3_UNION = 139776;
constexpr int O3_OTP = 68, O3_PBUF = 0, O3_KV = 36864, O3_NST = 4;
struct WinMaskT { int W; int tpos[2]; int t0;
    DI void set_block(int) {}
    DI int kind(int jb) const { const int k0 = jb * 64; return (k0 + 63 <= t0 && t0 + 63 - k0 < W) ? 0 : 2; }
    DI bool rowok(int) const { return true; }
    DI bool ok(int mt, int key) const { return key <= tpos[mt] && tpos[mt] - key < W; } };
struct SelMaskT { unsigned long long sm[2]; int jb; int tpos[2]; int t0;
    DI void set_block(int j) { jb = j; }
    DI int kind(int j) const { return (j * 64 + 63 <= t0) ? 1 : 2; }
    DI bool rowok(int mt) const { return ((sm[mt] >> jb) & 1ull) != 0ull; }
    DI bool ok(int mt, int key) const { return ((sm[mt] >> jb) & 1ull) != 0ull && key <= tpos[mt]; } };

template <class MaskF>
DI void flash_pass_lds(const bf16x8 (&qf)[2][2], const bf16_t* Kg, int ldk, const bf16_t* Vg, int ldv, unsigned long long use,
                       f32x4 (&o)[2][4], float (&mrow)[2], float (&lrow)[2], LAS unsigned char* lds, float c2, MaskF& mk, int tid, int wave, int lr, int lq) {
    constexpr int PP = 72;
    LAS bf16_t* pbuf = (LAS bf16_t*)(lds + O3_PBUF + wave * 4608);
    int R, C; pg8::stage_rc(tid * 16, R, C);
    const bf16_t* ksrc = Kg + (size_t)R * ldk + C; const bf16_t* vsrc = Vg + (size_t)R * ldv + C;
    const int koff = pg8::lds_byte(lr, lq * 8);
#pragma unroll
    for (int mt = 0; mt < 2; ++mt) { mrow[mt] = -1e30f; lrow[mt] = 0.f;
#pragma unroll
        for (int nt = 0; nt < 4; ++nt) o[mt][nt] = (f32x4){0.f, 0.f, 0.f, 0.f}; }
    __syncthreads();
    if (use == 0ull) return;
    unsigned long long rem_issue = use; int nissued = 0; const int total = __builtin_popcountll(use);
#define O3_ISSUE() do { const int j_ = __builtin_ctzll(rem_issue); rem_issue &= rem_issue - 1ull; const int b_ = (nissued & (O3_NST - 1)) * 16384; ++nissued; \
        __builtin_amdgcn_global_load_lds((const unsigned*)(ksrc + (size_t)j_ * 64 * ldk), (LAS unsigned*)(lds + O3_KV + b_ + wave * 1024), 16, 0, 0); \
        __builtin_amdgcn_global_load_lds((const unsigned*)(vsrc + j_ * 64), (LAS unsigned*)(lds + O3_KV + b_ + 8192 + wave * 1024), 16, 0, 0); } while (0)
#pragma unroll 1
    for (int k = 0; k < O3_NST - 1 && rem_issue; ++k) O3_ISSUE();
#pragma unroll 1
    for (int i = 0; i < total; ++i) {
        const int jb = __builtin_ctzll(use); use &= use - 1ull; const int buf = i & (O3_NST - 1);
        const int ahead = nissued - i - 1;
        if (ahead >= 2) asm volatile("s_waitcnt vmcnt(4)" ::: "memory"); else if (ahead == 1) asm volatile("s_waitcnt vmcnt(2)" ::: "memory"); else asm volatile("s_waitcnt vmcnt(0)" ::: "memory");
        asm volatile("s_waitcnt lgkmcnt(0)" ::: "memory"); __builtin_amdgcn_s_barrier(); asm volatile("" ::: "memory");
        if (rem_issue) O3_ISSUE();
        const LAS unsigned char* kb = lds + O3_KV + buf * 16384 + koff; const LAS unsigned char* vb = kb + 8192;
        mk.set_block(jb);
        const int key0 = jb * 64 + 4 * lq;
        f32x4 s[2][4];
#pragma unroll
        for (int mt = 0; mt < 2; ++mt)
#pragma unroll
            for (int nt = 0; nt < 4; ++nt) s[mt][nt] = (f32x4){0.f, 0.f, 0.f, 0.f};
#pragma unroll
        for (int nt = 0; nt < 4; ++nt)
#pragma unroll
            for (int ks = 0; ks < 2; ++ks) { const bf16x8 kf = *(const LAS bf16x8*)(kb + nt * 2048 + ks * 1024);
#pragma unroll
                for (int mt = 0; mt < 2; ++mt) s[mt][nt] = mfma16(kf, qf[mt][ks], s[mt][nt]); }
        const int kind = mk.kind(jb);
        if (kind == 2) {
#pragma unroll
            for (int mt = 0; mt < 2; ++mt)
#pragma unroll
                for (int nt = 0; nt < 4; ++nt)
#pragma unroll
                    for (int t = 0; t < 4; ++t) s[mt][nt][t] = mk.ok(mt, key0 + nt * 16 + t) ? s[mt][nt][t] : -INFINITY;
        } else if (kind == 1) {
#pragma unroll
            for (int mt = 0; mt < 2; ++mt) { const bool rk = mk.rowok(mt);
#pragma unroll
                for (int nt = 0; nt < 4; ++nt)
#pragma unroll
                    for (int t = 0; t < 4; ++t) s[mt][nt][t] = rk ? s[mt][nt][t] : -INFINITY; }
        }
#pragma unroll
        for (int mt = 0; mt < 2; ++mt) {
            float mx = -INFINITY;
#pragma unroll
            for (int nt = 0; nt < 4; ++nt)
#pragma unroll
                for (int t = 0; t < 4; ++t) mx = fmaxf(mx, s[mt][nt][t]);
            mx = fmaxf(mx, __shfl_xor(mx, 16)); mx = fmaxf(mx, __shfl_xor(mx, 32));
            const float mnew = fmaxf(mrow[mt], mx * c2), alpha = ex2(mrow[mt] - mnew); mrow[mt] = mnew;
            float ps = 0.f;
#pragma unroll
            for (int nt = 0; nt < 4; ++nt) {
#pragma unroll
                for (int t = 0; t < 4; ++t) { const float p = ex2(__builtin_fmaf(s[mt][nt][t], c2, -mnew)); s[mt][nt][t] = p; ps += p; }
                u32x2 w; w.x = pk2(s[mt][nt][0], s[mt][nt][1]); w.y = pk2(s[mt][nt][2], s[mt][nt][3]);
                *(LAS u32x2*)(pbuf + (mt * 16 + lr) * PP + nt * 16 + 4 * lq) = w; }
            lrow[mt] = lrow[mt] * alpha + ps;
#pragma unroll
            for (int nt = 0; nt < 4; ++nt) o[mt][nt] *= alpha;
        }
        LDS_WAIT();
#pragma unroll
        for (int ks = 0; ks < 2; ++ks) { bf16x8 pf[2];
#pragma unroll
            for (int mt = 0; mt < 2; ++mt) pf[mt] = *(const LAS bf16x8*)(pbuf + (mt * 16 + lr) * PP + ks * 32 + lq * 8);
#pragma unroll
            for (int nt = 0; nt < 4; ++nt) { const bf16x8 vf = *(const LAS bf16x8*)(vb + nt * 2048 + ks * 1024);
#pragma unroll
                for (int mt = 0; mt < 2; ++mt) o[mt][nt] = mfma16(vf, pf[mt], o[mt][nt]); } }
        LDS_WAIT();
    }
#undef O3_ISSUE
#pragma unroll
    for (int mt = 0; mt < 2; ++mt) { lrow[mt] += __shfl_xor(lrow[mt], 16); lrow[mt] += __shfl_xor(lrow[mt], 32); }
}

DI void o3_unit(const Args& a, int li, int bg, int tile, LAS unsigned char* lds, int tid, int wave, int lane) {
    asm volatile("" : "+v"(lane), "+v"(tid));
    unsigned char* R = a.ws + WS_R; const bf16_t* PROJ = (const bf16_t*)(R + R_PROJ); const bf16_t* VTb = (const bf16_t*)(R + R_VT);
    const bf16_t* KC = (const bf16_t*)(R + R_KC); const bf16_t* VCT = (const bf16_t*)(R + R_VCT); bf16_t* MIX = (bf16_t*)(a.ws + WS_H);
    const int b = bg >> 1, g = bg & 1, t0 = tile * 64, lr = lane & 15, lq = lane >> 4; const size_t rowb = (size_t)b * SEQ;
    LAS float* IMP = (LAS float*)(lds + O3_IMP + wave * 2048);
    LAS unsigned long long* SELM = (LAS unsigned long long*)(lds + O3_SELM + wave * 64); LAS unsigned long long* UNI8 = (LAS unsigned long long*)(lds + O3_UNION);
    LAS bf16_t* pbuf = (LAS bf16_t*)(lds + O3_PBUF + wave * 4608);
    const float c2 = 0.125f * LOG2E;
    const int e = lr & 3; int qpos[2]; qpos[0] = t0 + 8 * wave + (lr >> 2); qpos[1] = qpos[0] + 4;
    const int koff = pg8::lds_byte(lr, lq * 8);
    __syncthreads();
    {
        int Rr, Cc; pg8::stage_rc(tid * 16, Rr, Cc);
#pragma unroll
        for (int c = 0; c < 4; ++c) {
            __builtin_amdgcn_global_load_lds((const unsigned*)(KC + ((size_t)bg * 256 + c * 64 + Rr) * 64 + Cc), (LAS unsigned*)(lds + O3_KV + c * 16384 + wave * 1024), 16, 0, 0);
            __builtin_amdgcn_global_load_lds((const unsigned*)(VCT + ((size_t)bg * 64 + Rr) * 256 + c * 64 + Cc), (LAS unsigned*)(lds + O3_KV + c * 16384 + 8192 + wave * 1024), 16, 0, 0); }
    }
    bf16x8 qf[2][2];
#pragma unroll
    for (int mt = 0; mt < 2; ++mt)
#pragma unroll
        for (int ks = 0; ks < 2; ++ks) qf[mt][ks] = *(const bf16x8*)(PROJ + (rowb + t0 + 8 * wave + 4 * mt + (lr >> 2)) * OD_PITCH + g * 256 + (lr & 3) * 64 + ks * 32 + lq * 8);
    LAS float* GT = (LAS float*)(lds + O3_GATES + wave * 2048) + lane * 8;
    { float gl[2][3];
#pragma unroll
      for (int mt = 0; mt < 2; ++mt)
#pragma unroll
          for (int br = 0; br < 3; ++br) gl[mt][br] = bf2f(PROJ[(rowb + qpos[mt]) * OD_PITCH + 1664 + g * 12 + e * 3 + br]);
#pragma unroll
      for (int mt = 0; mt < 2; ++mt)
#pragma unroll
          for (int br = 0; br < 3; ++br) GT[mt * 4 + br] = sigmoid_f(gl[mt][br]); }
#define GATE(mt, br) GT[(mt) * 4 + (br)]
    VM_WAIT(); __syncthreads();
    f32x4 oacc[2][4];
#pragma unroll
    for (int mt = 0; mt < 2; ++mt) {
        f32x4 s[4][4];
#pragma unroll
        for (int c = 0; c < 4; ++c)
#pragma unroll
            for (int nt = 0; nt < 4; ++nt) { s[c][nt] = (f32x4){0.f, 0.f, 0.f, 0.f};
#pragma unroll
                for (int ks = 0; ks < 2; ++ks) { const bf16x8 kf = *(const LAS bf16x8*)(lds + O3_KV + c * 16384 + koff + nt * 2048 + ks * 1024); s[c][nt] = mfma16(kf, qf[mt][ks], s[c][nt]); } }
        float mx = -INFINITY;
#pragma unroll
        for (int c = 0; c < 4; ++c)
#pragma unroll
            for (int nt = 0; nt < 4; ++nt)
#pragma unroll
                for (int t = 0; t < 4; ++t) { const int n = c * 64 + nt * 16 + 4 * lq + t; const bool ok = (n < 255) && (16 * n + 31 <= qpos[mt]);
                    const float v = ok ? s[c][nt][t] : -INFINITY; s[c][nt][t] = v; mx = fmaxf(mx, v); }
        mx = fmaxf(mx, __shfl_xor(mx, 16)); mx = fmaxf(mx, __shfl_xor(mx, 32));
        const float mm = (mx == -INFINITY) ? 0.f : mx * c2; float sum = 0.f;
#pragma unroll
        for (int c = 0; c < 4; ++c)
#pragma unroll
            for (int nt = 0; nt < 4; ++nt)
#pragma unroll
                for (int t = 0; t < 4; ++t) { const float p = ex2(__builtin_fmaf(s[c][nt][t], c2, -mm)); s[c][nt][t] = p; sum += p; }
        sum += __shfl_xor(sum, 16); sum += __shfl_xor(sum, 32);
        const float inv = 1.0f / fmaxf(sum, 1e-30f);
#pragma unroll
        for (int c = 0; c < 4; ++c)
#pragma unroll
            for (int nt = 0; nt < 4; ++nt) s[c][nt] *= inv;
        const int srcl = (lane + 48) & 63;
#pragma unroll
        for (int c = 0; c < 4; ++c)
#pragma unroll
            for (int nt = 0; nt < 4; ++nt) {
                const float own = (s[c][nt][0] + s[c][nt][1]) + (s[c][nt][2] + s[c][nt][3]);
                const float a_ = __shfl(s[c][nt][3], srcl);
                float b_ = 0.f; if (c > 0 || nt > 0) b_ = __shfl(s[(nt > 0) ? c : c - (c > 0 ? 1 : 0)][(nt > 0) ? nt - 1 : 3][3], srcl);
                float v = own + (lq > 0 ? a_ : b_);
                v += __shfl_xor(v, 1); v += __shfl_xor(v, 2);
                if (e == 0) IMP[(4 * mt + (lr >> 2)) * 64 + c * 16 + nt * 4 + lq] = v; }
#pragma unroll
        for (int nt = 0; nt < 4; ++nt) oacc[mt][nt] = (f32x4){0.f, 0.f, 0.f, 0.f};
#pragma unroll
        for (int c = 0; c < 4; ++c) {
#pragma unroll
            for (int nt = 0; nt < 4; ++nt) { u32x2 w; w.x = pk2(s[c][nt][0], s[c][nt][1]); w.y = pk2(s[c][nt][2], s[c][nt][3]); *(LAS u32x2*)(pbuf + lr * 72 + nt * 16 + 4 * lq) = w; }
            LDS_WAIT();
#pragma unroll
            for (int ks = 0; ks < 2; ++ks) { const bf16x8 pf = *(const LAS bf16x8*)(pbuf + lr * 72 + ks * 32 + lq * 8);
#pragma unroll
                for (int nt = 0; nt < 4; ++nt) { const bf16x8 vf = *(const LAS bf16x8*)(lds + O3_KV + c * 16384 + 8192 + koff + nt * 2048 + ks * 1024); oacc[mt][nt] = mfma16(vf, pf, oacc[mt][nt]); } }
            LDS_WAIT();
        }
        const float g0 = GATE(mt, 0);
#pragma unroll
        for (int nt = 0; nt < 4; ++nt) oacc[mt][nt] *= g0;
    }
    LDS_WAIT();
    unsigned long long wunion = 0ull;
    {
        const int j = lane; const bool valid = j <= tile, forced = valid && (j == 0 || j == tile || j == tile - 1);
        const unsigned long long vmask = __ballot(valid); const int nvalid = __builtin_popcountll(vmask);
#pragma unroll 1
        for (int tk = 0; tk < 8; ++tk) {
            unsigned long long m = vmask;
            if (nvalid > 16) {
                const float sc = forced ? 1e6f : IMP[tk * 64 + j];
                const unsigned ub = __float_as_uint(sc); const unsigned key = (ub & 0x80000000u) ? ~ub : (ub | 0x80000000u);
                unsigned prefix = 0u;
#pragma unroll 1
                for (int bit = 31; bit >= 0; --bit) { const unsigned cand = prefix | (1u << bit);
                    const int c = __builtin_popcountll(__ballot(valid && key >= cand)); if (c >= 16) prefix = cand; }
                const unsigned long long gt = __ballot(valid && key > prefix); unsigned long long eq = __ballot(valid && key == prefix);
                int need = 16 - __builtin_popcountll(gt); unsigned long long sel = 0ull;
#pragma unroll 1
                for (; need > 0 && eq; --need) { const unsigned long long b1 = eq & (0ull - eq); sel |= b1; eq ^= b1; }
                m = gt | sel;
            }
            wunion |= m; if (lane == 0) SELM[tk] = m;
        }
    }
    if (lane == 0) UNI8[wave] = wunion;
    LDS_WAIT();
    __syncthreads();
    unsigned long long use_sel = 0ull;
#pragma unroll
    for (int w = 0; w < 8; ++w) use_sel |= UNI8[w];
    { const unsigned lo32 = __builtin_amdgcn_readfirstlane((unsigned)use_sel), hi32 = __builtin_amdgcn_readfirstlane((unsigned)(use_sel >> 32)); use_sel = ((unsigned long long)hi32 << 32) | lo32; }
    f32x4 o[2][4]; float mrow[2], lrow[2];
    {
        SelMaskT mk; mk.sm[0] = SELM[lr >> 2]; mk.sm[1] = SELM[4 + (lr >> 2)]; mk.tpos[0] = qpos[0]; mk.tpos[1] = qpos[1]; mk.jb = 0; mk.t0 = t0;
        flash_pass_lds(qf, PROJ + rowb * OD_PITCH + 768 + g * 64, OD_PITCH, VTb + (size_t)(g * 64) * MTOK + rowb, MTOK, use_sel, o, mrow, lrow, lds, c2, mk, tid, wave, lr, lq);
#pragma unroll
        for (int mt = 0; mt < 2; ++mt) { const float f = GATE(mt, 1) / lrow[mt];
#pragma unroll
            for (int nt = 0; nt < 4; ++nt) oacc[mt][nt] += o[mt][nt] * f; }
    }
    {
        WinMaskT mk; mk.W = 512; mk.tpos[0] = qpos[0]; mk.tpos[1] = qpos[1]; mk.t0 = t0;
        const int jlo = tile >= 8 ? tile - 8 : 0; const unsigned long long use = ((tile == 63) ? ~0ull : ((1ull << (tile + 1)) - 1ull)) & ~((1ull << jlo) - 1ull);
        flash_pass_lds(qf, PROJ + rowb * OD_PITCH + 896 + g * 64, OD_PITCH, VTb + (size_t)(128 + g * 64) * MTOK + rowb, MTOK, use, o, mrow, lrow, lds, c2, mk, tid, wave, lr, lq);
#pragma unroll
        for (int mt = 0; mt < 2; ++mt) { const float f = GATE(mt, 2) / lrow[mt];
#pragma unroll
            for (int nt = 0; nt < 4; ++nt) { const f32x4 v = oacc[mt][nt] + o[mt][nt] * f;
                u32x2 w; w.x = pk2(v[0], v[1]); w.y = pk2(v[2], v[3]); *(u32x2*)(MIX + (rowb + qpos[mt]) * DM + g * 256 + e * 64 + nt * 16 + 4 * lq) = w; } }
    }
    {
#pragma unroll
        for (int mt = 0; mt < 2; ++mt)
#pragma unroll
            for (int ks = 0; ks < 2; ++ks) qf[mt][ks] = *(const bf16x8*)(PROJ + (rowb + t0 + 8 * wave + 4 * mt + (lr >> 2)) * OD_PITCH + 1152 + g * 256 + (lr & 3) * 64 + ks * 32 + lq * 8);
        WinMaskT mk; mk.W = 128; mk.tpos[0] = qpos[0]; mk.tpos[1] = qpos[1]; mk.t0 = t0;
        const int jlo = tile >= 2 ? tile - 2 : 0; const unsigned long long use = ((tile == 63) ? ~0ull : ((1ull << (tile + 1)) - 1ull)) & ~((1ull << jlo) - 1ull);
        flash_pass_lds(qf, PROJ + rowb * OD_PITCH + 1024 + g * 64, OD_PITCH, VTb + (size_t)(256 + g * 64) * MTOK + rowb, MTOK, use, o, mrow, lrow, lds, c2, mk, tid, wave, lr, lq);
        const float sk = a.in[I_SINKS][li * 8 + g * 4 + e] * LOG2E;
#pragma unroll
        for (int mt = 0; mt < 2; ++mt) { const float f = 1.0f / (lrow[mt] + ex2(sk - mrow[mt]));
#pragma unroll
            for (int nt = 0; nt < 4; ++nt) { const f32x4 v = o[mt][nt] * f;
                u32x2 w; w.x = pk2(v[0], v[1]); w.y = pk2(v[2], v[3]); *(u32x2*)(MIX + (rowb + qpos[mt]) * DM + 512 + g * 256 + e * 64 + nt * 16 + 4 * lq) = w; } }
    }
#undef GATE
}
DI void o3_phase(const Args& a, int li, LAS unsigned char* lds, int tid, int wave, int lane, int bid, int G) {
    for (int p = bid; p < 256; p += G) { const int bg = p >> 5, tl = p & 31;
        o3_unit(a, li, bg, 63 - tl, lds, tid, wave, lane);
        for (int rep = 0; rep < ((DUP_MASK & 8192) ? 2 : 1); ++rep) o3_unit(a, li, bg, tl, lds, tid, wave, lane); }
}

constexpr int XA_PBUF = 0, XA_PP = 40, XA_KV = 10240, XA_STAGE = 32768, XA_NST = 4;
DI void xattn_phase(const Args& a, LAS unsigned char* lds, int tid, int wave, int lane, int bid, int G) {
    const bf16_t* Q = (const bf16_t*)(a.ws + WS_R + R_Q); bf16_t* O = (bf16_t*)(a.ws + WS_H); const bf16_t* KX = (const bf16_t*)(a.ws + WS_KX); const bf16_t* VTX = (const bf16_t*)(a.ws + WS_VTX);
    const float c2 = 0.0625f * LOG2E;
    for (int u = bid; u < 512; u += G) {
        asm volatile("" : "+v"(lane), "+v"(tid));
        const int lr = lane & 15, lq = lane >> 4; LAS bf16_t* pbuf = (LAS bf16_t*)(lds + XA_PBUF + wave * 1280);
        const int b = u >> 7, hd = (u >> 5) & 3, qt = u & 31;
        const size_t row0 = (size_t)b * SEQ + qt * 128 + wave * 16;
        const bf16_t* ksrc[2]; const bf16_t* vsrc[2];
#pragma unroll
        for (int i = 0; i < 2; ++i) { const int bb = tid * 16 + i * 8192, blk = bb >> 10, sb = bb & 1023, sw = sb ^ (((sb >> 9) & 1) << 5);
            ksrc[i] = KX + ((size_t)b * MEMLEN + (blk & 1) * 16 + (sw >> 6)) * DM + hd * 256 + (blk >> 1) * 32 + ((sw & 63) >> 1);
            vsrc[i] = VTX + ((size_t)hd * 256 + blk * 16 + (sw >> 6)) * DM + b * MEMLEN + ((sw & 63) >> 1); }
        const int koff = pg8::lds_byte(lr, lq * 8);
        __syncthreads();
#define XA_ISSUE(j_) do { const int st_ = XA_KV + ((j_) & (XA_NST - 1)) * XA_STAGE + wave * 1024; \
        __builtin_amdgcn_global_load_lds((const unsigned*)(ksrc[0] + (size_t)(j_) * 32 * DM), (LAS unsigned*)(lds + st_), 16, 0, 0); \
        __builtin_amdgcn_global_load_lds((const unsigned*)(ksrc[1] + (size_t)(j_) * 32 * DM), (LAS unsigned*)(lds + st_ + 8192), 16, 0, 0); \
        __builtin_amdgcn_global_load_lds((const unsigned*)(vsrc[0] + (j_) * 32), (LAS unsigned*)(lds + st_ + 16384), 16, 0, 0); \
        __builtin_amdgcn_global_load_lds((const unsigned*)(vsrc[1] + (j_) * 32), (LAS unsigned*)(lds + st_ + 24576), 16, 0, 0); } while (0)
        bf16x8 qf[8];
#pragma unroll
        for (int ks = 0; ks < 8; ++ks) qf[ks] = *(const bf16x8*)(Q + (row0 + lr) * DM + hd * 256 + ks * 32 + lq * 8);
        asm volatile("" ::: "memory");
        XA_ISSUE(0); XA_ISSUE(1); XA_ISSUE(2);
        f32x4 o[16]; float mrow = -1e30f, lsum = 0.f;
#pragma unroll
        for (int nt = 0; nt < 16; ++nt) o[nt] = (f32x4){0.f, 0.f, 0.f, 0.f};
#pragma unroll 1
        for (int j = 0; j < 8; ++j) {
            if (j <= 5) asm volatile("s_waitcnt vmcnt(8)" ::: "memory"); else if (j == 6) asm volatile("s_waitcnt vmcnt(4)" ::: "memory"); else asm volatile("s_waitcnt vmcnt(0)" ::: "memory");
            asm volatile("s_waitcnt lgkmcnt(0)" ::: "memory"); __builtin_amdgcn_s_barrier(); asm volatile("" ::: "memory");
            if (j + 3 < 8) XA_ISSUE(j + 3);
            const LAS unsigned char* st = lds + XA_KV + (j & (XA_NST - 1)) * XA_STAGE + koff;
            f32x4 s[2];
#pragma unroll
            for (int nt = 0; nt < 2; ++nt) { s[nt] = (f32x4){0.f, 0.f, 0.f, 0.f};
#pragma unroll
                for (int ks = 0; ks < 8; ++ks) { const bf16x8 kf = *(const LAS bf16x8*)(st + (ks * 2 + nt) * 1024); s[nt] = mfma16(kf, qf[ks], s[nt]); } }
            float mx = fmaxf(fmaxf(fmaxf(s[0][0], s[0][1]), fmaxf(s[0][2], s[0][3])), fmaxf(fmaxf(s[1][0], s[1][1]), fmaxf(s[1][2], s[1][3])));
            mx = fmaxf(mx, __shfl_xor(mx, 16)); mx = fmaxf(mx, __shfl_xor(mx, 32));
            const float mnew = fmaxf(mrow, mx * c2), alpha = ex2(mrow - mnew); mrow = mnew;
            float ps = 0.f;
#pragma unroll
            for (int nt = 0; nt < 2; ++nt) {
#pragma unroll
                for (int t = 0; t < 4; ++t) { const float p = ex2(__builtin_fmaf(s[nt][t], c2, -mnew)); s[nt][t] = p; ps += p; }
                u32x2 w; w.x = pk2(s[nt][0], s[nt][1]); w.y = pk2(s[nt][2], s[nt][3]); *(LAS u32x2*)(pbuf + lr * XA_PP + nt * 16 + 4 * lq) = w; }
            lsum = lsum * alpha + ps;
#pragma unroll
            for (int nt = 0; nt < 16; ++nt) o[nt] *= alpha;
            LDS_WAIT();
            const bf16x8 pf = *(const LAS bf16x8*)(pbuf + lr * XA_PP + lq * 8);
#pragma unroll
            for (int nt = 0; nt < 16; ++nt) { const bf16x8 vf = *(const LAS bf16x8*)(st + 16384 + nt * 1024); o[nt] = mfma16(vf, pf, o[nt]); }
            LDS_WAIT();
        }
#undef XA_ISSUE
        lsum += __shfl_xor(lsum, 16); lsum += __shfl_xor(lsum, 32);
        const float f = 1.0f / lsum;
#pragma unroll
        for (int nt = 0; nt < 16; ++nt) { const f32x4 v = o[nt] * f; u32x2 w; w.x = pk2(v[0], v[1]); w.y = pk2(v[2], v[3]);
            *(u32x2*)(O + (row0 + lr) * DM + hd * 256 + nt * 16 + 4 * lq) = w; }
    }
}

#ifndef MK_MODE
#define MK_MODE 1
#endif
constexpr int PH_PER_LAYER = 20, PH_FINAL = DEPTH * PH_PER_LAYER, PH_TOTAL = PH_FINAL + 1;
extern __shared__ __attribute__((aligned(16))) unsigned char lds_raw[];

#define PHASE_SETUP \
    asm volatile("" : "+s"(kp_)); \
    LAS unsigned char* lds = (LAS unsigned char*)lds_raw; \
    int tid = threadIdx.x, bid = blockIdx.x, G = gridDim.x; asm volatile("" : "+v"(tid)); asm volatile("" : "+s"(bid), "+s"(G)); \
    const int lane = tid & 63, wave = __builtin_amdgcn_readfirstlane(tid >> 6); const int gw = bid * 8 + wave, NGW = G * 8; (void)bid; \
    Args a; _Pragma("unroll") for (int i_ = 0; i_ < 25; ++i_) a.in[i_] = kp_->in[i_]; a.out = kp_->out; a.ws = kp_->ws; a.ph_lo = 0; a.ph_hi = 0; \
    unsigned char* ws = a.ws; float* X = (float*)(ws + WS_X); bf16_t* H = (bf16_t*)(ws + WS_H); unsigned char* R = ws + WS_R; unsigned char* W = ws + (wpar_ ? WS_W2 : WS_W); \
    (void)lds; (void)tid; (void)lane; (void)wave; (void)G; (void)gw; (void)NGW; (void)X; (void)H; (void)R; (void)W;
#define UNI(x) __builtin_amdgcn_readfirstlane(x)

DI void P_prologue(KP kp_, int layer) { layer = UNI(layer); const int wpar_ = layer & 1; PHASE_SETUP layer_prologue(kp_, a, layer, lds, tid, wave, lane, gw, NGW); __syncthreads(); }
DI void P_norm(KP kp_, int layer, int which) { layer = UNI(layer); which = UNI(which); const int wpar_ = layer & 1; PHASE_SETUP
    norm_phase((layer == 0 && which == 0) ? a.in[I_X] : X, a.in[I_NORMW] + ((size_t)layer * 4 + which) * DM, H, gw, NGW, lane); }
DI void P_norm0_kvx(KP kp_, int layer) { layer = UNI(layer); const int wpar_ = layer & 1; PHASE_SETUP
    const float* xin = (layer == 0) ? a.in[I_X] : X; const float* nw = a.in[I_NORMW] + (size_t)layer * 4 * DM;
    if (G >= 64) {
        if (bid < 32) {
            const bool vpart = bid >= 16;
            const bf16_t* A = vpart ? (const bf16_t*)(W + W_XKV) + (size_t)DM * DM : (const bf16_t*)(ws + WS_MEMN);
            const bf16_t* Bt = vpart ? (const bf16_t*)(ws + WS_MEMN) : (const bf16_t*)(W + W_XKV);
            pg8::Gemm g{A, Bt, DM, DM, 128, 128, DM}; pg8::StaticOrder S; S.init(g, vpart ? DM : NB * MEMLEN, vpart ? NB * MEMLEN : DM, 16, bid & 15);
            pg8::EpiBf16<0> E{vpart ? (bf16_t*)(ws + WS_VTX) : (bf16_t*)(ws + WS_KX), DM, nullptr, 0}; pg8::gemm_phase(lds, g, S, E, tid);
        } else norm_phase(xin, nw, H, (bid - 32) * 8 + wave, (G - 32) * 8, lane);
    } else {
        for (int which = 0; which < 2; ++which) {
            const bool vpart = which == 1;
            const bf16_t* A = vpart ? (const bf16_t*)(W + W_XKV) + (size_t)DM * DM : (const bf16_t*)(ws + WS_MEMN);
            const bf16_t* Bt = vpart ? (const bf16_t*)(ws + WS_MEMN) : (const bf16_t*)(W + W_XKV);
            pg8::Gemm g{A, Bt, DM, DM, 128, 128, DM}; pg8::StaticOrder S; S.init(g, vpart ? DM : NB * MEMLEN, vpart ? NB * MEMLEN : DM, G, bid);
            pg8::EpiBf16<0> E{vpart ? (bf16_t*)(ws + WS_VTX) : (bf16_t*)(ws + WS_KX), DM, nullptr, 0}; pg8::gemm_phase(lds, g, S, E, tid); }
        norm_phase(xin, nw, H, gw, NGW, lane);
    } }
DI void P_final(KP kp_) { const int wpar_ = 0; PHASE_SETUP final_norm_phase(X, a.in[I_FNORMW], a.out, gw, NGW, lane); }
DI void P_gemm_bf16(KP kp_, int which, int layer) { which = UNI(which); layer = UNI(layer); const int wpar_ = layer & 1; PHASE_SETUP
    const bf16_t* A = H; const bf16_t* Bt = (const bf16_t*)(W + W_IN); bf16_t* O = (bf16_t*)(R + R_PROJ); int M = MTOK, N = EV_PITCH, ldc = EV_PITCH, rot = 0;
    if (which == 0) { A = (const bf16_t*)(ws + WS_MEMN); Bt = (const bf16_t*)(W + W_XKV); O = (bf16_t*)(ws + WS_KX); M = NB * MEMLEN; N = DM; ldc = DM; }
    else if (which == 1) { A = (const bf16_t*)(W + W_XKV) + (size_t)DM * DM; Bt = (const bf16_t*)(ws + WS_MEMN); O = (bf16_t*)(ws + WS_VTX); M = DM; N = NB * MEMLEN; ldc = DM; rot = 16; }
    else if (which == 3) { N = OD_PITCH; ldc = OD_PITCH; }
    else if (which == 4) { A = (const bf16_t*)(W + W_IN) + (size_t)OD_PITCH * DM; Bt = H; O = (bf16_t*)(R + R_VT); M = 512; N = MTOK; ldc = MTOK; rot = 64; }
    else if (which == 5) { Bt = (const bf16_t*)(W + W_XQ); O = (bf16_t*)(R + R_Q); N = DM; ldc = DM; }
    pg8::Gemm g{A, Bt, DM, DM, 128, 128, DM}; pg8::StaticOrder S; S.init(g, M, N, G, (bid + G - rot) % G);
    pg8::EpiBf16<0> E{O, ldc, nullptr, 0}; pg8::gemm_phase(lds, g, S, E, tid);
    if (which == 2) prologue_tail(kp_, a, layer + 1, 1, 128, bid, G, lds, tid, wave, lane);
    if (which == 3) prologue_tail(kp_, a, layer + 1, 1, 192, bid, G, lds, tid, wave, lane); }
DI void P_gemm_swiglu(KP kp_, int half, int layer) { half = UNI(half); layer = UNI(layer); const int wpar_ = layer & 1; PHASE_SETUP
    pg8::Gemm g{H, (const bf16_t*)(W + W_GU) + (size_t)half * 2 * FF * DM, DM, DM, 128, 128, DM}; pg8::StaticOrder S; S.init(g, MTOK, 2 * FF, G, bid);
    pg8::EpiSwiGLU E{(bf16_t*)(R + R_HID), FF}; pg8::gemm_phase(lds, g, S, E, tid);
    prologue_tail(kp_, a, layer + 1, half ? 2 : 0, 128, bid, G, lds, tid, wave, lane); }
DI void P_gemm_resid(KP kp_, int which, int first, int layer) { which = UNI(which); first = UNI(first); layer = UNI(layer); const int wpar_ = layer & 1; PHASE_SETUP
    const bf16_t* A = (const bf16_t*)(R + R_HID); const bf16_t* Bt = (const bf16_t*)(W + W_D) + (size_t)which * DM * FF; int K = FF; float sc = 0.5f;
    if (which == 2) { A = H; Bt = (const bf16_t*)(W + W_OUT); K = DM; sc = 1.0f; }
    else if (which == 3) { A = H; Bt = (const bf16_t*)(W + W_XO); K = DM; sc = 1.0f; }
    pg8::Gemm g{A, Bt, K, K, 128, 128, K}; pg8::StaticOrder S; S.init(g, MTOK, DM, G, bid);
    pg8::EpiResid E{first ? a.in[I_X] : X, X, sc}; pg8::gemm_phase(lds, g, S, E, tid); }
DI void P_gemm_cmp(KP kp_, int layer) { layer = UNI(layer); const int wpar_ = layer & 1; PHASE_SETUP
    pg8::Gemm g{nullptr, nullptr, 16 * OD_PITCH, 2048, OD_PITCH * 2, 128, 2048};
    CmpOrder S{G, bid, (const char*)(R + R_PROJ), (const char*)(W + W_C1)};
    pg8::EpiBf16<2> E{(bf16_t*)(R + R_HIDC), 256, (const float*)(ws + WS_BIAS1), 1}; pg8::gemm_phase(lds, g, S, E, tid); }
DI void P_e0(KP kp_, int li) { li = UNI(li); const int wpar_ = 0; PHASE_SETUP for (int u = bid; u < 256; u += G) e0_unit(a, li, u, lds, tid, wave, lane); }
DI void P_e1(KP kp_) { const int wpar_ = 0; PHASE_SETUP e1_phase(a, lds, tid, wave, lane, bid, G); }
DI void P_e2(KP kp_) { const int wpar_ = 0; PHASE_SETUP e2_phase(a, tid, bid, G); }
DI void P_e3(KP kp_, int li) { li = UNI(li); const int wpar_ = 0; PHASE_SETUP e3_phase(a, li, lds, tid, wave, lane, bid, G); }
DI void P_e4(KP kp_, int li) { li = UNI(li); const int wpar_ = 0; PHASE_SETUP e4_phase(a, li, gw, NGW, lane); }
DI void P_o2(KP kp_, int layer) { layer = UNI(layer); const int wpar_ = layer & 1; PHASE_SETUP o2_phase(a, W, gw, lane); }
DI void P_o3(KP kp_, int li) { li = UNI(li); const int wpar_ = 0; PHASE_SETUP o3_phase(a, li, lds, tid, wave, lane, bid, G); }
DI void P_xattn(KP kp_) { const int wpar_ = 0; PHASE_SETUP xattn_phase(a, lds, tid, wave, lane, bid, G); }

DI void grid_bar(KP kp_) {
    asm volatile("" : "+s"(kp_));
    XcdBarrier b; b.bar = (unsigned*)(kp_->ws + WS_CTL) + 4096 + kp_->li * XCD_BAR_WORDS; b.x = xb_xcc_id(); b.st = (volatile LAS unsigned*)((LAS unsigned char*)lds_raw + LDSCTL_OFF) + 8;
    xcd_barrier(b);
}
__global__ void __launch_bounds__(512, 2) fwd_kernel(KArgs ka) {
    KP kp = (KP)__builtin_amdgcn_kernarg_segment_ptr();
    {
        LAS unsigned char* lds = (LAS unsigned char*)lds_raw;
        volatile LAS unsigned* MISC = (volatile LAS unsigned*)(lds + LDSCTL_OFF);
        for (int u = threadIdx.x; u < 128; u += 512) MISC[u] = 0u;
        __syncthreads();
        if (ka.ph_hi - ka.ph_lo > 1) (void)xcd_barrier_post((unsigned*)(ka.ws + WS_CTL) + 4096 + ka.li * XCD_BAR_WORDS, MISC + 8);
    }
#define DUP(bit, call) call; if (DUP_MASK & (1 << (bit))) { call; }
#define PH(id, ...) { KP k_ = kp; asm volatile("" : "+s"(k_)); const int lo_ = k_->ph_lo, hi_ = k_->ph_hi; if (lo_ <= (id) && (id) < hi_) { __VA_ARGS__; if ((id) + 1 < hi_) { grid_bar(kp); if (DUP_MASK & 32768) grid_bar(kp); } } }
    for (int layer = 0; layer < DEPTH; ++layer) {
        const int base = layer * PH_PER_LAYER, li = layer >> 1; const bool odd = (layer & 1) != 0;
        if (layer == 0 || gridDim.x != 256) { PH(base + 0, DUP(9, P_prologue(kp, layer))) }
        PH(base + 2, P_norm0_kvx(kp, layer))
        PH(base + 3, DUP(1, P_gemm_swiglu(kp, 0, layer)))
        PH(base + 4, P_gemm_resid(kp, 0, layer == 0 ? 1 : 0, layer))
        PH(base + 5, DUP(0, P_norm(kp, layer, 1)))
        if (!odd) {
            PH(base + 6, DUP(2, P_gemm_bf16(kp, 2, layer)))
            PH(base + 7, P_e0(kp, li))
            PH(base + 8, DUP(3, P_e1(kp)))
            PH(base + 9, DUP(4, P_e2(kp)))
            PH(base + 10, DUP(5, P_e3(kp, li)))
            PH(base + 11, DUP(6, P_e4(kp, li)))
        } else {
            PH(base + 6, DUP(2, P_gemm_bf16(kp, 3, layer)); DUP(2, P_gemm_bf16(kp, 4, layer)))
            PH(base + 7, DUP(7, P_gemm_cmp(kp, layer)))
            PH(base + 8, DUP(7, P_o2(kp, layer)))
            PH(base + 9, DUP(8, P_o3(kp, li)))
        }
        PH(base + 12, P_gemm_resid(kp, 2, 0, layer))
        PH(base + 13, DUP(0, P_norm(kp, layer, 2)))
        PH(base + 14, DUP(2, P_gemm_bf16(kp, 5, layer)))
        PH(base + 15, DUP(11, P_xattn(kp)))
        PH(base + 16, P_gemm_resid(kp, 3, 0, layer))
        PH(base + 17, DUP(0, P_norm(kp, layer, 3)))
        PH(base + 18, DUP(1, P_gemm_swiglu(kp, 1, layer)))
        PH(base + 19, P_gemm_resid(kp, 1, 0, layer))
    }
    PH(PH_FINAL, DUP(10, P_final(kp)))
#undef PH
}

extern "C" void kernel_launch(void* const* d_in, const int* in_sizes, int n_in, void* d_out, int out_size, void* d_ws, size_t ws_size, hipStream_t stream) {
    static int grid = 0;
    if (grid == 0) {
        if (n_in != 25 || out_size != MTOK * DM || ws_size < WS_END) { fprintf(stderr, "kernel_launch: unexpected problem (n_in %d, out %d, ws %zu < %zu)\n", n_in, out_size, ws_size, (size_t)WS_END); grid = -1; return; }
        int dev = 0, cus = 0, per_cu = 0;
        if (hipGetDevice(&dev) != hipSuccess || hipDeviceGetAttribute(&cus, hipDeviceAttributeMultiprocessorCount, dev) != hipSuccess) { grid = -1; return; }
        if (hipFuncSetAttribute((const void*)fwd_kernel, hipFuncAttributeMaxDynamicSharedMemorySize, LDS_BYTES) != hipSuccess) { fprintf(stderr, "kernel_launch: hipFuncSetAttribute failed\n"); grid = -1; return; }
        if (hipOccupancyMaxActiveBlocksPerMultiprocessor(&per_cu, (const void*)fwd_kernel, 512, LDS_BYTES) != hipSuccess || per_cu < 1) fprintf(stderr, "kernel_launch: occupancy query says %d\n", per_cu);
        (void)hipGetLastError();
        grid = cus;
    }
    if (grid < 0) return;
    (void)hipMemsetAsync((char*)d_ws + WS_CTL, 0, CTL_ZERO_BYTES, stream);
    KArgs a{};
    for (int i = 0; i < 25; ++i) a.in[i] = (const float*)d_in[i];
    a.out = (float*)d_out; a.ws = (unsigned char*)d_ws; a.pad = 0;
#if MK_MODE == 1
    a.ph_lo = 0; a.ph_hi = PH_TOTAL; a.li = 0;
    hipLaunchKernelGGL(fwd_kernel, dim3(grid), dim3(512), LDS_BYTES, stream, a);
#else
    for (int p = 0; p < PH_TOTAL; ++p) { const int l = p % PH_PER_LAYER; if (p < PH_FINAL && (((p / PH_PER_LAYER) & 1) != 0) && (l == 10 || l == 11)) continue;
        a.ph_lo = p; a.ph_hi = p + 1; a.li = 0;
        hipLaunchKernelGGL(fwd_kernel, dim3(grid), dim3(512), LDS_BYTES, stream, a); }
#endif
}
```
